# Optimizing an MI355X kernel written in HIP

```python
import functools
import jax, jax.numpy as jnp
from jax import lax
import numpy as np

D_MODEL = 2048
BATCH = 4
SEQ = 2048
DEPTH = 1
DEC_BATCH = 8
DEC_SEQ = 8
PAST_LEN = 16384
PAGE_SIZE = 128

HEAD_DIM = 128
N_HEADS = D_MODEL // HEAD_DIM
N_KV_HEADS = 4
GROUP = N_HEADS // N_KV_HEADS
KV_W = N_KV_HEADS * HEAD_DIM
CMP_LEN = 32
CMP_STRIDE = 16
CMP_SUB = CMP_LEN // CMP_STRIDE
CMP_HID = HEAD_DIM
SLC_LEN = 64
SLC_TOP = 16
N_LOCAL_BLOCKS = 2
WINDOW = 512
WIN_BLK = 128
SLC_Q_CHUNK = 64
CONV_DIM = D_MODEL
CONV_W = 3
D_FF = 4 * D_MODEL
N_KV_KINDS = 4
RMS_EPS = 1e-6
NEG = -1e30
SCALE = HEAD_DIM ** -0.5
W_IN_SPLITS = (N_HEADS * HEAD_DIM,) + (KV_W,) * 6 + (3 * N_HEADS,) + (CONV_DIM,) * 3 + (D_MODEL,) * 2
W_IN_COLS = sum(W_IN_SPLITS)

kernel_name = "nsa_shortconv_gated_hybrid_step"


def rmsnorm(x, g):
    xf = x.astype(jnp.float32)
    y = xf * lax.rsqrt(jnp.mean(xf * xf, axis=-1, keepdims=True) + RMS_EPS)
    return (y * g.astype(jnp.float32)).astype(x.dtype)


def compress(k, w1, w2, pe):
    B, T = k.shape[:2]
    n_chunk = T // CMP_STRIDE
    chunks = k[:, :n_chunk * CMP_STRIDE].reshape(B, n_chunk, CMP_STRIDE, N_KV_HEADS, HEAD_DIM)
    w1s = w1.reshape(CMP_SUB, CMP_STRIDE, HEAD_DIM, CMP_HID)
    part = jnp.einsum('bcrkd,srdf->bcskf', chunks, w1s)
    nc = n_chunk - CMP_SUB + 1
    h = part[:, 0:nc, 0]
    for s in range(1, CMP_SUB):
        h = h + part[:, s:s + nc, s]
    h = h + jnp.einsum('srd,srdf->f', pe.reshape(CMP_SUB, CMP_STRIDE, HEAD_DIM), w1s)
    return jax.nn.gelu(h) @ w2


def cmp_attend(q, kc, vc, q_pos):
    nc = kc.shape[1]
    blk_end = jnp.arange(nc) * CMP_STRIDE + CMP_LEN - 1
    mask = blk_end[None, :] <= q_pos[:, None]
    s = jnp.einsum('bskgd,bckd->bkgsc', q, kc).astype(jnp.float32) * SCALE
    s = jnp.where(mask, s, NEG)
    p = jax.nn.softmax(s, axis=-1) * mask
    o = jnp.einsum('bkgsc,bckd->bskgd', p.astype(vc.dtype), vc)
    return o, p


def select_blocks(p_cmp, q_pos, n_blocks):
    pg = jnp.sum(p_cmp, axis=2)
    nc = pg.shape[-1]
    cs = jnp.arange(nc) * CMP_STRIDE
    sb = jnp.arange(n_blocks) * SLC_LEN
    ov = jnp.clip(jnp.minimum(cs[:, None] + CMP_LEN, sb[None, :] + SLC_LEN)
                  - jnp.maximum(cs[:, None], sb[None, :]), 0, None)
    m = (ov / CMP_STRIDE).astype(jnp.float32)
    score = jnp.einsum('bksc,cn->bksn', pg, m)
    cur = q_pos // SLC_LEN
    j = jnp.arange(n_blocks)
    valid = j[None, :] <= cur[:, None]
    forced = (j[None, :] == 0) | (j[None, :] > cur[:, None] - N_LOCAL_BLOCKS)
    score = jnp.where(valid, jnp.where(forced, jnp.inf, score), -jnp.inf)
    n_top = min(SLC_TOP, n_blocks)
    vals, idx = lax.top_k(score, n_top)
    return idx, vals > -jnp.inf


def slc_attend(q, kb, vb, idx, valid, q_pos):
    gather = jax.vmap(jax.vmap(lambda blocks, ix: blocks[ix]))
    kg = gather(kb, idx)
    vg = gather(vb, idx)
    kpos = idx[..., None] * SLC_LEN + jnp.arange(SLC_LEN)
    mask = valid[..., None] & (kpos <= q_pos[None, None, :, None, None])
    s = jnp.einsum('bskgd,bksnld->bksgnl', q, kg).astype(jnp.float32) * SCALE
    s = jnp.where(mask[:, :, :, None], s, NEG)
    p = jax.nn.softmax(s, axis=(-2, -1))
    return jnp.einsum('bksgnl,bksnld->bskgd', p.astype(vg.dtype), vg)


def nsa_global(q, k_cmp, v_cmp, k_slc, v_slc, q_pos, cw, chunked):
    kc = compress(k_cmp, cw[0], cw[1], cw[2])
    vc = compress(v_cmp, cw[3], cw[4], cw[5])
    o_cmp, p_cmp = cmp_attend(q, kc, vc, q_pos)
    B, T = k_slc.shape[:2]
    ns = -(-T // SLC_LEN)
    idx, valid = select_blocks(p_cmp, q_pos, ns)
    padw = ((0, 0), (0, ns * SLC_LEN - T), (0, 0), (0, 0))
    kb = jnp.pad(k_slc, padw).reshape(B, ns, SLC_LEN, N_KV_HEADS, HEAD_DIM).transpose(0, 3, 1, 2, 4)
    vb = jnp.pad(v_slc, padw).reshape(B, ns, SLC_LEN, N_KV_HEADS, HEAD_DIM).transpose(0, 3, 1, 2, 4)
    if chunked:
        S = q.shape[1]
        qc = min(SLC_Q_CHUNK, S)
        nq = S // qc
        n_top = idx.shape[-1]
        qs = q.reshape(B, nq, qc, N_KV_HEADS, GROUP, HEAD_DIM).swapaxes(0, 1)
        ids = idx.reshape(B, N_KV_HEADS, nq, qc, n_top).transpose(2, 0, 1, 3, 4)
        vls = valid.reshape(B, N_KV_HEADS, nq, qc, n_top).transpose(2, 0, 1, 3, 4)
        ps = q_pos.reshape(nq, qc)
        o = lax.map(lambda a: slc_attend(a[0], kb, vb, a[1], a[2], a[3]), (qs, ids, vls, ps))
        o_slc = o.swapaxes(0, 1).reshape(B, S, N_KV_HEADS, GROUP, HEAD_DIM)
    else:
        o_slc = slc_attend(q, kb, vb, idx, valid, q_pos)
    return o_cmp, o_slc


def window_prompt(q, k, v):
    B, S = k.shape[:2]
    blk = min(WIN_BLK, S)
    nb = S // blk
    nprev = -(-WINDOW // blk)
    span = (nprev + 1) * blk
    padw = ((0, 0), (nprev * blk, 0), (0, 0), (0, 0))
    kp = jnp.pad(k, padw).reshape(B, nb + nprev, blk, N_KV_HEADS, HEAD_DIM)
    vp = jnp.pad(v, padw).reshape(B, nb + nprev, blk, N_KV_HEADS, HEAD_DIM)
    kband = jnp.concatenate([kp[:, j:j + nb] for j in range(nprev + 1)], axis=2)
    vband = jnp.concatenate([vp[:, j:j + nb] for j in range(nprev + 1)], axis=2)
    qb = q.reshape(B, nb, blk, N_KV_HEADS, GROUP, HEAD_DIM)
    qpos = jnp.arange(S).reshape(nb, blk)
    kpos = (jnp.arange(nb) * blk - nprev * blk)[:, None] + jnp.arange(span)[None, :]
    diff = qpos[:, :, None] - kpos[:, None, :]
    mask = (kpos[:, None, :] >= 0) & (diff >= 0) & (diff < WINDOW)
    s = jnp.einsum('bnqkgd,bnckd->bnkgqc', qb, kband).astype(jnp.float32) * SCALE
    s = jnp.where(mask[None, :, None, None], s, NEG)
    p = jax.nn.softmax(s, axis=-1)
    o = jnp.einsum('bnkgqc,bnckd->bnqkgd', p.astype(vband.dtype), vband)
    return o.reshape(B, S, N_KV_HEADS, GROUP, HEAD_DIM)


def local_attend(q, k, v, mask):
    s = jnp.einsum('bskgd,btkd->bkgst', q, k).astype(jnp.float32) * SCALE
    s = jnp.where(mask, s, NEG)
    p = jax.nn.softmax(s, axis=-1)
    return jnp.einsum('bkgst,btkd->bskgd', p.astype(v.dtype), v)


def nsa_prompt(q, kv, cw):
    k_cmp, v_cmp, k_slc, v_slc, k_win, v_win = kv
    S = q.shape[1]
    q_pos = jnp.arange(S)
    o_cmp, o_slc = nsa_global(q, k_cmp, v_cmp, k_slc, v_slc, q_pos, cw, True)
    o_win = window_prompt(q, k_win, v_win)
    kv_rows = jnp.stack([k_cmp, v_cmp, k_slc, v_slc], axis=2)
    wb = min(WINDOW, S)
    win_state = jnp.stack([k_win, v_win], axis=2)[:, S - wb:]
    return o_cmp, o_slc, o_win, kv_rows, win_state


def nsa_sample(q, kv, cw, cache, page_table, win):
    k_cmp, v_cmp, k_slc, v_slc, k_win, v_win = kv
    DB, DS = q.shape[:2]
    past_len = page_table.shape[1] * cache.shape[1]
    kv_rows = jnp.stack([k_cmp, v_cmp, k_slc, v_slc], axis=2)
    past = cache[page_table].reshape(DB, past_len, N_KV_KINDS, N_KV_HEADS, HEAD_DIM)
    full = jnp.concatenate([past, kv_rows.astype(past.dtype)], axis=1)
    q_pos = past_len + jnp.arange(DS)
    o_cmp, o_slc = nsa_global(q, full[:, :, 0], full[:, :, 1], full[:, :, 2], full[:, :, 3], q_pos, cw, False)
    wb = win.shape[1]
    wk = jnp.concatenate([win, jnp.stack([k_win, v_win], axis=2).astype(win.dtype)], axis=1)
    kpos = past_len - wb + jnp.arange(wb + DS)
    diff = q_pos[:, None] - kpos[None, :]
    o_win = local_attend(q, wk[:, :, 0], wk[:, :, 1], (diff >= 0) & (diff < WINDOW))
    win_state = wk[:, DS:]
    return o_cmp, o_slc, o_win, kv_rows, win_state


def short_conv(u, prev, w, b):
    S = u.shape[1]
    up = jnp.concatenate([prev.astype(u.dtype), u], axis=1)
    y = b
    for j in range(CONV_W):
        y = y + up[:, j:j + S] * w[j]
    return y, up[:, S:]


def layer_forward(x, c, lw, cw, nsa_fn, conv_prev):
    B, S = x.shape[:2]
    ada = jax.nn.silu(c) @ lw['w_ada'] + lw['b_ada']
    sh1, sc1, g1, sh2, sc2, g2 = jnp.split(ada[:, None, :], 6, axis=-1)
    h = rmsnorm(x, lw['norm1_g']) * (1 + sc1) + sh1
    parts = jnp.split(h @ lw['w_in'], list(np.cumsum(W_IN_SPLITS)[:-1]), axis=-1)
    q, k_cmp, v_cmp, k_slc, v_slc, k_win, v_win, g_nsa, u_in, b_gate, c_gate, m_attn, m_conv = parts
    q = q.reshape(B, S, N_KV_HEADS, GROUP, HEAD_DIM)
    kv = tuple(t.reshape(B, S, N_KV_HEADS, HEAD_DIM) for t in (k_cmp, v_cmp, k_slc, v_slc, k_win, v_win))
    o_cmp, o_slc, o_win, kv_rows, win_state = nsa_fn(q, kv, cw)
    g = jax.nn.sigmoid(g_nsa).reshape(B, S, 3, N_KV_HEADS, GROUP, 1)
    o_attn = (g[:, :, 0] * o_cmp + g[:, :, 1] * o_slc + g[:, :, 2] * o_win).reshape(B, S, N_HEADS * HEAD_DIM)
    conv_y, conv_state = short_conv(c_gate * u_in, conv_prev, lw['conv_w'], lw['conv_b'])
    z = b_gate * conv_y
    mixed = (jax.nn.sigmoid(m_attn) * (o_attn @ lw['w_attn_proj'])
             + jax.nn.sigmoid(m_conv) * (z @ lw['w_conv_proj']))
    x = x + g1 * (mixed @ lw['w_out'])
    h2 = rmsnorm(x, lw['norm2_g']) * (1 + sc2) + sh2
    x = x + g2 * (jnp.square(jax.nn.relu(h2 @ lw['w_mlp1'])) @ lw['w_mlp2'])
    return x, kv_rows, win_state, conv_state


def setup_inputs(seed: int = 0) -> dict:
    key = jax.random.key(seed)
    ks = jax.random.split(key, 32)
    f32 = jnp.float32
    n_pages = PAST_LEN // PAGE_SIZE
    n_used = DEC_BATCH * n_pages
    n_pool = n_used + max(1, n_used // 4)
    win_buf = min(WINDOW, PAST_LEN)

    def nrm(k, shape, scale):
        return jax.random.normal(k, shape, f32) * scale

    page_table = jax.random.permutation(ks[0], n_pool)[:n_used].reshape(DEC_BATCH, n_pages).astype(jnp.int32)
    return {
        'x_prompt': nrm(ks[1], (BATCH, SEQ, D_MODEL), 1.0),
        'x_sample': nrm(ks[2], (DEC_BATCH, DEC_SEQ, D_MODEL), 1.0),
        'c_prompt': nrm(ks[3], (BATCH, D_MODEL), 1.0),
        'c_sample': nrm(ks[4], (DEC_BATCH, D_MODEL), 1.0),
        'cache_nsa_kv': nrm(ks[5], (DEPTH, n_pool, PAGE_SIZE, N_KV_KINDS, N_KV_HEADS, HEAD_DIM), 1.0),
        'page_table': page_table,
        'state_win_kv': nrm(ks[6], (DEPTH, DEC_BATCH, win_buf, 2, N_KV_HEADS, HEAD_DIM), 1.0),
        'state_conv': nrm(ks[7], (DEPTH, DEC_BATCH, CONV_W - 1, CONV_DIM), 1.0),
        'w_ada': nrm(ks[8], (DEPTH, D_MODEL, 6 * D_MODEL), 0.5 * D_MODEL ** -0.5),
        'b_ada': nrm(ks[9], (DEPTH, 6 * D_MODEL), 0.02),
        'norm1_g': 1.0 + nrm(ks[10], (DEPTH, D_MODEL), 0.05),
        'norm2_g': 1.0 + nrm(ks[11], (DEPTH, D_MODEL), 0.05),
        'w_in': nrm(ks[12], (DEPTH, D_MODEL, W_IN_COLS), D_MODEL ** -0.5),
        'w_cmp_k1': nrm(ks[13], (DEPTH, CMP_LEN * HEAD_DIM, CMP_HID), (CMP_LEN * HEAD_DIM) ** -0.5),
        'w_cmp_k2': nrm(ks[14], (DEPTH, CMP_HID, HEAD_DIM), 1.5 * CMP_HID ** -0.5),
        'pe_cmp_k': nrm(ks[15], (DEPTH, CMP_LEN, HEAD_DIM), 0.1),
        'w_cmp_v1': nrm(ks[16], (DEPTH, CMP_LEN * HEAD_DIM, CMP_HID), (CMP_LEN * HEAD_DIM) ** -0.5),
        'w_cmp_v2': nrm(ks[17], (DEPTH, CMP_HID, HEAD_DIM), 1.5 * CMP_HID ** -0.5),
        'pe_cmp_v': nrm(ks[18], (DEPTH, CMP_LEN, HEAD_DIM), 0.1),
        'conv_w': nrm(ks[19], (DEPTH, CONV_W, CONV_DIM), CONV_W ** -0.5),
        'conv_b': nrm(ks[20], (DEPTH, CONV_DIM), 0.02),
        'w_attn_proj': nrm(ks[21], (DEPTH, N_HEADS * HEAD_DIM, D_MODEL), (N_HEADS * HEAD_DIM) ** -0.5),
        'w_conv_proj': nrm(ks[22], (DEPTH, CONV_DIM, D_MODEL), CONV_DIM ** -0.5),
        'w_out': nrm(ks[23], (DEPTH, D_MODEL, D_MODEL), D_MODEL ** -0.5),
        'w_mlp1': nrm(ks[24], (DEPTH, D_MODEL, D_FF), D_MODEL ** -0.5),
        'w_mlp2': nrm(ks[25], (DEPTH, D_FF, D_MODEL), D_FF ** -0.5),
        'normf_g': 1.0 + nrm(ks[26], (D_MODEL,), 0.05),
    }


def reference(x_prompt, x_sample, c_prompt, c_sample, cache_nsa_kv, page_table, state_win_kv, state_conv,
              w_ada, b_ada, norm1_g, norm2_g, w_in, w_cmp_k1, w_cmp_k2, pe_cmp_k, w_cmp_v1, w_cmp_v2, pe_cmp_v,
              conv_w, conv_b, w_attn_proj, w_conv_proj, w_out, w_mlp1, w_mlp2, normf_g):
    yp, ys = x_prompt, x_sample
    kv_p, kv_s, win_p, win_s, conv_p, conv_s = [], [], [], [], [], []
    for l in range(DEPTH):
        lw = {'w_ada': w_ada[l], 'b_ada': b_ada[l], 'norm1_g': norm1_g[l], 'norm2_g': norm2_g[l],
              'w_in': w_in[l], 'conv_w': conv_w[l], 'conv_b': conv_b[l], 'w_attn_proj': w_attn_proj[l],
              'w_conv_proj': w_conv_proj[l], 'w_out': w_out[l], 'w_mlp1': w_mlp1[l], 'w_mlp2': w_mlp2[l]}
        cw = (w_cmp_k1[l], w_cmp_k2[l], pe_cmp_k[l], w_cmp_v1[l], w_cmp_v2[l], pe_cmp_v[l])
        conv0 = jnp.zeros((yp.shape[0], CONV_W - 1, CONV_DIM), yp.dtype)
        yp, a, b, c = layer_forward(yp, c_prompt, lw, cw, nsa_prompt, conv0)
        kv_p.append(a); win_p.append(b); conv_p.append(c)
        sample_fn = functools.partial(nsa_sample, cache=cache_nsa_kv[l], page_table=page_table, win=state_win_kv[l])
        ys, a, b, c = layer_forward(ys, c_sample, lw, cw, sample_fn, state_conv[l])
        kv_s.append(a); win_s.append(b); conv_s.append(c)
    y_prompt = rmsnorm(yp, normf_g)
    y_sample = rmsnorm(ys, normf_g)
    return (y_prompt, y_sample, jnp.stack(kv_p), jnp.stack(kv_s), jnp.stack(win_p), jnp.stack(win_s),
            jnp.stack(conv_p), jnp.stack(conv_s))
```

```cpp
#include <hip/hip_runtime.h>
#include <cstdio>
#include <cstdint>

#ifndef MK_PER_PHASE
#define MK_PER_PHASE 1
#endif

#define LAS __attribute__((address_space(3)))
typedef unsigned short bf16;
typedef short bf16x8 __attribute__((ext_vector_type(8)));
typedef float f32x4 __attribute__((ext_vector_type(4)));
typedef float f32x2 __attribute__((ext_vector_type(2)));
typedef unsigned u32x4 __attribute__((ext_vector_type(4)));
typedef unsigned u32x2 __attribute__((ext_vector_type(2)));

constexpr int D = 2048, NBP = 4, SEQ = 2048, NBS = 8, DSQ = 8, PAST = 16384, PAGE = 128, NPAGES = 128;
constexpr int HD = 128, NH = 16, NKV = 4, GRP = 4;
constexpr int MP = NBP * SEQ;
constexpr int MS = NBS * DSQ;
constexpr int MR = MP + MS;
constexpr int MPAD = 8448;
constexpr int NIN = 15616;
constexpr int NIN_REAL = 15408;
constexpr int DFF = 8192;
constexpr int NBATCH = NBP + NBS;
constexpr float RMS_EPS = 1e-6f;
constexpr float SCALE = 0.08838834764831845f;
constexpr int PC_Q = 0, PC_KV = 2048, PC_KWIN = 4096, PC_VWIN = 4608, PC_U = 5120, PC_B = 7168, PC_C = 9216, PC_MA = 11264, PC_MC = 13312, PC_G = 15360;
constexpr int NCP = 127, NCS = 1023;
constexpr int NSP = 32, NSS = 257;

constexpr size_t OUT_YP = 0, OUT_YS = OUT_YP + (size_t)MP * D, OUT_KVP = OUT_YS + (size_t)MS * D, OUT_KVS = OUT_KVP + (size_t)MP * 2048,
                 OUT_WINP = OUT_KVS + (size_t)MS * 2048, OUT_WINS = OUT_WINP + (size_t)NBP * 512 * 1024, OUT_CONVP = OUT_WINS + (size_t)NBS * 512 * 1024,
                 OUT_CONVS = OUT_CONVP + (size_t)NBP * 2 * D, OUT_END = OUT_CONVS + (size_t)NBS * 2 * D;

constexpr size_t al256(size_t x) { return (x + 255) & ~(size_t)255; }
constexpr size_t WS_CTL = 0, CTL_BYTES = 1u << 20;
constexpr size_t WS_ADA = WS_CTL + CTL_BYTES;
constexpr size_t WS_PEB = al256(WS_ADA + (size_t)NBATCH * 6 * D * 4);
constexpr size_t WS_WIN_T = al256(WS_PEB + 2 * 128 * 4);
constexpr size_t WS_WP_T = al256(WS_WIN_T + (size_t)NIN * D * 2);
constexpr size_t WS_WOUT_T = al256(WS_WP_T + (size_t)D * 2 * D * 2);
constexpr size_t WS_W1_T = al256(WS_WOUT_T + (size_t)D * D * 2);
constexpr size_t WS_W2_T = al256(WS_W1_T + (size_t)DFF * D * 2);
constexpr size_t WS_WC_T = al256(WS_W2_T + (size_t)D * DFF * 2);
constexpr size_t WS_H = al256(WS_WC_T + (size_t)512 * 2048 * 2);
constexpr size_t WS_P = al256(WS_H + (size_t)MPAD * D * 2);
constexpr size_t WS_KV6 = al256(WS_P + (size_t)MPAD * NIN * 2);
constexpr size_t WS_CA = al256(WS_KV6 + (size_t)6 * NBP * NKV * SEQ * HD * 2);
constexpr size_t WS_PARTS = al256(WS_CA + (size_t)2 * NBS * NKV * PAST * HD * 2);
constexpr size_t WS_PARTP = al256(WS_PARTS + (size_t)32768 * 512 * 4);
constexpr size_t WS_KCS = al256(WS_PARTP + (size_t)2048 * 512 * 4);
constexpr size_t WS_KCP = al256(WS_KCS + (size_t)2 * NBS * NKV * 1024 * HD * 4);
constexpr size_t WS_OCMP = al256(WS_KCP + (size_t)2 * NBP * NKV * 128 * HD * 4);
constexpr size_t WS_OSLC = al256(WS_OCMP + (size_t)MPAD * D * 4);
constexpr size_t WS_OWIN = al256(WS_OSLC + (size_t)MPAD * D * 4);
constexpr size_t WS_SELP = al256(WS_OWIN + (size_t)MPAD * D * 4);
constexpr size_t WS_SELS = al256(WS_SELP + (size_t)NBP * NKV * SEQ * 4);
constexpr size_t WS_A2 = al256(WS_SELS + (size_t)NBS * NKV * DSQ * 16 * 4);
constexpr size_t WS_MIX = al256(WS_A2 + (size_t)MPAD * 2 * D * 2);
constexpr size_t WS_X1 = al256(WS_MIX + (size_t)MPAD * D * 2);
constexpr size_t WS_HM = al256(WS_X1 + (size_t)MPAD * D * 4);
constexpr size_t WS_X2 = al256(WS_HM + (size_t)MPAD * DFF * 2);
constexpr size_t WS_END = al256(WS_X2 + (size_t)MPAD * D * 4);

__device__ __forceinline__ float bf2f(bf16 b) { return __uint_as_float(((unsigned)b) << 16); }
__device__ __forceinline__ unsigned f2bf(float f) { unsigned u = __float_as_uint(f); return (u + 0x7fffu + ((u >> 16) & 1u)) >> 16; }
__device__ __forceinline__ unsigned pk2(float lo, float hi) { return f2bf(lo) | (f2bf(hi) << 16); }
__device__ __forceinline__ float lo_bf(unsigned w) { return __uint_as_float(w << 16); }
__device__ __forceinline__ float hi_bf(unsigned w) { return __uint_as_float(w & 0xffff0000u); }
__device__ __forceinline__ float sigmoidf_(float x) { return 1.0f / (1.0f + __expf(-x)); }
__device__ __forceinline__ float wave_sum(float v) {
#pragma unroll
    for (int o = 1; o < 64; o <<= 1) v += __shfl_xor(v, o);
    return v;
}
__device__ __forceinline__ float wave_max(float v) {
#pragma unroll
    for (int o = 1; o < 64; o <<= 1) v = fmaxf(v, __shfl_xor(v, o));
    return v;
}
__device__ __forceinline__ int batch_of(int r) { return r < MP ? (r >> 11) : (NBP + (((r < MR ? r : MR - 1) - MP) >> 3)); }

namespace pg8 {
constexpr int BM = 256, BK = 64, HALF = 128, HTB = HALF * BK * 2, STAGE_BYTES = 8 * HTB, NXCD = 8, WGM = 8;
__host__ __device__ __forceinline__ int lds_byte(int r, int c) { const int st = (r >> 4) * 2 + (c >> 5), rr = r & 15, cc = c & 31, ob = rr * 64 + cc * 2; return st * 1024 + (ob ^ (((ob >> 9) & 1) << 5)); }
__host__ __device__ __forceinline__ void stage_rc(int b, int& R, int& C) { const int st = b / 1024, sb = b % 1024, swz = sb ^ (((sb >> 9) & 1) << 5); R = (st >> 1) * 16 + swz / 64; C = (st & 1) * 32 + (swz % 64) / 2; }
__host__ __device__ __forceinline__ int perm32(int rho) { const int n = rho >> 4, i = rho & 15; return 8 * (i >> 2) + 4 * n + (i & 3); }

struct Unit { int pm, pn, part; };
struct Prob { const char* A; const char* B; size_t a_tile, a_pn, a_part, b_tile, b_part; unsigned lda, ldb; int nt;
    __device__ __forceinline__ const char* a_ptr(const Unit& u) const { return A + (size_t)u.pm * a_tile + (size_t)u.pn * a_pn + (size_t)u.part * a_part; }
    __device__ __forceinline__ const char* b_ptr(const Unit& u) const { return B + (size_t)u.pn * b_tile + (size_t)u.part * b_part; } };

struct Order {
    int nM, nN, nwg, G, c, parts;
    __device__ void init(int M, int N, int G_, int c_, int parts_) { nM = M / BM; nN = N / BM; nwg = nM * nN; G = G_; c = c_; parts = parts_; }
    __device__ bool next(int i, Unit& u) const {
        const int ti = i / parts; u.part = i - ti * parts;
        const long L = (long)ti * G + c; if (L >= nwg) return false;
        int wgid = (int)L; { const int q = nwg / NXCD, r = nwg % NXCD, xcd = wgid % NXCD, off = wgid / NXCD; wgid = (xcd < r ? xcd * (q + 1) : r * (q + 1) + (xcd - r) * q) + off; }
        const int nig = WGM * nN, gid = wgid / nig, fm = gid * WGM, gsz = (nM - fm) < WGM ? (nM - fm) : WGM;
        u.pm = fm + ((wgid % nig) % gsz); u.pn = (wgid % nig) / gsz; return true;
    }
};
__device__ __forceinline__ unsigned cvt_pk_bf16(float lo, float hi) { unsigned r; asm volatile("v_cvt_pk_bf16_f32 %0, %1, %2" : "=v"(r) : "v"(lo), "v"(hi)); return r; }

template <class Epi, bool ALIGN_EPI = true, bool SP2 = true>
__device__ __forceinline__ void gemm_phase(LAS unsigned char* lds, const Prob g, const Order& S, const Epi& E) {
    const int tid = threadIdx.x, wid = __builtin_amdgcn_readfirstlane(tid >> 6), lane = tid & 63, wr = wid >> 2, wc = wid & 3, fr = lane & 15, fq = lane >> 4;
    const int nt = g.nt;
    unsigned voffA[2], voffB[2];
#pragma unroll
    for (int i = 0; i < 2; ++i) { int R, C; stage_rc(tid * 16 + i * 8192, R, C); const int Rb = Epi::PERM ? ((R & ~31) + perm32(R & 31)) : R;
        voffA[i] = (unsigned)R * g.lda + (unsigned)C * 2u; voffB[i] = (unsigned)Rb * g.ldb + (unsigned)C * 2u; }
    const size_t kstep = (size_t)(BK * 2);
    const size_t hstepA = (size_t)HALF * g.lda, hstepB = (size_t)HALF * g.ldb;
    const unsigned ldsw = (unsigned)wid * 1024u;
    const int aoff = lds_byte(wr * 64 + fr, fq * 8), boff = lds_byte(wc * 32 + fr, fq * 8);
#define PG8_SA(b, h) (((b) * 2 + (h)) * HTB)
#define PG8_SB(b, h) ((4 + (b) * 2 + (h)) * HTB)
#define PG8_STAGE(bufoff, gbase, voff) do { _Pragma("unroll") for (int _i = 0; _i < 2; ++_i) \
        __builtin_amdgcn_global_load_lds((const unsigned*)((const char*)(gbase) + (voff)[_i]), (LAS unsigned*)(lds + (bufoff) + ldsw + _i * 8192), 16, 0, 0); } while (0)
#define PG8_LDA(dst, b, h) do { _Pragma("unroll") for (int m = 0; m < 4; ++m) _Pragma("unroll") for (int k = 0; k < 2; ++k) dst[m][k] = *(const LAS bf16x8*)(lds + PG8_SA(b, h) + aoff + m * 2048 + k * 1024); } while (0)
#define PG8_LDB(dst, b, h) do { _Pragma("unroll") for (int n = 0; n < 2; ++n) _Pragma("unroll") for (int k = 0; k < 2; ++k) dst[n][k] = *(const LAS bf16x8*)(lds + PG8_SB(b, h) + boff + n * 2048 + k * 1024); } while (0)
#define PG8_MMA(ai, bj, At, Bt) do { __builtin_amdgcn_s_setprio(1); _Pragma("unroll") for (int m = 0; m < 4; ++m) _Pragma("unroll") for (int n = 0; n < 2; ++n) _Pragma("unroll") for (int k = 0; k < 2; ++k) \
        acc[ai][bj][m][n] = __builtin_amdgcn_mfma_f32_16x16x32_bf16(Bt[n][k], At[m][k], acc[ai][bj][m][n], 0, 0, 0); __builtin_amdgcn_s_setprio(0); } while (0)
#define PG8_WAIT_V(n) asm volatile("s_waitcnt vmcnt(" #n ")" ::: "memory")
#define PG8_WAIT_L(n) asm volatile("s_waitcnt lgkmcnt(" #n ")" ::: "memory")
#define PG8_BAR __builtin_amdgcn_s_barrier()
#define PG8_SCHED __builtin_amdgcn_sched_barrier(0)
    Unit cur, nxt; int ui = 0;
    if (!S.next(0, cur)) return;
    f32x4 acc[2][2][4][2];
#pragma unroll
    for (int a = 0; a < 2; ++a)
#pragma unroll
        for (int b = 0; b < 2; ++b)
#pragma unroll
            for (int m = 0; m < 4; ++m)
#pragma unroll
                for (int n = 0; n < 2; ++n) acc[a][b][m][n] = (f32x4){0.f, 0.f, 0.f, 0.f};
    bf16x8 At[4][2], B0[2][2], B1[2][2];
    const char* cA = g.a_ptr(cur); const char* cB = g.b_ptr(cur);
    if constexpr (SP2) {
        PG8_STAGE(PG8_SB(0, 0), cB, voffB); PG8_STAGE(PG8_SB(0, 1), cB + hstepB, voffB); PG8_STAGE(PG8_SA(0, 0), cA, voffA); PG8_STAGE(PG8_SA(0, 1), cA + hstepA, voffA);
        if (wr == 1) PG8_BAR;
        PG8_WAIT_V(2); PG8_BAR;
        PG8_STAGE(PG8_SB(1, 0), cB + kstep, voffB); PG8_STAGE(PG8_SA(1, 0), cA + kstep, voffA); PG8_STAGE(PG8_SB(1, 1), cB + hstepB + kstep, voffB);
        PG8_WAIT_V(6); PG8_BAR;
    } else {
        PG8_STAGE(PG8_SB(0, 0), cB, voffB); PG8_STAGE(PG8_SA(0, 0), cA, voffA); PG8_STAGE(PG8_SB(0, 1), cB + hstepB, voffB); PG8_STAGE(PG8_SA(0, 1), cA + hstepA, voffA);
        if (wr == 1) PG8_BAR;
        PG8_WAIT_V(4); PG8_BAR;
        PG8_STAGE(PG8_SB(1, 0), cB + kstep, voffB); PG8_STAGE(PG8_SA(1, 0), cA + kstep, voffA); PG8_STAGE(PG8_SB(1, 1), cB + hstepB + kstep, voffB);
        PG8_WAIT_V(6); PG8_BAR;
    }
    for (;;) {
        const bool has_next = S.next(ui + 1, nxt);
        const char* nA = has_next ? g.a_ptr(nxt) : cA; const char* nB = has_next ? g.b_ptr(nxt) : cB;
        for (int t = 0; t < nt; t += 2) {
            const bool last = (t == nt - 2);
            const char* a1 = cA + (size_t)(t + 1) * kstep;
            const char* a2 = last ? nA : cA + (size_t)(t + 2) * kstep; const char* b2 = last ? nB : cB + (size_t)(t + 2) * kstep;
            const char* a3 = a2 + kstep; const char* b3 = b2 + kstep;
            if constexpr (SP2) {
            PG8_LDB(B0, 0, 0); PG8_LDB(B1, 0, 1); PG8_SCHED; PG8_LDA(At, 0, 0); PG8_STAGE(PG8_SA(1, 1), a1 + hstepA, voffA);
            PG8_WAIT_V(8); PG8_WAIT_L(0); PG8_BAR; PG8_MMA(0, 0, At, B0); PG8_MMA(0, 1, At, B1); PG8_BAR; PG8_SCHED;
            PG8_LDA(At, 0, 1); PG8_STAGE(PG8_SB(0, 0), b2, voffB); PG8_STAGE(PG8_SB(0, 1), b2 + hstepB, voffB); PG8_STAGE(PG8_SA(0, 0), a2, voffA);
            PG8_WAIT_V(8); PG8_WAIT_L(0); PG8_BAR; PG8_MMA(1, 0, At, B0); PG8_MMA(1, 1, At, B1); PG8_BAR; PG8_SCHED;
            PG8_LDB(B0, 1, 0); PG8_LDB(B1, 1, 1); PG8_SCHED; PG8_LDA(At, 1, 0); PG8_STAGE(PG8_SA(0, 1), a2 + hstepA, voffA);
            PG8_WAIT_V(8); PG8_WAIT_L(0); PG8_BAR; PG8_MMA(0, 0, At, B0); PG8_MMA(0, 1, At, B1); PG8_BAR; PG8_SCHED;
            PG8_LDA(At, 1, 1); PG8_STAGE(PG8_SB(1, 0), b3, voffB); PG8_STAGE(PG8_SB(1, 1), b3 + hstepB, voffB); PG8_STAGE(PG8_SA(1, 0), a3, voffA);
            PG8_WAIT_V(8); PG8_WAIT_L(0); PG8_BAR; PG8_MMA(1, 0, At, B0); PG8_MMA(1, 1, At, B1); PG8_BAR; PG8_SCHED;
            } else {
            PG8_LDB(B0, 0, 0); PG8_SCHED; PG8_LDA(At, 0, 0); PG8_STAGE(PG8_SA(1, 1), a1 + hstepA, voffA);
            PG8_WAIT_L(8); PG8_BAR; PG8_WAIT_L(0); PG8_MMA(0, 0, At, B0); PG8_BAR; PG8_SCHED;
            PG8_LDB(B1, 0, 1); PG8_STAGE(PG8_SB(0, 0), b2, voffB);
            PG8_BAR; PG8_WAIT_L(0); PG8_MMA(0, 1, At, B1); PG8_BAR;
            PG8_LDA(At, 0, 1); PG8_STAGE(PG8_SA(0, 0), a2, voffA);
            PG8_BAR; PG8_WAIT_L(0); PG8_MMA(1, 0, At, B0); PG8_BAR; PG8_SCHED;
            PG8_STAGE(PG8_SB(0, 1), b2 + hstepB, voffB);
            PG8_WAIT_V(6); PG8_BAR; PG8_MMA(1, 1, At, B1); PG8_BAR;
            PG8_LDB(B0, 1, 0); PG8_SCHED; PG8_LDA(At, 1, 0); PG8_STAGE(PG8_SA(0, 1), a2 + hstepA, voffA);
            PG8_WAIT_L(8); PG8_BAR; PG8_WAIT_L(0); PG8_MMA(0, 0, At, B0); PG8_BAR; PG8_SCHED;
            PG8_LDB(B1, 1, 1); PG8_STAGE(PG8_SB(1, 0), b3, voffB);
            PG8_BAR; PG8_WAIT_L(0); PG8_MMA(0, 1, At, B1); PG8_BAR;
            PG8_LDA(At, 1, 1); PG8_STAGE(PG8_SA(1, 0), a3, voffA);
            PG8_BAR; PG8_WAIT_L(0); PG8_MMA(1, 0, At, B0); PG8_BAR; PG8_SCHED;
            PG8_STAGE(PG8_SB(1, 1), b3 + hstepB, voffB);
            PG8_WAIT_V(6); PG8_BAR; PG8_MMA(1, 1, At, B1); PG8_BAR;
            }
        }
        if constexpr (ALIGN_EPI) { if (wr == 0) PG8_BAR; }
        E(acc, cur, wr, wc, fr, fq);
        if (!has_next) break;
        if (!E.keep(cur)) {
#pragma unroll
        for (int a = 0; a < 2; ++a)
#pragma unroll
            for (int b = 0; b < 2; ++b)
#pragma unroll
                for (int m = 0; m < 4; ++m)
#pragma unroll
                    for (int n = 0; n < 2; ++n) acc[a][b][m][n] = (f32x4){0.f, 0.f, 0.f, 0.f};
        }
        cur = nxt; cA = nA; cB = nB; ++ui;
        if constexpr (ALIGN_EPI) { if (wr == 1) PG8_BAR; }
    }
    PG8_WAIT_V(0);
    if constexpr (!ALIGN_EPI) { if (wr == 0) PG8_BAR; }
    PG8_BAR;
#undef PG8_SA
#undef PG8_SB
#undef PG8_STAGE
#undef PG8_LDA
#undef PG8_LDB
#undef PG8_MMA
#undef PG8_WAIT_V
#undef PG8_WAIT_L
#undef PG8_BAR
#undef PG8_SCHED
}
}
using pg8::Unit;
typedef f32x4 AccT[2][2][4][2];

#define XB_TMO      128
#define XB_XCNT(j)  (256  + 64 * (j))
#define XB_XSUB(j)  (1280 + 64 * (j))
#define XB_XGEN(j)  (2304 + 64 * (j))
#define XB_TOP      3328
#define XB_TOPGEN   3392
#define XCD_BAR_WORDS 3456
#define XB_SPIN_CAP (1u << 18)
__device__ __forceinline__ unsigned xb_ld(unsigned* p)              { return __hip_atomic_load(p, __ATOMIC_RELAXED, __HIP_MEMORY_SCOPE_AGENT); }
__device__ __forceinline__ unsigned xb_add(unsigned* p, unsigned v) { return __hip_atomic_fetch_add(p, v, __ATOMIC_RELAXED, __HIP_MEMORY_SCOPE_AGENT); }
__device__ __forceinline__ unsigned xb_xcc_id() { return (unsigned)__builtin_amdgcn_s_getreg((3 << 11) | 20) & 0xFu; }
#define XB_SPIN(cond, bar) do { unsigned _sp = 0; while (cond) { __builtin_amdgcn_s_sleep(1); \
    if ((++_sp & 255u) == 0u) { if (xb_ld(&(bar)[XB_TMO])) break; if (_sp > XB_SPIN_CAP) { atomicAdd(&(bar)[XB_TMO], 1u); break; } } } } while (0)
struct XcdBarrier { unsigned* bar; unsigned x; volatile LAS unsigned* st; };
__device__ __forceinline__ XcdBarrier xcd_barrier_post(unsigned* bar, volatile LAS unsigned* st) {
    XcdBarrier b; b.bar = bar; b.x = xb_xcc_id(); b.st = st;
    if (threadIdx.x == 0) (void)xb_add(&bar[XB_XCNT(b.x)], 1u);
    return b;
}
__device__ __forceinline__ void xcd_barrier_complete(unsigned* bar, unsigned x, unsigned& nloc, unsigned& nx) {
    const unsigned G = gridDim.x * gridDim.y * gridDim.z;
    unsigned sum, cnt, mine, sp = 0u;
    for (;;) {
        sum = 0u; cnt = 0u; mine = 0u;
#pragma unroll
        for (unsigned j = 0; j < 16; ++j) { const unsigned c = xb_ld(&bar[XB_XCNT(j)]); sum += c; cnt += (c > 0u) ? 1u : 0u; mine = (j == x) ? c : mine; }
        if (sum == G) break;
        __builtin_amdgcn_s_sleep(1);
        if ((++sp & 255u) == 0u) { if (xb_ld(&bar[XB_TMO])) break; if (sp > XB_SPIN_CAP) { atomicAdd(&bar[XB_TMO], 1u); break; } }
    }
    nloc = mine > 0u ? mine : 1u; nx = cnt > 0u ? cnt : 1u;
}
__device__ __forceinline__ void xcd_barrier(const XcdBarrier& b) {
    asm volatile("s_waitcnt vmcnt(0)" ::: "memory");
    __syncthreads();
    if (threadIdx.x == 0) {
        unsigned* bar = b.bar;
        __builtin_amdgcn_s_waitcnt(0);
        unsigned nloc = b.st[0], nx = b.st[1];
        if (nloc == 0u) { xcd_barrier_complete(bar, b.x, nloc, nx); b.st[0] = nloc; b.st[1] = nx; }
        const unsigned old = xb_add(&bar[XB_XSUB(b.x)], 1u);
        const unsigned gen = old / nloc;
        if (old + 1u == (gen + 1u) * nloc) {
            __builtin_amdgcn_fence(__ATOMIC_RELEASE, "agent");
            asm volatile("s_waitcnt vmcnt(0)" ::: "memory");
            const unsigned og = xb_add(&bar[XB_TOP], 1u);
            const unsigned tg = og / nx;
            if (og + 1u == (tg + 1u) * nx) xb_add(&bar[XB_TOPGEN], 1u);
            else XB_SPIN(xb_ld(&bar[XB_TOPGEN]) == tg, bar);
            __builtin_amdgcn_fence(__ATOMIC_ACQUIRE, "agent");
            xb_add(&bar[XB_XGEN(b.x)], 1u);
            asm volatile("s_waitcnt vmcnt(0)" ::: "memory");
        } else {
            XB_SPIN(xb_ld(&bar[XB_XGEN(b.x)]) == gen, bar);
            __builtin_amdgcn_fence(__ATOMIC_ACQUIRE, "agent");
            asm volatile("s_waitcnt vmcnt(0)" ::: "memory");
        }
    }
    __syncthreads();
}

struct Args {
    const float *x_p, *x_s, *c_p, *c_s, *cache; const int* ptab; const float *st_win, *st_conv, *w_ada, *b_ada, *n1g, *n2g, *w_in,
        *wck1, *wck2, *pek, *wcv1, *wcv2, *pev, *conv_w, *conv_b, *w_ap, *w_cp, *w_out, *w_m1, *w_m2, *nfg;
    float* out; unsigned char* ws; int ph_lo, ph_hi;
};
struct Frame { LAS unsigned char* lds; int tid, lane, wave, vcu, G; };
constexpr int LDS_BYTES = 147456;
constexpr int RING_BYTES = 131072, MISC_OFF = RING_BYTES + 320;

__device__ __forceinline__ const float* x_row(const Args& a, int r) { const int rr = r < MR ? r : MR - 1; return rr < MP ? a.x_p + (size_t)rr * D : a.x_s + (size_t)(rr - MP) * D; }

__device__ __forceinline__ void ph_ada(const Args& a, const Frame& F) {
    LAS float* sc = (LAS float*)F.lds;
    LAS float* red = sc + NBATCH * D;
    float* ada = (float*)(a.ws + WS_ADA);
    for (int i = F.tid; i < NBATCH * D; i += 512) { const int bi = i / D, k = i % D; const float v = bi < NBP ? a.c_p[bi * D + k] : a.c_s[(bi - NBP) * D + k]; sc[i] = v / (1.0f + __expf(-v)); }
    __syncthreads();
    const int j = F.tid & 63, sl = F.tid >> 6;
    for (int ch = F.vcu; ch < 6 * D / 64; ch += F.G) {
        float acc[NBATCH];
#pragma unroll
        for (int b = 0; b < NBATCH; ++b) acc[b] = 0.f;
        const float* w = a.w_ada + (size_t)(sl * 256) * (6 * D) + ch * 64 + j;
        for (int k = 0; k < 256; ++k) { const float wv = w[(size_t)k * (6 * D)];
#pragma unroll
            for (int b = 0; b < NBATCH; ++b) acc[b] += sc[b * D + sl * 256 + k] * wv; }
#pragma unroll
        for (int b = 0; b < NBATCH; ++b) red[(sl * NBATCH + b) * 64 + j] = acc[b];
        __syncthreads();
        for (int i = F.tid; i < NBATCH * 64; i += 512) { const int b = i >> 6, jj = i & 63; float s = 0.f;
#pragma unroll
            for (int q = 0; q < 8; ++q) s += red[(q * NBATCH + b) * 64 + jj];
            ada[(size_t)b * 6 * D + ch * 64 + jj] = s + a.b_ada[ch * 64 + jj]; }
        __syncthreads();
    }
    for (int kind = 0; kind < 2; ++kind) if (F.vcu == F.G - 1 - kind) {
        const float* pe = kind ? a.pev : a.pek; const float* w1 = kind ? a.wcv1 : a.wck1;
        const int f = F.tid & 127, q = F.tid >> 7; float s = 0.f;
        for (int jj = q * 1024; jj < (q + 1) * 1024; ++jj) s += pe[jj] * w1[(size_t)jj * 128 + f];
        red[q * 128 + f] = s; __syncthreads();
        if (F.tid < 128) ((float*)(a.ws + WS_PEB))[kind * 128 + f] = red[f] + red[128 + f] + red[256 + f] + red[384 + f];
        __syncthreads();
    }
}
__device__ __forceinline__ void tr_item(const float* W, int ldw, bf16* WT, int ldt, int k0, int ns, int nd, int nvalid, LAS float* scr, int lane) {
#pragma unroll 8
    for (int i = 0; i < 32; ++i) { const int kk = 2 * i + (lane >> 5), n = lane & 31; scr[kk * 33 + n] = n < nvalid ? W[(size_t)(k0 + kk) * ldw + ns + n] : 0.f; }
    asm volatile("s_waitcnt lgkmcnt(0)" ::: "memory");
    const int c = lane & 7;
#pragma unroll
    for (int j = 0; j < 4; ++j) { const int n = (lane >> 3) + 8 * j; const LAS float* s = scr + (8 * c) * 33 + n;
        u32x4 o; o.x = pk2(s[0 * 33], s[1 * 33]); o.y = pk2(s[2 * 33], s[3 * 33]); o.z = pk2(s[4 * 33], s[5 * 33]); o.w = pk2(s[6 * 33], s[7 * 33]);
        *(u32x4*)(WT + (size_t)(nd + n) * ldt + k0 + 8 * c) = o; }
    asm volatile("s_waitcnt lgkmcnt(0)" ::: "memory");
}
__device__ __forceinline__ void ph_transpose(const Args& a, const Frame& F) {
    LAS float* scr = (LAS float*)F.lds + F.wave * (64 * 33);
    const int gw = F.vcu * 8 + F.wave, NGW = F.G * 8;
    constexpr int I_IN = 32 * (NIN / 32), I_P = 32 * 64, I_O = 32 * 64, I_1 = 32 * 256, I_2 = 128 * 64, I_C = 32 * 4;
    constexpr int NIT = I_IN + 2 * I_P + I_O + I_1 + I_2 + 4 * I_C;
    bf16* win_t = (bf16*)(a.ws + WS_WIN_T); bf16* wp_t = (bf16*)(a.ws + WS_WP_T); bf16* wout_t = (bf16*)(a.ws + WS_WOUT_T);
    bf16* w1_t = (bf16*)(a.ws + WS_W1_T); bf16* w2_t = (bf16*)(a.ws + WS_W2_T); bf16* wc_t = (bf16*)(a.ws + WS_WC_T);
    for (int it = gw; it < NIT; it += NGW) {
        int r = it;
        if (r < I_IN) { const int nb = r % (NIN / 32), kb = r / (NIN / 32), nd = nb * 32; int ns, nv;
            if (nd < PC_U) { ns = nd; nv = 32; } else if (nd < PC_G) { ns = nd + 48; nv = 32; } else { ns = 5120 + (nd - PC_G); nv = 5168 - ns; nv = nv < 0 ? 0 : (nv > 32 ? 32 : nv); }
            tr_item(a.w_in, NIN_REAL, win_t, D, kb * 64, ns, nd, nv, scr, F.lane); continue; } r -= I_IN;
        if (r < I_P) { tr_item(a.w_ap, D, wp_t, 2 * D, (r / 64) * 64, (r % 64) * 32, (r % 64) * 32, 32, scr, F.lane); continue; } r -= I_P;
        if (r < I_P) { tr_item(a.w_cp, D, wp_t + D, 2 * D, (r / 64) * 64, (r % 64) * 32, (r % 64) * 32, 32, scr, F.lane); continue; } r -= I_P;
        if (r < I_O) { tr_item(a.w_out, D, wout_t, D, (r / 64) * 64, (r % 64) * 32, (r % 64) * 32, 32, scr, F.lane); continue; } r -= I_O;
        if (r < I_1) { tr_item(a.w_m1, DFF, w1_t, D, (r / 256) * 64, (r % 256) * 32, (r % 256) * 32, 32, scr, F.lane); continue; } r -= I_1;
        if (r < I_2) { tr_item(a.w_m2, D, w2_t, DFF, (r / 64) * 64, (r % 64) * 32, (r % 64) * 32, 32, scr, F.lane); continue; } r -= I_2;
        { const int q = r / I_C, rr = r % I_C, kind = q >> 1, s = q & 1;
          const float* w1 = (kind ? a.wcv1 : a.wck1) + (size_t)s * 2048 * 128;
          tr_item(w1, 128, wc_t + (size_t)(kind * 256 + s * 128) * 2048, 2048, (rr / 4) * 64, (rr % 4) * 32, (rr % 4) * 32, 32, scr, F.lane); }
    }
}
__device__ __forceinline__ void ph_cache_cvt(const Args& a, const Frame& F) {
    const int gw = F.vcu * 8 + F.wave, NGW = F.G * 8; bf16* ca = (bf16*)(a.ws + WS_CA);
    const int l = F.lane, kind = l >> 5, kvh = (l & 31) >> 3, d0 = (l & 7) * 16;
    for (int it = gw; it < NBS * PAST; it += NGW) { const int b = it >> 14, pos = it & (PAST - 1);
        const int page = a.ptab[b * NPAGES + (pos >> 7)];
        const float* src = a.cache + ((size_t)page * PAGE + (pos & 127)) * 2048 + l * 16;
        const f32x4 v0 = *(const f32x4*)src, v1 = *(const f32x4*)(src + 4), v2 = *(const f32x4*)(src + 8), v3 = *(const f32x4*)(src + 12);
        u32x4 o0 = {pk2(v0[0], v0[1]), pk2(v0[2], v0[3]), pk2(v1[0], v1[1]), pk2(v1[2], v1[3])}, o1 = {pk2(v2[0], v2[1]), pk2(v2[2], v2[3]), pk2(v3[0], v3[1]), pk2(v3[2], v3[3])};
        bf16* dst = ca + ((((size_t)kind * NBS + b) * NKV + kvh) * PAST + pos) * HD + d0;
        *(u32x4*)dst = o0; *(u32x4*)(dst + 8) = o1; }
}

template <int WHICH> __device__ __forceinline__ void ph_modnorm(const Args& a, const Frame& F) {
    const int gw = F.vcu * 8 + F.wave, NGW = F.G * 8; const float* ada = (const float*)(a.ws + WS_ADA);
    bf16* H = (bf16*)(a.ws + WS_H); const float* g = WHICH ? a.n2g : a.n1g;
    for (int r = gw; r < MPAD; r += NGW) {
        bf16* orow = H + (size_t)r * D;
        if (r >= MR) { for (int j = 0; j < 4; ++j) *(u32x4*)(orow + (F.lane + 64 * j) * 8) = (u32x4){0u, 0u, 0u, 0u}; continue; }
        const float* xr = WHICH ? (const float*)(a.ws + WS_X1) + (size_t)r * D : x_row(a, r);
        const int bi = batch_of(r); const float* sh = ada + (size_t)bi * 6 * D + (WHICH ? 3 * D : 0); const float* sc = sh + D;
        f32x4 v[8]; float ss = 0.f;
#pragma unroll
        for (int j = 0; j < 8; ++j) { v[j] = *(const f32x4*)(xr + (F.lane + 64 * j) * 4); ss += (v[j][0] * v[j][0] + v[j][1] * v[j][1]) + (v[j][2] * v[j][2] + v[j][3] * v[j][3]); }
        const float rstd = rsqrtf(wave_sum(ss) * (1.0f / D) + RMS_EPS);
#pragma unroll
        for (int j = 0; j < 8; ++j) { const int c = (F.lane + 64 * j) * 4; const f32x4 gg = *(const f32x4*)(g + c), s1 = *(const f32x4*)(sc + c), s0 = *(const f32x4*)(sh + c);
            f32x4 o;
#pragma unroll
            for (int e = 0; e < 4; ++e) o[e] = v[j][e] * rstd * gg[e] * (1.0f + s1[e]) + s0[e];
            *(u32x2*)(orow + c) = (u32x2){pk2(o[0], o[1]), pk2(o[2], o[3])}; }
    }
}

struct EpiIn {
    static constexpr bool PERM = true;
    bf16* P; bf16* KV6; float* out;
    __device__ __forceinline__ bool keep(const Unit&) const { return false; }
    __device__ __forceinline__ void operator()(AccT& acc, const Unit& u, int wr, int wc, int fr, int fq) const {
        const int row0 = u.pm * 256 + wr * 64 + fr, colt = u.pn * 256 + wc * 32 + 8 * fq;
#pragma unroll
        for (int ai = 0; ai < 2; ++ai)
#pragma unroll
            for (int m = 0; m < 4; ++m) { const int r = row0 + ai * 128 + m * 16;
#pragma unroll
                for (int bj = 0; bj < 2; ++bj) { const int c = colt + bj * 128; const f32x4 v0 = acc[ai][bj][m][0], v1 = acc[ai][bj][m][1];
                    u32x4 w; w.x = pg8::cvt_pk_bf16(v0[0], v0[1]); w.y = pg8::cvt_pk_bf16(v0[2], v0[3]); w.z = pg8::cvt_pk_bf16(v1[0], v1[1]); w.w = pg8::cvt_pk_bf16(v1[2], v1[3]);
                    *(u32x4*)(P + (size_t)r * NIN + c) = w;
                    if (u.pn >= 8 && u.pn < 20 && r < MR) {
                        const int cc = c - PC_KV, kind = cc >> 9, kvh = (cc >> 7) & 3, d = cc & 127;
                        if (r < MP) { const int b = r >> 11, s = r & 2047;
                            *(u32x4*)(KV6 + ((((size_t)kind * NBP + b) * NKV + kvh) * SEQ + s) * HD + d) = w;
                            if (u.pn < 16) { float* o = out + OUT_KVP + (size_t)r * 2048 + cc; *(f32x4*)o = v0; *(f32x4*)(o + 4) = v1; }
                            else if (s >= SEQ - 512) { float* o = out + OUT_WINP + ((size_t)b * 512 + (s - (SEQ - 512))) * 1024 + (c - PC_KWIN); *(f32x4*)o = v0; *(f32x4*)(o + 4) = v1; }
                        } else { const int rs = r - MP, b = rs >> 3, s = rs & 7;
                            if (u.pn < 16) { float* o = out + OUT_KVS + (size_t)rs * 2048 + cc; *(f32x4*)o = v0; *(f32x4*)(o + 4) = v1; }
                            else { float* o = out + OUT_WINS + ((size_t)b * 512 + 504 + s) * 1024 + (c - PC_KWIN); *(f32x4*)o = v0; *(f32x4*)(o + 4) = v1; }
                        }
                    }
                } }
    }
};
struct EpiF32 {
    static constexpr bool PERM = false;
    float* C; int ldc;
    __device__ __forceinline__ bool keep(const Unit&) const { return false; }
    __device__ __forceinline__ void operator()(AccT& acc, const Unit& u, int wr, int wc, int fr, int fq) const {
        const int row0 = u.pm * 256 + wr * 64 + fr, col0 = u.pn * 256 + wc * 32 + 4 * fq;
#pragma unroll
        for (int ai = 0; ai < 2; ++ai)
#pragma unroll
            for (int m = 0; m < 4; ++m) { float* rowp = C + (size_t)(row0 + ai * 128 + m * 16) * ldc + col0;
#pragma unroll
                for (int bj = 0; bj < 2; ++bj)
#pragma unroll
                    for (int n = 0; n < 2; ++n) *(f32x4*)(rowp + bj * 128 + n * 16) = acc[ai][bj][m][n]; }
    }
};
struct EpiProj {
    static constexpr bool PERM = true;
    const bf16* P; bf16* MIX;
    __device__ __forceinline__ bool keep(const Unit& u) const { return u.part == 0; }
    __device__ __forceinline__ void operator()(AccT& acc, const Unit& u, int wr, int wc, int fr, int fq) const {
        const int row0 = u.pm * 256 + wr * 64 + fr, colt = u.pn * 256 + wc * 32 + 8 * fq;
#pragma unroll
        for (int ai = 0; ai < 2; ++ai)
#pragma unroll
            for (int m = 0; m < 4; ++m) { const int r = row0 + ai * 128 + m * 16;
#pragma unroll
                for (int bj = 0; bj < 2; ++bj) { const int c = colt + bj * 128;
                    const u32x4 mc = *(const u32x4*)(P + (size_t)r * NIN + PC_MC + c);
                    float sc[8];
#pragma unroll
                    for (int e = 0; e < 4; ++e) { sc[2 * e] = sigmoidf_(lo_bf(mc[e])); sc[2 * e + 1] = sigmoidf_(hi_bf(mc[e])); }
                    if (u.part == 0) {
                        const u32x4 ma = *(const u32x4*)(P + (size_t)r * NIN + PC_MA + c);
#pragma unroll
                        for (int e = 0; e < 4; ++e) { const float s0 = sigmoidf_(lo_bf(ma[e])) / sc[2 * e], s1 = sigmoidf_(hi_bf(ma[e])) / sc[2 * e + 1];
                            acc[ai][bj][m][e >> 1][(e & 1) * 2] *= s0; acc[ai][bj][m][e >> 1][(e & 1) * 2 + 1] *= s1; }
                    } else {
                        const f32x4 v0 = acc[ai][bj][m][0], v1 = acc[ai][bj][m][1];
                        u32x4 w; w.x = pg8::cvt_pk_bf16(v0[0] * sc[0], v0[1] * sc[1]); w.y = pg8::cvt_pk_bf16(v0[2] * sc[2], v0[3] * sc[3]);
                        w.z = pg8::cvt_pk_bf16(v1[0] * sc[4], v1[1] * sc[5]); w.w = pg8::cvt_pk_bf16(v1[2] * sc[6], v1[3] * sc[7]);
                        *(u32x4*)(MIX + (size_t)r * D + c) = w;
                    }
                } }
    }
};
template <int WHICH> struct EpiRes {
    static constexpr bool PERM = false;
    Args a;
    __device__ __forceinline__ bool keep(const Unit&) const { return false; }
    __device__ __forceinline__ void operator()(AccT& acc, const Unit& u, int wr, int wc, int fr, int fq) const {
        const int row0 = u.pm * 256 + wr * 64 + fr, col0 = u.pn * 256 + wc * 32 + 4 * fq;
        const float* ada = (const float*)(a.ws + WS_ADA); float* O = (float*)(a.ws + (WHICH ? WS_X2 : WS_X1));
#pragma unroll
        for (int ai = 0; ai < 2; ++ai)
#pragma unroll
            for (int m = 0; m < 4; ++m) { const int r = row0 + ai * 128 + m * 16;
                const float* base = WHICH ? (const float*)(a.ws + WS_X1) + (size_t)r * D : x_row(a, r);
                const float* gate = ada + (size_t)batch_of(r) * 6 * D + (WHICH ? 5 * D : 2 * D);
#pragma unroll
                for (int bj = 0; bj < 2; ++bj)
#pragma unroll
                    for (int n = 0; n < 2; ++n) { const int c = col0 + bj * 128 + n * 16; const f32x4 bs = *(const f32x4*)(base + c), gg = *(const f32x4*)(gate + c);
                        *(f32x4*)(O + (size_t)r * D + c) = bs + gg * acc[ai][bj][m][n]; } }
    }
};
struct EpiRelu2 {
    static constexpr bool PERM = true;
    bf16* HM;
    __device__ __forceinline__ bool keep(const Unit&) const { return false; }
    __device__ __forceinline__ void operator()(AccT& acc, const Unit& u, int wr, int wc, int fr, int fq) const {
        const int row0 = u.pm * 256 + wr * 64 + fr, colt = u.pn * 256 + wc * 32 + 8 * fq;
#pragma unroll
        for (int ai = 0; ai < 2; ++ai)
#pragma unroll
            for (int m = 0; m < 4; ++m) { const int r = row0 + ai * 128 + m * 16;
#pragma unroll
                for (int bj = 0; bj < 2; ++bj) { const int c = colt + bj * 128; f32x4 v0 = acc[ai][bj][m][0], v1 = acc[ai][bj][m][1];
#pragma unroll
                    for (int e = 0; e < 4; ++e) { const float p = fmaxf(v0[e], 0.f), q = fmaxf(v1[e], 0.f); v0[e] = p * p; v1[e] = q * q; }
                    u32x4 w; w.x = pg8::cvt_pk_bf16(v0[0], v0[1]); w.y = pg8::cvt_pk_bf16(v0[2], v0[3]); w.z = pg8::cvt_pk_bf16(v1[0], v1[1]); w.w = pg8::cvt_pk_bf16(v1[2], v1[3]);
                    *(u32x4*)(HM + (size_t)r * DFF + c) = w; } }
    }
};

__device__ __forceinline__ float gelu_tanh(float x) { const float u = 0.7978845608028654f * (x + 0.044715f * x * x * x); return 0.5f * x * (1.0f + tanhf(u)); }
template <int SAMPLE> __device__ __forceinline__ void ph_cmp_finish(const Args& a, const Frame& F) {
    constexpr int NB = SAMPLE ? NBS : NBP, NCH = SAMPLE ? 1024 : 128, NC = NCH - 1;
    const float* part = (const float*)(a.ws + (SAMPLE ? WS_PARTS : WS_PARTP)); float* kc = (float*)(a.ws + (SAMPLE ? WS_KCS : WS_KCP));
    const float* peb = (const float*)(a.ws + WS_PEB);
    LAS float* gl = (LAS float*)F.lds + F.wave * 128;
    const int gw = F.vcu * 8 + F.wave, NGW = F.G * 8;
    for (int it = gw; it < 2 * NB * NKV * NC; it += NGW) {
        const int c = it % NC, q = it / NC, kvh = q % NKV, b = (q / NKV) % NB, kind = q / (NKV * NB);
        const size_t row = ((size_t)b * NKV + kvh) * NCH + c;
        const float* w2 = kind ? a.wcv2 : a.wck2;
#pragma unroll
        for (int j = 0; j < 2; ++j) { const int f = F.lane + 64 * j;
            const float h = part[row * 512 + kind * 256 + f] + part[(row + 1) * 512 + kind * 256 + 128 + f] + peb[kind * 128 + f];
            gl[f] = gelu_tanh(h); }
        asm volatile("s_waitcnt lgkmcnt(0)" ::: "memory");
        float o0 = 0.f, o1 = 0.f;
        for (int f = 0; f < 128; ++f) { const float gv = gl[f]; o0 += gv * w2[f * 128 + F.lane]; o1 += gv * w2[f * 128 + 64 + F.lane]; }
        float* dst = kc + ((((size_t)kind * NB + b) * NKV + kvh) * NCH + c) * HD;
        dst[F.lane] = o0; dst[64 + F.lane] = o1;
        asm volatile("s_waitcnt lgkmcnt(0)" ::: "memory");
    }
}

struct WaveAtt { LAS float* qs; LAS float* pb; float o[4][2]; float m[4]; float l[4]; };
__device__ __forceinline__ void att_load_q(const bf16* P, int r, int kvh, WaveAtt& W, int lane) {
    const bf16* q = P + (size_t)r * NIN + PC_Q + kvh * 512;
#pragma unroll
    for (int j = 0; j < 4; ++j) { const unsigned w = *(const unsigned*)(q + (lane + 64 * j) * 2); W.qs[(lane + 64 * j) * 2] = lo_bf(w); W.qs[(lane + 64 * j) * 2 + 1] = hi_bf(w); }
    asm volatile("s_waitcnt lgkmcnt(0)" ::: "memory");
}
__device__ __forceinline__ void att_init(WaveAtt& W) {
#pragma unroll
    for (int g = 0; g < 4; ++g) { W.o[g][0] = 0.f; W.o[g][1] = 0.f; W.m[g] = -1e30f; W.l[g] = 0.f; }
}
template <class T> __device__ __forceinline__ void att_dot4(const T* krow, const WaveAtt& W, float (&s)[4]) {
    s[0] = s[1] = s[2] = s[3] = 0.f;
#pragma unroll 2
    for (int d = 0; d < 128; d += 8) {
        float kv[8];
        if constexpr (sizeof(T) == 4) { const f32x4 a0 = *(const f32x4*)((const float*)krow + d), a1 = *(const f32x4*)((const float*)krow + d + 4);
            kv[0] = a0[0]; kv[1] = a0[1]; kv[2] = a0[2]; kv[3] = a0[3]; kv[4] = a1[0]; kv[5] = a1[1]; kv[6] = a1[2]; kv[7] = a1[3]; }
        else { const u32x4 a0 = *(const u32x4*)((const bf16*)krow + d);
#pragma unroll
            for (int e = 0; e < 4; ++e) { kv[2 * e] = lo_bf(a0[e]); kv[2 * e + 1] = hi_bf(a0[e]); } }
#pragma unroll
        for (int g = 0; g < 4; ++g) { const f32x4 q0 = *(const LAS f32x4*)(W.qs + g * 128 + d), q1 = *(const LAS f32x4*)(W.qs + g * 128 + d + 4);
            s[g] += (kv[0] * q0[0] + kv[1] * q0[1]) + (kv[2] * q0[2] + kv[3] * q0[3]) + (kv[4] * q1[0] + kv[5] * q1[1]) + (kv[6] * q1[2] + kv[7] * q1[3]); }
    }
}
template <class T> __device__ __forceinline__ void att_pv(const T* V, size_t vstride, int nk, WaveAtt& W, int lane) {
#pragma unroll 4
    for (int j = 0; j < nk; ++j) { float v0, v1;
        if constexpr (sizeof(T) == 4) { const f32x2 v = *(const f32x2*)((const float*)V + (size_t)j * vstride + 2 * lane); v0 = v[0]; v1 = v[1]; }
        else { const unsigned w = *(const unsigned*)((const bf16*)V + (size_t)j * vstride + 2 * lane); v0 = lo_bf(w); v1 = hi_bf(w); }
        const f32x4 p = *(const LAS f32x4*)(W.pb + j * 4);
#pragma unroll
        for (int g = 0; g < 4; ++g) { W.o[g][0] += p[g] * v0; W.o[g][1] += p[g] * v1; } }
}
template <class T> __device__ __forceinline__ void att_segment(const T* K, size_t kstride, const T* V, size_t vstride, int nk, bool valid, WaveAtt& W, int lane) {
    float s[4];
    if (valid) att_dot4<T>(K + (size_t)lane * kstride, W, s); else { s[0] = s[1] = s[2] = s[3] = 0.f; }
    f32x4 p;
#pragma unroll
    for (int g = 0; g < 4; ++g) { const float sv = valid ? s[g] * SCALE : -__builtin_inff();
        const float mx = wave_max(sv), mn = fmaxf(W.m[g], mx), alpha = __expf(W.m[g] - mn), pv = __expf(sv - mn);
        W.l[g] = W.l[g] * alpha + wave_sum(pv); W.o[g][0] *= alpha; W.o[g][1] *= alpha; W.m[g] = mn; p[g] = pv; }
    *(LAS f32x4*)(W.pb + lane * 4) = p;
    asm volatile("s_waitcnt lgkmcnt(0)" ::: "memory");
    att_pv<T>(V, vstride, nk, W, lane);
    asm volatile("s_waitcnt lgkmcnt(0)" ::: "memory");
}
__device__ __forceinline__ void att_store(float* O, int r, int kvh, const WaveAtt& W, int lane, bool normalise) {
#pragma unroll
    for (int g = 0; g < 4; ++g) { const float inv = normalise ? (W.l[g] > 0.f ? 1.0f / W.l[g] : 0.f) : 1.0f;
        *(f32x2*)(O + (size_t)r * D + (kvh * 4 + g) * 128 + 2 * lane) = (f32x2){W.o[g][0] * inv, W.o[g][1] * inv}; }
}

template <int SAMPLE> __device__ __forceinline__ void ph_cmp_attend(const Args& a, const Frame& F) {
    constexpr int NSEG = SAMPLE ? 16 : 2, NCH = SAMPLE ? 1024 : 128, NC = NCH - 1, NB = SAMPLE ? NBS : NBP, SQ = SAMPLE ? DSQ : SEQ;
    const bf16* P = (const bf16*)(a.ws + WS_P); const float* kcb = (const float*)(a.ws + (SAMPLE ? WS_KCS : WS_KCP));
    float* OC = (float*)(a.ws + WS_OCMP);
    LAS float* wl = (LAS float*)F.lds + F.wave * 4096;
    WaveAtt W; W.qs = wl; W.pb = wl + 512; LAS float* pg = wl + 768 + 4; LAS float* scl = wl + 768 + 1040;
    const int gw = F.vcu * 8 + F.wave, NGW = F.G * 8, lane = F.lane;
#pragma unroll 1
    for (int it = gw; it < NB * NKV * SQ; it += NGW) {
        const int s = it % SQ, kvh = (it / SQ) % NKV, b = it / (SQ * NKV);
        const int r = SAMPLE ? MP + b * DSQ + s : b * SEQ + s, pos = SAMPLE ? PAST + s : s;
        const int nvis = pos >= 31 ? ((pos - 31) / 16 + 1 < NC ? (pos - 31) / 16 + 1 : NC) : 0;
        att_load_q(P, r, kvh, W, lane);
        const float* Kc = kcb + (((size_t)0 * NB + b) * NKV + kvh) * NCH * HD; const float* Vc = kcb + (((size_t)1 * NB + b) * NKV + kvh) * NCH * HD;
        float mx[4] = {-1e30f, -1e30f, -1e30f, -1e30f}, ls[4] = {0.f, 0.f, 0.f, 0.f};
        const int nseg = (nvis + 63) >> 6;
#pragma unroll 1
        for (int sg = 0; sg < nseg; ++sg) { const int c = sg * 64 + lane; const bool valid = c < nvis; float t[4];
            if (valid) att_dot4<float>(Kc + (size_t)c * HD, W, t); else { t[0] = t[1] = t[2] = t[3] = 0.f; }
#pragma unroll
            for (int g = 0; g < 4; ++g) { const float sv = valid ? t[g] * SCALE : -__builtin_inff(); const float m2 = fmaxf(mx[g], wave_max(sv));
                ls[g] = ls[g] * __expf(mx[g] - m2) + wave_sum(__expf(sv - m2)); mx[g] = m2; } }
#pragma unroll
        for (int g = 0; g < 4; ++g) ls[g] = ls[g] > 0.f ? 1.0f / ls[g] : 0.f;
        att_init(W);
        for (int i = lane; i < NSEG * 64; i += 64) pg[i] = 0.f;
#pragma unroll 1
        for (int sg = 0; sg < nseg; ++sg) { const int c = sg * 64 + lane; const bool valid = c < nvis; float t[4];
            if (valid) att_dot4<float>(Kc + (size_t)c * HD, W, t); else { t[0] = t[1] = t[2] = t[3] = 0.f; }
            f32x4 p; float pgs = 0.f;
#pragma unroll
            for (int g = 0; g < 4; ++g) { p[g] = valid ? __expf(t[g] * SCALE - mx[g]) * ls[g] : 0.f; pgs += p[g]; }
            pg[c] = pgs;
            const int base = sg * 64; int nk = nvis - base; nk = nk > 64 ? 64 : nk;
            *(LAS f32x4*)(W.pb + lane * 4) = p; asm volatile("s_waitcnt lgkmcnt(0)" ::: "memory");
            att_pv<float>(Vc + (size_t)base * HD, HD, nk, W, lane); asm volatile("s_waitcnt lgkmcnt(0)" ::: "memory"); }
        att_store(OC, r, kvh, W, lane, false);
        if (lane == 0) { pg[-1] = 0.f; pg[NSEG * 64] = 0.f; }
        asm volatile("s_waitcnt lgkmcnt(0)" ::: "memory");
        const int cur = pos >> 6;
        if constexpr (!SAMPLE) {
            float val = -__builtin_inff();
            if (lane < NSP) { const int n = lane; const float scv = pg[4 * n - 1] + 2.0f * (pg[4 * n] + pg[4 * n + 1] + pg[4 * n + 2]) + pg[4 * n + 3];
                const bool vld = n <= cur, forced = (n == 0) || (n > cur - 2); val = vld ? (forced ? __builtin_inff() : scv) : -__builtin_inff(); }
            int rank = 0;
            for (int k = 0; k < NSP; ++k) { const float vk = __shfl(val, k); rank += (vk > val || (vk == val && k < lane)) ? 1 : 0; }
            const bool sel = lane < NSP && rank < 16 && val > -__builtin_inff();
            const unsigned long long bm = __ballot(sel);
            if (lane == 0) ((unsigned*)(a.ws + WS_SELP))[((size_t)b * NKV + kvh) * SEQ + s] = (unsigned)bm;
        } else {
            for (int n = lane; n < 256; n += 64) scl[n] = (n >= 1 && n <= 254) ? pg[4 * n - 1] + 2.0f * (pg[4 * n] + pg[4 * n + 1] + pg[4 * n + 2]) + pg[4 * n + 3] : -__builtin_inff();
            asm volatile("s_waitcnt lgkmcnt(0)" ::: "memory");
            unsigned* selw = (unsigned*)(a.ws + WS_SELS) + (((size_t)b * NKV + kvh) * DSQ + s) * 16;
#pragma unroll
            for (int i = 0; i < 4; ++i) { const int n = lane + 64 * i; const float val = scl[n]; int rank = 0;
#pragma unroll 2
                for (int k = 1; k <= 254; ++k) { const float vk = scl[k]; rank += (vk > val || (vk == val && k < n)) ? 1 : 0; }
                const bool sel = (n >= 1 && n <= 254 && rank < 13) || n == 0 || n == 255;
                const unsigned long long bm = __ballot(sel);
                if (lane == 0) { selw[2 * i] = (unsigned)bm; selw[2 * i + 1] = (unsigned)(bm >> 32); } }
            if (lane == 0) selw[8] = 1u;
        }
        asm volatile("s_waitcnt lgkmcnt(0)" ::: "memory");
    }
}
template <int SAMPLE> __device__ __forceinline__ void ph_slc_attend(const Args& a, const Frame& F) {
    constexpr int NB = SAMPLE ? NBS : NBP, SQ = SAMPLE ? DSQ : SEQ;
    const bf16* P = (const bf16*)(a.ws + WS_P); const bf16* KV6 = (const bf16*)(a.ws + WS_KV6); float* OS = (float*)(a.ws + WS_OSLC);
    LAS float* wl = (LAS float*)F.lds + F.wave * 1024; WaveAtt W; W.qs = wl; W.pb = wl + 512;
    const int gw = F.vcu * 8 + F.wave, NGW = F.G * 8, lane = F.lane;
#pragma unroll 1
    for (int it = gw; it < NB * NKV * SQ; it += NGW) {
        const int s = it % SQ, kvh = (it / SQ) % NKV, b = it / (SQ * NKV);
        const int r = SAMPLE ? MP + b * DSQ + s : b * SEQ + s;
        att_load_q(P, r, kvh, W, lane); att_init(W);
        if constexpr (!SAMPLE) {
            const unsigned mask = ((const unsigned*)(a.ws + WS_SELP))[((size_t)b * NKV + kvh) * SEQ + s];
            const bf16* Kb = KV6 + (((size_t)2 * NBP + b) * NKV + kvh) * SEQ * HD; const bf16* Vb = KV6 + (((size_t)3 * NBP + b) * NKV + kvh) * SEQ * HD;
#pragma unroll 1
            for (int n = 0; n < NSP; ++n) if ((mask >> n) & 1u) { const int k0 = n * 64; int nk = s - k0 + 1; nk = nk > 64 ? 64 : nk; if (nk <= 0) continue;
                att_segment<bf16>(Kb + (size_t)k0 * HD, HD, Vb + (size_t)k0 * HD, HD, nk, lane < nk, W, lane); }
        } else {
            const unsigned* selw = (const unsigned*)(a.ws + WS_SELS) + (((size_t)b * NKV + kvh) * DSQ + s) * 16;
#pragma unroll 1
            for (int n = 0; n < 256; ++n) if ((selw[n >> 5] >> (n & 31)) & 1u) {
                const int page = a.ptab[b * NPAGES + (n >> 1)];
                const float* base = a.cache + ((size_t)page * PAGE + (n & 1) * 64) * 2048 + kvh * HD;
                att_segment<float>(base + 2 * 512, 2048, base + 3 * 512, 2048, 64, true, W, lane); }
            const bf16* nb = P + (size_t)(MP + b * DSQ) * NIN + PC_KV + kvh * HD;
            att_segment<bf16>(nb + 2 * 512, NIN, nb + 3 * 512, NIN, s + 1, lane <= s, W, lane);
        }
        att_store(OS, r, kvh, W, lane, true);
    }
}
template <int SAMPLE> __device__ __forceinline__ void ph_win_attend(const Args& a, const Frame& F) {
    constexpr int NB = SAMPLE ? NBS : NBP, SQ = SAMPLE ? DSQ : SEQ;
    const bf16* P = (const bf16*)(a.ws + WS_P); const bf16* KV6 = (const bf16*)(a.ws + WS_KV6); float* OW = (float*)(a.ws + WS_OWIN);
    LAS float* wl = (LAS float*)F.lds + F.wave * 1024; WaveAtt W; W.qs = wl; W.pb = wl + 512;
    const int gw = F.vcu * 8 + F.wave, NGW = F.G * 8, lane = F.lane;
#pragma unroll 1
    for (int it = gw; it < NB * NKV * SQ; it += NGW) {
        const int s = it % SQ, kvh = (it / SQ) % NKV, b = it / (SQ * NKV);
        const int r = SAMPLE ? MP + b * DSQ + s : b * SEQ + s;
        att_load_q(P, r, kvh, W, lane); att_init(W);
        if constexpr (!SAMPLE) {
            const bf16* Kb = KV6 + (((size_t)4 * NBP + b) * NKV + kvh) * SEQ * HD; const bf16* Vb = KV6 + (((size_t)5 * NBP + b) * NKV + kvh) * SEQ * HD;
            const int lo = s - 511 > 0 ? s - 511 : 0;
#pragma unroll 1
            for (int k0 = (lo >> 6) << 6; k0 <= s; k0 += 64) { int nk = s - k0 + 1; nk = nk > 64 ? 64 : nk; const int kp = k0 + lane;
                att_segment<bf16>(Kb + (size_t)k0 * HD, HD, Vb + (size_t)k0 * HD, HD, nk, kp >= lo && kp <= s, W, lane); }
        } else {
            const float* st = a.st_win + (size_t)b * 512 * 1024 + kvh * HD;
#pragma unroll 1
            for (int i0 = 0; i0 < 512; i0 += 64) { const int i = i0 + lane;
                att_segment<float>(st + (size_t)i0 * 1024, 1024, st + (size_t)i0 * 1024 + 512, 1024, 64, i > s, W, lane); }
            const bf16* nb = P + (size_t)(MP + b * DSQ) * NIN + kvh * HD;
            att_segment<bf16>(nb + PC_KWIN, NIN, nb + PC_VWIN, NIN, s + 1, lane <= s, W, lane);
        }
        att_store(OW, r, kvh, W, lane, true);
    }
    if constexpr (SAMPLE) {
        float* ow = a.out + OUT_WINS;
        for (size_t i = (size_t)(F.vcu * 512 + F.tid); i < (size_t)NBS * 504 * 256; i += (size_t)F.G * 512) { const size_t b = i / (504 * 256), rem = i % (504 * 256);
            *(f32x4*)(ow + b * 512 * 1024 + rem * 4) = *(const f32x4*)(a.st_win + b * 512 * 1024 + 8 * 1024 + rem * 4); }
    }
}

__device__ __forceinline__ void ph_combine(const Args& a, const Frame& F) {
    const bf16* P = (const bf16*)(a.ws + WS_P); bf16* A2 = (bf16*)(a.ws + WS_A2);
    const float* OC = (const float*)(a.ws + WS_OCMP); const float* OS = (const float*)(a.ws + WS_OSLC); const float* OW = (const float*)(a.ws + WS_OWIN);
    const int gw = F.vcu * 8 + F.wave, NGW = F.G * 8, lane = F.lane;
    for (int r = gw; r < MPAD; r += NGW) {
        bf16* orow = A2 + (size_t)r * 2 * D;
        if (r >= MR) { for (int j = 0; j < 8; ++j) *(u32x4*)(orow + (lane + 64 * j) * 8) = (u32x4){0u, 0u, 0u, 0u}; continue; }
        const bf16* pr = P + (size_t)r * NIN;
#pragma unroll
        for (int j = 0; j < 8; ++j) { const int c = (lane + 64 * j) * 4, h = c >> 7;
            const float g0 = sigmoidf_(bf2f(pr[PC_G + h])), g1 = sigmoidf_(bf2f(pr[PC_G + 16 + h])), g2 = sigmoidf_(bf2f(pr[PC_G + 32 + h]));
            const f32x4 v = g0 * *(const f32x4*)(OC + (size_t)r * D + c) + g1 * *(const f32x4*)(OS + (size_t)r * D + c) + g2 * *(const f32x4*)(OW + (size_t)r * D + c);
            *(u32x2*)(orow + c) = (u32x2){pk2(v[0], v[1]), pk2(v[2], v[3])}; }
        const bool smp = r >= MP; const int s = smp ? (r - MP) & 7 : r & 2047, b = smp ? (r - MP) >> 3 : r >> 11;
#pragma unroll
        for (int j = 0; j < 8; ++j) { const int c = (lane + 64 * j) * 4; f32x4 u[3];
#pragma unroll
            for (int t = 0; t < 3; ++t) { const int ss = s - 2 + t;
                if (ss >= 0) { const bf16* q = pr - (size_t)(2 - t) * NIN; const u32x2 cg = *(const u32x2*)(q + PC_C + c), ui = *(const u32x2*)(q + PC_U + c);
                    u[t] = (f32x4){lo_bf(cg[0]) * lo_bf(ui[0]), hi_bf(cg[0]) * hi_bf(ui[0]), lo_bf(cg[1]) * lo_bf(ui[1]), hi_bf(cg[1]) * hi_bf(ui[1])}; }
                else if (smp) u[t] = *(const f32x4*)(a.st_conv + ((size_t)b * 2 + (ss + 2)) * D + c);
                else u[t] = (f32x4){0.f, 0.f, 0.f, 0.f}; }
            const f32x4 w0 = *(const f32x4*)(a.conv_w + c), w1 = *(const f32x4*)(a.conv_w + D + c), w2 = *(const f32x4*)(a.conv_w + 2 * D + c), cb = *(const f32x4*)(a.conv_b + c);
            const u32x2 bg = *(const u32x2*)(pr + PC_B + c);
            const f32x4 y = cb + w0 * u[0] + w1 * u[1] + w2 * u[2];
            const f32x4 z = {lo_bf(bg[0]) * y[0], hi_bf(bg[0]) * y[1], lo_bf(bg[1]) * y[2], hi_bf(bg[1]) * y[3]};
            *(u32x2*)(orow + D + c) = (u32x2){pk2(z[0], z[1]), pk2(z[2], z[3])};
            const int SL = smp ? DSQ : SEQ;
            if (s >= SL - 2) { float* o = a.out + (smp ? OUT_CONVS : OUT_CONVP) + ((size_t)b * 2 + (s - (SL - 2))) * D + c; *(f32x4*)o = u[2]; } }
    }
}
__device__ __forceinline__ void ph_final(const Args& a, const Frame& F) {
    const int gw = F.vcu * 8 + F.wave, NGW = F.G * 8; const float* X2 = (const float*)(a.ws + WS_X2);
    for (int r = gw; r < MR; r += NGW) {
        const float* xr = X2 + (size_t)r * D; float* o = a.out + (r < MP ? OUT_YP + (size_t)r * D : OUT_YS + (size_t)(r - MP) * D);
        f32x4 v[8]; float ss = 0.f;
#pragma unroll
        for (int j = 0; j < 8; ++j) { v[j] = *(const f32x4*)(xr + (F.lane + 64 * j) * 4); ss += (v[j][0] * v[j][0] + v[j][1] * v[j][1]) + (v[j][2] * v[j][2] + v[j][3] * v[j][3]); }
        const float rstd = rsqrtf(wave_sum(ss) * (1.0f / D) + RMS_EPS);
#pragma unroll
        for (int j = 0; j < 8; ++j) { const int c = (F.lane + 64 * j) * 4; *(f32x4*)(o + c) = v[j] * rstd * *(const f32x4*)(a.nfg + c); }
    }
}

constexpr int N_PHASES = 15;
__global__ void __launch_bounds__(512, 2) nsa_fwd(Args a) {
    extern __shared__ __attribute__((aligned(16))) unsigned char lds_raw[];
    Frame F; F.lds = (LAS unsigned char*)lds_raw; F.tid = threadIdx.x; F.lane = F.tid & 63; F.wave = __builtin_amdgcn_readfirstlane(F.tid >> 6);
    F.G = gridDim.x; { const int bx = blockIdx.x; F.vcu = (F.G % 8 == 0) ? (bx % 8) * (F.G / 8) + bx / 8 : bx; }
    volatile LAS unsigned* MISC = (volatile LAS unsigned*)(F.lds + MISC_OFF);
    for (int u = F.tid; u < (LDS_BYTES - RING_BYTES) / 4; u += 512) ((LAS unsigned*)(F.lds + RING_BYTES))[u] = 0u;
    __syncthreads();
#if MK_PER_PHASE
#define GRID_BAR() do { } while (0)
#else
    XcdBarrier bar = xcd_barrier_post((unsigned*)(a.ws + WS_CTL) + 4096, MISC + 8);
#define GRID_BAR() xcd_barrier(bar)
#endif
    (void)MISC;
    const int lo = a.ph_lo, hi = a.ph_hi;
#ifdef DBG_ONLY
#define IN(k) ((k) == DBG_ONLY && lo <= (k) && (k) < hi)
#else
#define IN(k) (lo <= (k) && (k) < hi)
#endif
#define SEAM(k) do { if (IN(k) && IN((k) + 1)) GRID_BAR(); } while (0)
    if (IN(0)) { ph_ada(a, F); } SEAM(0);
    if (IN(1)) { ph_transpose(a, F); ph_cache_cvt(a, F); ph_modnorm<0>(a, F); } SEAM(1);
    if (IN(2)) {
        { pg8::Prob g{(const char*)(a.ws + WS_H), (const char*)(a.ws + WS_WIN_T), (size_t)256 * D * 2, 0, 0, (size_t)256 * D * 2, 0, D * 2, D * 2, D / 64};
          pg8::Order S; S.init(MPAD, NIN, F.G, (int)blockIdx.x, 1);
          EpiIn E{(bf16*)(a.ws + WS_P), (bf16*)(a.ws + WS_KV6), a.out};
          pg8::gemm_phase<EpiIn>(F.lds, g, S, E); }
        {
          pg8::Prob g{(const char*)(a.ws + WS_CA), (const char*)(a.ws + WS_WC_T), (size_t)256 * 2048 * 2, (size_t)NBS * NKV * PAST * HD * 2, 0, (size_t)256 * 2048 * 2, 0, 2048 * 2, 2048 * 2, 2048 / 64};
          pg8::Order S; S.init(32768, 512, F.G, (int)blockIdx.x, 1);
          EpiF32 E{(float*)(a.ws + WS_PARTS), 512};
          pg8::gemm_phase<EpiF32>(F.lds, g, S, E); }
    } SEAM(2);
    if (IN(3)) {
        { pg8::Prob g{(const char*)(a.ws + WS_KV6), (const char*)(a.ws + WS_WC_T), (size_t)256 * 2048 * 2, (size_t)NBP * NKV * SEQ * HD * 2, 0, (size_t)256 * 2048 * 2, 0, 2048 * 2, 2048 * 2, 2048 / 64};
          pg8::Order S; S.init(2048, 512, F.G, (int)blockIdx.x, 1);
          EpiF32 E{(float*)(a.ws + WS_PARTP), 512};
          pg8::gemm_phase<EpiF32>(F.lds, g, S, E); }
        ph_cmp_finish<1>(a, F);
        ph_win_attend<0>(a, F); ph_win_attend<1>(a, F);
    } SEAM(3);
    if (IN(4)) { ph_cmp_finish<0>(a, F); ph_cmp_attend<1>(a, F); } SEAM(4);
    if (IN(5)) { ph_cmp_attend<0>(a, F); ph_slc_attend<1>(a, F); } SEAM(5);
    if (IN(6)) { ph_slc_attend<0>(a, F); } SEAM(6);
    if (IN(7)) { ph_combine(a, F); } SEAM(7);
    if (IN(8)) {
        pg8::Prob g{(const char*)(a.ws + WS_A2), (const char*)(a.ws + WS_WP_T), (size_t)256 * 2 * D * 2, 0, (size_t)D * 2, (size_t)256 * 2 * D * 2, (size_t)D * 2, 2 * D * 2, 2 * D * 2, D / 64};
        pg8::Order S; S.init(MPAD, D, F.G, (int)blockIdx.x, 2);
        EpiProj E{(const bf16*)(a.ws + WS_P), (bf16*)(a.ws + WS_MIX)};
        pg8::gemm_phase<EpiProj>(F.lds, g, S, E);
    } SEAM(8);
    if (IN(9)) {
        pg8::Prob g{(const char*)(a.ws + WS_MIX), (const char*)(a.ws + WS_WOUT_T), (size_t)256 * D * 2, 0, 0, (size_t)256 * D * 2, 0, D * 2, D * 2, D / 64};
        pg8::Order S; S.init(MPAD, D, F.G, (int)blockIdx.x, 1);
        EpiRes<0> E{a};
        pg8::gemm_phase<EpiRes<0>>(F.lds, g, S, E);
    } SEAM(9);
    if (IN(10)) { ph_modnorm<1>(a, F); } SEAM(10);
    if (IN(11)) {
        pg8::Prob g{(const char*)(a.ws + WS_H), (const char*)(a.ws + WS_W1_T), (size_t)256 * D * 2, 0, 0, (size_t)256 * D * 2, 0, D * 2, D * 2, D / 64};
        pg8::Order S; S.init(MPAD, DFF, F.G, (int)blockIdx.x, 1);
        EpiRelu2 E{(bf16*)(a.ws + WS_HM)};
        pg8::gemm_phase<EpiRelu2>(F.lds, g, S, E);
    } SEAM(11);
    if (IN(12)) {
        pg8::Prob g{(const char*)(a.ws + WS_HM), (const char*)(a.ws + WS_W2_T), (size_t)256 * DFF * 2, 0, 0, (size_t)256 * DFF * 2, 0, DFF * 2, DFF * 2, DFF / 64};
        pg8::Order S; S.init(MPAD, D, F.G, (int)blockIdx.x, 1);
        EpiRes<1> E{a};
        pg8::gemm_phase<EpiRes<1>>(F.lds, g, S, E);
    } SEAM(12);
    if (IN(13)) { ph_final(a, F); }
#undef IN
#undef SEAM
}

extern "C" void kernel_launch(void* const* d_in, const int* in_sizes, int n_in, void* d_out, int out_size, void* d_ws, size_t ws_size, hipStream_t stream) {
    static int grid = 0;
    if (grid == 0) {
        if (n_in != 27 || (size_t)out_size != OUT_END || ws_size < WS_END) { fprintf(stderr, "kernel_launch: unexpected shapes (n_in %d out %d ws %zu need %zu)\n", n_in, out_size, ws_size, (size_t)WS_END); grid = -1; return; }
        int dev = 0, cus = 0;
        if (hipGetDevice(&dev) != hipSuccess || hipDeviceGetAttribute(&cus, hipDeviceAttributeMultiprocessorCount, dev) != hipSuccess) { grid = -1; return; }
        if (hipFuncSetAttribute((const void*)nsa_fwd, hipFuncAttributeMaxDynamicSharedMemorySize, LDS_BYTES) != hipSuccess) { fprintf(stderr, "kernel_launch: hipFuncSetAttribute failed\n"); grid = -1; return; }
        (void)hipGetLastError();
        grid = cus;
    }
    if (grid < 0) return;
    if (hipMemsetAsync((char*)d_ws + WS_CTL, 0, CTL_BYTES, stream) != hipSuccess) { fprintf(stderr, "kernel_launch: memset failed\n"); return; }
    Args a{};
    const float** fp = (const float**)&a;
    for (int i = 0; i < 27; ++i) fp[i] = (const float*)d_in[i];
    a.out = (float*)d_out; a.ws = (unsigned char*)d_ws;
#if MK_PER_PHASE
    for (int p = 0; p < N_PHASES - 1; ++p) { a.ph_lo = p; a.ph_hi = p + 1; hipLaunchKernelGGL(nsa_fwd, dim3(grid), dim3(512), LDS_BYTES, stream, a); }
#else
    a.ph_lo = 0; a.ph_hi = N_PHASES; hipLaunchKernelGGL(nsa_fwd, dim3(grid), dim3(512), LDS_BYTES, stream, a);
#endif
    const hipError_t le = hipPeekAtLastError();
    if (le != hipSuccess) fprintf(stderr, "kernel_launch: launch failed: %s\n", hipGetErrorName(le));
}
```

```cpp
#include <hip/hip_runtime.h>
#include <cstdio>
#include <cstdint>

#ifndef MK_PER_PHASE
#define MK_PER_PHASE 0
#endif

#ifndef DBG_REPEAT
#define DBG_REPEAT 0
#endif
#ifndef DBG_CHECK
#define DBG_CHECK 0
#endif
#define GATED ((DBG_CHECK & 7) == 0)
#define LAS __attribute__((address_space(3)))
typedef unsigned short bf16;
typedef short bf16x8 __attribute__((ext_vector_type(8)));
typedef float f32x4 __attribute__((ext_vector_type(4)));
typedef float f32x2 __attribute__((ext_vector_type(2)));
typedef unsigned u32x4 __attribute__((ext_vector_type(4)));
typedef unsigned u32x2 __attribute__((ext_vector_type(2)));

constexpr int D = 2048, NBP = 4, SEQ = 2048, NBS = 8, DSQ = 8, PAST = 16384, PAGE = 128, NPAGES = 128;
constexpr int HD = 128, NH = 16, NKV = 4, GRP = 4;
constexpr int MP = NBP * SEQ;
constexpr int MS = NBS * DSQ;
constexpr int MR = MP + MS;
constexpr int MPAD = 8448;
constexpr int NIN = 15616;
constexpr int NIN_REAL = 15408;
constexpr int DFF = 8192;
constexpr int NBATCH = NBP + NBS;
constexpr float RMS_EPS = 1e-6f;
constexpr float SCALE = 0.08838834764831845f;
constexpr int PC_Q = 0, PC_KV = 2048, PC_KWIN = 4096, PC_VWIN = 4608, PC_U = 5120, PC_B = 7168, PC_C = 9216, PC_MA = 11264, PC_MC = 13312, PC_G = 15360;
constexpr int NCP = 127, NCS = 1023;
constexpr int NSP = 32, NSS = 257;

constexpr int PRS = 256;
#define PX(P_, r_, c_) ((P_) + ((size_t)((c_) >> 8) * MPAD + (size_t)(r_)) * PRS + ((c_) & 255))
constexpr size_t OUT_YP = 0, OUT_YS = OUT_YP + (size_t)MP * D, OUT_KVP = OUT_YS + (size_t)MS * D, OUT_KVS = OUT_KVP + (size_t)MP * 2048,
                 OUT_WINP = OUT_KVS + (size_t)MS * 2048, OUT_WINS = OUT_WINP + (size_t)NBP * 512 * 1024, OUT_CONVP = OUT_WINS + (size_t)NBS * 512 * 1024,
                 OUT_CONVS = OUT_CONVP + (size_t)NBP * 2 * D, OUT_END = OUT_CONVS + (size_t)NBS * 2 * D;

constexpr size_t al256(size_t x) { return (x + 255) & ~(size_t)255; }
constexpr size_t WS_CTL = 0, CTL_BYTES = 1u << 20;
constexpr size_t WS_ADA = WS_CTL + CTL_BYTES;
constexpr size_t WS_PEB = al256(WS_ADA + (size_t)NBATCH * 6 * D * 4);
constexpr size_t WS_PEBP = al256(WS_PEB + 2 * 128 * 4);
constexpr size_t WS_WIN_T = al256(WS_PEBP + 2 * 32 * 128 * 4);
constexpr size_t WS_WP_T = al256(WS_WIN_T + (size_t)NIN * D * 2);
constexpr size_t WS_WOUT_T = al256(WS_WP_T + (size_t)D * 2 * D * 2);
constexpr size_t WS_W1_T = al256(WS_WOUT_T + (size_t)D * D * 2);
constexpr size_t WS_W2_T = al256(WS_W1_T + (size_t)DFF * D * 2);
constexpr size_t WS_WC_T = al256(WS_W2_T + (size_t)D * DFF * 2);
constexpr size_t WS_H = al256(WS_WC_T + (size_t)512 * 2048 * 2);
constexpr size_t WS_P = al256(WS_H + (size_t)MPAD * D * 2);
constexpr size_t WS_KV6 = al256(WS_P + (size_t)MPAD * NIN * 2);
constexpr size_t WS_CA = al256(WS_KV6 + (size_t)6 * NBP * NKV * SEQ * HD * 2);
constexpr size_t WS_PARTS = al256(WS_CA + (size_t)2 * NBS * NKV * PAST * HD * 2);
constexpr size_t WS_PARTP = al256(WS_PARTS + (size_t)32768 * 512 * 4);
constexpr size_t WS_KCS = al256(WS_PARTP + (size_t)2048 * 512 * 4);
constexpr size_t WS_KCP = al256(WS_KCS + (size_t)2 * NBS * NKV * 1024 * HD * 4);
constexpr size_t WS_OCMP = al256(WS_KCP + (size_t)2 * NBP * NKV * 128 * HD * 4);
constexpr size_t WS_OSLC = al256(WS_OCMP + (size_t)MPAD * D * 4);
constexpr size_t WS_OWIN = al256(WS_OSLC + (size_t)MPAD * D * 4);
constexpr size_t WS_SELP = al256(WS_OWIN + (size_t)MPAD * D * 4);
constexpr size_t WS_SELS = al256(WS_SELP + (size_t)NBP * NKV * SEQ * 4);
constexpr size_t WS_A2 = al256(WS_SELS + (size_t)NBS * NKV * DSQ * 16 * 4);
constexpr size_t WS_MIX = al256(WS_A2 + (size_t)MPAD * 2 * D * 2);
constexpr size_t WS_X1 = al256(WS_MIX + (size_t)MPAD * D * 2);
constexpr size_t WS_HM = al256(WS_X1 + (size_t)MPAD * D * 4);
constexpr size_t WS_X2 = al256(WS_HM + (size_t)MPAD * DFF * 2);
constexpr size_t WS_DBGA = al256(WS_X2 + (size_t)MPAD * D * 4);
constexpr size_t WS_DBGB = al256(WS_DBGA + (size_t)MPAD * D * 4);
constexpr size_t WS_DBGC = al256(WS_DBGB + (size_t)MPAD * D * 4);
constexpr size_t WS_SELP2 = al256(WS_DBGC + (size_t)MPAD * D * 4);
constexpr size_t WS_END = al256(WS_SELP2 + (size_t)NBP * NKV * SEQ * 4);

__device__ __forceinline__ float bf2f(bf16 b) { return __uint_as_float(((unsigned)b) << 16); }
__device__ __forceinline__ unsigned f2bf(float f) { unsigned u = __float_as_uint(f); return (u + 0x7fffu + ((u >> 16) & 1u)) >> 16; }
__device__ __forceinline__ unsigned pk2(float lo, float hi) { return f2bf(lo) | (f2bf(hi) << 16); }
__device__ __forceinline__ float lo_bf(unsigned w) { return __uint_as_float(w << 16); }
__device__ __forceinline__ float hi_bf(unsigned w) { return __uint_as_float(w & 0xffff0000u); }
__device__ __forceinline__ float sigmoidf_(float x) { return 1.0f / (1.0f + __expf(-x)); }
template <int C> __device__ __forceinline__ float dppf(float v) { return __int_as_float(__builtin_amdgcn_update_dpp(0, __float_as_int(v), C, 0xF, 0xF, true)); }
__device__ __forceinline__ float wave_sum(float v) {
    v += dppf<0xB1>(v); v += dppf<0x4E>(v); v += dppf<0x141>(v); v += dppf<0x140>(v);
    { auto r = __builtin_amdgcn_permlane16_swap(__float_as_uint(v), __float_as_uint(v), false, false); v = __uint_as_float(r[0]) + __uint_as_float(r[1]); }
    { auto r = __builtin_amdgcn_permlane32_swap(__float_as_uint(v), __float_as_uint(v), false, false); v = __uint_as_float(r[0]) + __uint_as_float(r[1]); }
    return v;
}
__device__ __forceinline__ float wave_max(float v) {
    v = fmaxf(v, dppf<0xB1>(v)); v = fmaxf(v, dppf<0x4E>(v)); v = fmaxf(v, dppf<0x141>(v)); v = fmaxf(v, dppf<0x140>(v));
    { auto r = __builtin_amdgcn_permlane16_swap(__float_as_uint(v), __float_as_uint(v), false, false); v = fmaxf(__uint_as_float(r[0]), __uint_as_float(r[1])); }
    { auto r = __builtin_amdgcn_permlane32_swap(__float_as_uint(v), __float_as_uint(v), false, false); v = fmaxf(__uint_as_float(r[0]), __uint_as_float(r[1])); }
    return v;
}
__device__ __forceinline__ float dpp_xor1(float v) { return __int_as_float(__builtin_amdgcn_update_dpp(0, __float_as_int(v), 0xB1, 0xF, 0xF, true)); }
__device__ __forceinline__ float dpp_xor2(float v) { return __int_as_float(__builtin_amdgcn_update_dpp(0, __float_as_int(v), 0x4E, 0xF, 0xF, true)); }
__device__ __forceinline__ int batch_of(int r) { return r < MP ? (r >> 11) : (NBP + (((r < MR ? r : MR - 1) - MP) >> 3)); }

namespace pg8 {
constexpr int BM = 256, BK = 64, HALF = 128, HTB = HALF * BK * 2, STAGE_BYTES = 8 * HTB, NXCD = 8, WGM = 8;
__host__ __device__ __forceinline__ int lds_byte(int r, int c) { const int st = (r >> 4) * 2 + (c >> 5), rr = r & 15, cc = c & 31, ob = rr * 64 + cc * 2; return st * 1024 + (ob ^ (((ob >> 9) & 1) << 5)); }
__host__ __device__ __forceinline__ void stage_rc(int b, int& R, int& C) { const int st = b / 1024, sb = b % 1024, swz = sb ^ (((sb >> 9) & 1) << 5); R = (st >> 1) * 16 + swz / 64; C = (st & 1) * 32 + (swz % 64) / 2; }
__host__ __device__ __forceinline__ int perm32(int rho) { const int n = rho >> 4, i = rho & 15; return 8 * (i >> 2) + 4 * n + (i & 3); }

struct Unit { int pm, pn, part; };
struct Prob { const char* A; const char* B; size_t a_tile, a_pn, a_part, b_tile, b_part; unsigned lda, ldb; int nt;
    __device__ __forceinline__ const char* a_ptr(const Unit& u) const { return A + (size_t)u.pm * a_tile + (size_t)u.pn * a_pn + (size_t)u.part * a_part; }
    __device__ __forceinline__ const char* b_ptr(const Unit& u) const { return B + (size_t)u.pn * b_tile + (size_t)u.part * b_part; } };

struct Order {
    int nM, nN, nwg, G, c, parts;
    __device__ void init(int M, int N, int G_, int c_, int parts_) { nM = M / BM; nN = N / BM; nwg = nM * nN; G = G_; c = c_; parts = parts_; }
    __device__ bool next(int i, Unit& u) const {
        const int ti = i / parts; u.part = i - ti * parts;
        const long L = (long)ti * G + c; if (L >= nwg) return false;
        int wgid = (int)L; { const int q = nwg / NXCD, r = nwg % NXCD, xcd = wgid % NXCD, off = wgid / NXCD; wgid = (xcd < r ? xcd * (q + 1) : r * (q + 1) + (xcd - r) * q) + off; }
        const int nig = WGM * nN, gid = wgid / nig, fm = gid * WGM, gsz = (nM - fm) < WGM ? (nM - fm) : WGM;
        u.pm = fm + ((wgid % nig) % gsz); u.pn = (wgid % nig) / gsz; return true;
    }
};
__device__ __forceinline__ unsigned cvt_pk_bf16(float lo, float hi) { unsigned r; asm volatile("v_cvt_pk_bf16_f32 %0, %1, %2" : "=v"(r) : "v"(lo), "v"(hi)); return r; }

template <class Epi, bool ALIGN_EPI = true, bool SP2 = true>
__device__ __forceinline__ void gemm_phase(LAS unsigned char* lds, const Prob g, const Order& S, const Epi& E) {
    const int tid = threadIdx.x, wid = __builtin_amdgcn_readfirstlane(tid >> 6), lane = tid & 63, wr = wid >> 2, wc = wid & 3, fr = lane & 15, fq = lane >> 4;
    const int nt = g.nt;
    unsigned voffA[2], voffB[2];
#pragma unroll
    for (int i = 0; i < 2; ++i) { int R, C; stage_rc(tid * 16 + i * 8192, R, C); const int Rb = Epi::PERM ? ((R & ~31) + perm32(R & 31)) : R;
        voffA[i] = (unsigned)R * g.lda + (unsigned)C * 2u; voffB[i] = (unsigned)Rb * g.ldb + (unsigned)C * 2u; }
    const size_t kstep = (size_t)(BK * 2);
    const size_t hstepA = (size_t)HALF * g.lda, hstepB = (size_t)HALF * g.ldb;
    const unsigned ldsw = (unsigned)wid * 1024u;
    const int aoff = lds_byte(wr * 64 + fr, fq * 8), boff = lds_byte(wc * 32 + fr, fq * 8);
#define PG8_SA(b, h) (((b) * 2 + (h)) * HTB)
#define PG8_SB(b, h) ((4 + (b) * 2 + (h)) * HTB)
#define PG8_STAGE(bufoff, gbase, voff) do { _Pragma("unroll") for (int _i = 0; _i < 2; ++_i) \
        __builtin_amdgcn_global_load_lds((const unsigned*)((const char*)(gbase) + (voff)[_i]), (LAS unsigned*)(lds + (bufoff) + ldsw + _i * 8192), 16, 0, 0); } while (0)
#define PG8_LDA(dst, b, h) do { _Pragma("unroll") for (int m = 0; m < 4; ++m) _Pragma("unroll") for (int k = 0; k < 2; ++k) dst[m][k] = *(const LAS bf16x8*)(lds + PG8_SA(b, h) + aoff + m * 2048 + k * 1024); } while (0)
#define PG8_LDB(dst, b, h) do { _Pragma("unroll") for (int n = 0; n < 2; ++n) _Pragma("unroll") for (int k = 0; k < 2; ++k) dst[n][k] = *(const LAS bf16x8*)(lds + PG8_SB(b, h) + boff + n * 2048 + k * 1024); } while (0)
#define PG8_MMA(ai, bj, At, Bt) do { __builtin_amdgcn_s_setprio(1); _Pragma("unroll") for (int m = 0; m < 4; ++m) _Pragma("unroll") for (int n = 0; n < 2; ++n) _Pragma("unroll") for (int k = 0; k < 2; ++k) \
        acc[ai][bj][m][n] = __builtin_amdgcn_mfma_f32_16x16x32_bf16(Bt[n][k], At[m][k], acc[ai][bj][m][n], 0, 0, 0); __builtin_amdgcn_s_setprio(0); } while (0)
#define PG8_WAIT_V(n) asm volatile("s_waitcnt vmcnt(" #n ")" ::: "memory")
#define PG8_WAIT_L(n) asm volatile("s_waitcnt lgkmcnt(" #n ")" ::: "memory")
#define PG8_BAR __builtin_amdgcn_s_barrier()
#define PG8_SCHED __builtin_amdgcn_sched_barrier(0)
    Unit cur, nxt; int ui = 0;
    if (!S.next(0, cur)) return;
    f32x4 acc[2][2][4][2];
#pragma unroll
    for (int a = 0; a < 2; ++a)
#pragma unroll
        for (int b = 0; b < 2; ++b)
#pragma unroll
            for (int m = 0; m < 4; ++m)
#pragma unroll
                for (int n = 0; n < 2; ++n) acc[a][b][m][n] = (f32x4){0.f, 0.f, 0.f, 0.f};
    bf16x8 At[4][2], B0[2][2], B1[2][2];
    const char* cA = g.a_ptr(cur); const char* cB = g.b_ptr(cur);
    if constexpr (SP2) {
        PG8_STAGE(PG8_SB(0, 0), cB, voffB); PG8_STAGE(PG8_SB(0, 1), cB + hstepB, voffB); PG8_STAGE(PG8_SA(0, 0), cA, voffA); PG8_STAGE(PG8_SA(0, 1), cA + hstepA, voffA);
        if (wr == 1) PG8_BAR;
        PG8_WAIT_V(2); PG8_BAR;
        PG8_STAGE(PG8_SB(1, 0), cB + kstep, voffB); PG8_STAGE(PG8_SA(1, 0), cA + kstep, voffA); PG8_STAGE(PG8_SB(1, 1), cB + hstepB + kstep, voffB);
        PG8_WAIT_V(6); PG8_BAR;
    } else {
        PG8_STAGE(PG8_SB(0, 0), cB, voffB); PG8_STAGE(PG8_SA(0, 0), cA, voffA); PG8_STAGE(PG8_SB(0, 1), cB + hstepB, voffB); PG8_STAGE(PG8_SA(0, 1), cA + hstepA, voffA);
        if (wr == 1) PG8_BAR;
        PG8_WAIT_V(4); PG8_BAR;
        PG8_STAGE(PG8_SB(1, 0), cB + kstep, voffB); PG8_STAGE(PG8_SA(1, 0), cA + kstep, voffA); PG8_STAGE(PG8_SB(1, 1), cB + hstepB + kstep, voffB);
        PG8_WAIT_V(6); PG8_BAR;
    }
    for (;;) {
        const bool has_next = S.next(ui + 1, nxt);
        const char* nA = has_next ? g.a_ptr(nxt) : cA; const char* nB = has_next ? g.b_ptr(nxt) : cB;
        for (int t = 0; t < nt; t += 2) {
            const bool last = (t == nt - 2);
            const char* a1 = cA + (size_t)(t + 1) * kstep;
            const char* a2 = last ? nA : cA + (size_t)(t + 2) * kstep; const char* b2 = last ? nB : cB + (size_t)(t + 2) * kstep;
            const char* a3 = a2 + kstep; const char* b3 = b2 + kstep;
            if constexpr (SP2) {
            PG8_LDB(B0, 0, 0); PG8_LDB(B1, 0, 1); PG8_SCHED; PG8_LDA(At, 0, 0); PG8_STAGE(PG8_SA(1, 1), a1 + hstepA, voffA);
            PG8_WAIT_V(8); PG8_WAIT_L(0); PG8_BAR; PG8_MMA(0, 0, At, B0); PG8_MMA(0, 1, At, B1); PG8_BAR; PG8_SCHED;
            PG8_LDA(At, 0, 1); PG8_STAGE(PG8_SB(0, 0), b2, voffB); PG8_STAGE(PG8_SB(0, 1), b2 + hstepB, voffB); PG8_STAGE(PG8_SA(0, 0), a2, voffA);
            PG8_WAIT_V(8); PG8_WAIT_L(0); PG8_BAR; PG8_MMA(1, 0, At, B0); PG8_MMA(1, 1, At, B1); PG8_BAR; PG8_SCHED;
            PG8_LDB(B0, 1, 0); PG8_LDB(B1, 1, 1); PG8_SCHED; PG8_LDA(At, 1, 0); PG8_STAGE(PG8_SA(0, 1), a2 + hstepA, voffA);
            PG8_WAIT_V(8); PG8_WAIT_L(0); PG8_BAR; PG8_MMA(0, 0, At, B0); PG8_MMA(0, 1, At, B1); PG8_BAR; PG8_SCHED;
            PG8_LDA(At, 1, 1); PG8_STAGE(PG8_SB(1, 0), b3, voffB); PG8_STAGE(PG8_SB(1, 1), b3 + hstepB, voffB); PG8_STAGE(PG8_SA(1, 0), a3, voffA);
            PG8_WAIT_V(8); PG8_WAIT_L(0); PG8_BAR; PG8_MMA(1, 0, At, B0); PG8_MMA(1, 1, At, B1); PG8_BAR; PG8_SCHED;
            } else {
            PG8_LDB(B0, 0, 0); PG8_SCHED; PG8_LDA(At, 0, 0); PG8_STAGE(PG8_SA(1, 1), a1 + hstepA, voffA);
            PG8_WAIT_L(8); PG8_BAR; PG8_WAIT_L(0); PG8_MMA(0, 0, At, B0); PG8_BAR; PG8_SCHED;
            PG8_LDB(B1, 0, 1); PG8_STAGE(PG8_SB(0, 0), b2, voffB);
            PG8_BAR; PG8_WAIT_L(0); PG8_MMA(0, 1, At, B1); PG8_BAR;
            PG8_LDA(At, 0, 1); PG8_STAGE(PG8_SA(0, 0), a2, voffA);
            PG8_BAR; PG8_WAIT_L(0); PG8_MMA(1, 0, At, B0); PG8_BAR; PG8_SCHED;
            PG8_STAGE(PG8_SB(0, 1), b2 + hstepB, voffB);
            PG8_WAIT_V(6); PG8_BAR; PG8_MMA(1, 1, At, B1); PG8_BAR;
            PG8_LDB(B0, 1, 0); PG8_SCHED; PG8_LDA(At, 1, 0); PG8_STAGE(PG8_SA(0, 1), a2 + hstepA, voffA);
            PG8_WAIT_L(8); PG8_BAR; PG8_WAIT_L(0); PG8_MMA(0, 0, At, B0); PG8_BAR; PG8_SCHED;
            PG8_LDB(B1, 1, 1); PG8_STAGE(PG8_SB(1, 0), b3, voffB);
            PG8_BAR; PG8_WAIT_L(0); PG8_MMA(0, 1, At, B1); PG8_BAR;
            PG8_LDA(At, 1, 1); PG8_STAGE(PG8_SA(1, 0), a3, voffA);
            PG8_BAR; PG8_WAIT_L(0); PG8_MMA(1, 0, At, B0); PG8_BAR; PG8_SCHED;
            PG8_STAGE(PG8_SB(1, 1), b3 + hstepB, voffB);
            PG8_WAIT_V(6); PG8_BAR; PG8_MMA(1, 1, At, B1); PG8_BAR;
            }
        }
        if constexpr (ALIGN_EPI) { if (wr == 0) PG8_BAR; }
        E(acc, cur, wr, wc, fr, fq);
        if (!has_next) break;
        if (!E.keep(cur)) {
#pragma unroll
        for (int a = 0; a < 2; ++a)
#pragma unroll
            for (int b = 0; b < 2; ++b)
#pragma unroll
                for (int m = 0; m < 4; ++m)
#pragma unroll
                    for (int n = 0; n < 2; ++n) acc[a][b][m][n] = (f32x4){0.f, 0.f, 0.f, 0.f};
        }
        cur = nxt; cA = nA; cB = nB; ++ui;
        if constexpr (ALIGN_EPI) { if (wr == 1) PG8_BAR; }
    }
    PG8_WAIT_V(0);
    if constexpr (!ALIGN_EPI) { if (wr == 0) PG8_BAR; }
    PG8_BAR;
#undef PG8_SA
#undef PG8_SB
#undef PG8_STAGE
#undef PG8_LDA
#undef PG8_LDB
#undef PG8_MMA
#undef PG8_WAIT_V
#undef PG8_WAIT_L
#undef PG8_BAR
#undef PG8_SCHED
}
}
using pg8::Unit;
typedef f32x4 AccT[2][2][4][2];

#define XB_TMO      128
#define XB_XCNT(j)  (256  + 64 * (j))
#define XB_XSUB(j)  (1280 + 64 * (j))
#define XB_XGEN(j)  (2304 + 64 * (j))
#define XB_TOP      3328
#define XB_TOPGEN   3392
#define XCD_BAR_WORDS 3456
#define XB_SPIN_CAP (1u << 18)
__device__ __forceinline__ unsigned xb_ld(unsigned* p)              { return __hip_atomic_load(p, __ATOMIC_RELAXED, __HIP_MEMORY_SCOPE_AGENT); }
__device__ __forceinline__ unsigned xb_add(unsigned* p, unsigned v) { return __hip_atomic_fetch_add(p, v, __ATOMIC_RELAXED, __HIP_MEMORY_SCOPE_AGENT); }
__device__ __forceinline__ unsigned xb_xcc_id() { return (unsigned)__builtin_amdgcn_s_getreg((3 << 11) | 20) & 0xFu; }
#define XB_SPIN(cond, bar) do { unsigned _sp = 0; while (cond) { __builtin_amdgcn_s_sleep(1); \
    if ((++_sp & 255u) == 0u) { if (xb_ld(&(bar)[XB_TMO])) break; if (_sp > XB_SPIN_CAP) { atomicAdd(&(bar)[XB_TMO], 1u); break; } } } } while (0)
struct XcdBarrier { unsigned* bar; unsigned x; volatile LAS unsigned* st; };
__device__ __forceinline__ XcdBarrier xcd_barrier_post(unsigned* bar, volatile LAS unsigned* st) {
    XcdBarrier b; b.bar = bar; b.x = xb_xcc_id(); b.st = st;
    if (threadIdx.x == 0) (void)xb_add(&bar[XB_XCNT(b.x)], 1u);
    return b;
}
__device__ __forceinline__ void xcd_barrier_complete(unsigned* bar, unsigned x, unsigned& nloc, unsigned& nx) {
    const unsigned G = gridDim.x * gridDim.y * gridDim.z;
    unsigned sum, cnt, mine, sp = 0u;
    for (;;) {
        sum = 0u; cnt = 0u; mine = 0u;
#pragma unroll
        for (unsigned j = 0; j < 16; ++j) { const unsigned c = xb_ld(&bar[XB_XCNT(j)]); sum += c; cnt += (c > 0u) ? 1u : 0u; mine = (j == x) ? c : mine; }
        if (sum == G) break;
        __builtin_amdgcn_s_sleep(1);
        if ((++sp & 255u) == 0u) { if (xb_ld(&bar[XB_TMO])) break; if (sp > XB_SPIN_CAP) { atomicAdd(&bar[XB_TMO], 1u); break; } }
    }
    nloc = mine > 0u ? mine : 1u; nx = cnt > 0u ? cnt : 1u;
}
__device__ __forceinline__ void xcd_barrier(const XcdBarrier& b) {
    asm volatile("s_waitcnt vmcnt(0)" ::: "memory");
    __syncthreads();
    if (threadIdx.x == 0) {
        unsigned* bar = b.bar;
        __builtin_amdgcn_s_waitcnt(0);
        unsigned nloc = b.st[0], nx = b.st[1];
        if (nloc == 0u) { xcd_barrier_complete(bar, b.x, nloc, nx); b.st[0] = nloc; b.st[1] = nx; }
        const unsigned old = xb_add(&bar[XB_XSUB(b.x)], 1u);
        const unsigned gen = old / nloc;
        if (old + 1u == (gen + 1u) * nloc) {
            __builtin_amdgcn_fence(__ATOMIC_RELEASE, "agent");
            asm volatile("s_waitcnt vmcnt(0)" ::: "memory");
            const unsigned og = xb_add(&bar[XB_TOP], 1u);
            const unsigned tg = og / nx;
            if (og + 1u == (tg + 1u) * nx) xb_add(&bar[XB_TOPGEN], 1u);
            else XB_SPIN(xb_ld(&bar[XB_TOPGEN]) == tg, bar);
            __builtin_amdgcn_fence(__ATOMIC_ACQUIRE, "agent");
            xb_add(&bar[XB_XGEN(b.x)], 1u);
            asm volatile("s_waitcnt vmcnt(0)" ::: "memory");
        } else {
            XB_SPIN(xb_ld(&bar[XB_XGEN(b.x)]) == gen, bar);
            __builtin_amdgcn_fence(__ATOMIC_ACQUIRE, "agent");
            asm volatile("s_waitcnt vmcnt(0)" ::: "memory");
        }
    }
    __syncthreads();
}

struct Args {
    const float *x_p, *x_s, *c_p, *c_s, *cache; const int* ptab; const float *st_win, *st_conv, *w_ada, *b_ada, *n1g, *n2g, *w_in,
        *wck1, *wck2, *pek, *wcv1, *wcv2, *pev, *conv_w, *conv_b, *w_ap, *w_cp, *w_out, *w_m1, *w_m2, *nfg;
    float* out; unsigned char* ws; int ph_lo, ph_hi;
};
struct Frame { LAS unsigned char* lds; int tid, lane, wave, vcu, G; };
constexpr int LDS_BYTES = 147456;
constexpr int RING_BYTES = 131072, MISC_OFF = RING_BYTES + 320;

__device__ __forceinline__ const float* x_row(const Args& a, int r) { const int rr = r < MR ? r : MR - 1; return rr < MP ? a.x_p + (size_t)rr * D : a.x_s + (size_t)(rr - MP) * D; }

__device__ __forceinline__ void ph_ada(const Args& a, const Frame& F) {
    LAS float* sc = (LAS float*)F.lds;
    LAS float* red = sc + NBATCH * D;
    float* ada = (float*)(a.ws + WS_ADA);
    for (int i = F.tid; i < NBATCH * D; i += 512) { const int bi = i / D, k = i % D; const float v = bi < NBP ? a.c_p[bi * D + k] : a.c_s[(bi - NBP) * D + k]; sc[i] = v / (1.0f + __expf(-v)); }
    __syncthreads();
    const int cg = F.tid & 15, sl = F.tid >> 4;
    for (int ch = F.vcu; ch < 6 * D / 64; ch += F.G) {
        f32x4 acc[NBATCH];
#pragma unroll
        for (int b = 0; b < NBATCH; ++b) acc[b] = (f32x4){0.f, 0.f, 0.f, 0.f};
        const float* w = a.w_ada + (size_t)(sl * 64) * (6 * D) + ch * 64 + cg * 4;
#pragma unroll 1
        for (int k0 = 0; k0 < 64; k0 += 16) { f32x4 wv[16];
#pragma unroll
            for (int k = 0; k < 16; ++k) wv[k] = __builtin_nontemporal_load((const f32x4*)(w + (size_t)(k0 + k) * (6 * D)));
#pragma unroll
            for (int k = 0; k < 16; ++k)
#pragma unroll
                for (int b = 0; b < NBATCH; ++b) acc[b] += sc[b * D + sl * 64 + k0 + k] * wv[k]; }
#pragma unroll
        for (int b = 0; b < NBATCH; ++b)
#pragma unroll
            for (int e = 0; e < 4; ++e) { float v = acc[b][e]; v += __shfl_xor(v, 16); v += __shfl_xor(v, 32); acc[b][e] = v; }
        if (F.lane < 16) {
#pragma unroll
            for (int b = 0; b < NBATCH; ++b) *(LAS f32x4*)(red + (F.wave * NBATCH + b) * 64 + cg * 4) = acc[b]; }
        __syncthreads();
        for (int i = F.tid; i < NBATCH * 64; i += 512) { const int b = i >> 6, jj = i & 63; float s_ = 0.f;
#pragma unroll
            for (int q = 0; q < 8; ++q) s_ += red[(q * NBATCH + b) * 64 + jj];
            ada[(size_t)b * 6 * D + ch * 64 + jj] = s_ + a.b_ada[ch * 64 + jj]; }
        __syncthreads();
    }
    for (int u = F.G - 1 - F.vcu; u < 64; u += F.G) { const int kind = u >> 5, sl = u & 31;
        const float* pe = (kind ? a.pev : a.pek) + sl * 128; const float* w1 = (kind ? a.wcv1 : a.wck1) + (size_t)sl * 128 * 128;
        const int f = F.tid & 127, q = F.tid >> 7; float s_ = 0.f;
#pragma unroll 8
        for (int jj = q * 32; jj < (q + 1) * 32; ++jj) s_ += pe[jj] * w1[(size_t)jj * 128 + f];
        __syncthreads(); red[q * 128 + f] = s_; __syncthreads();
        if (F.tid < 128) ((float*)(a.ws + WS_PEBP))[(kind * 32 + sl) * 128 + f] = red[f] + red[128 + f] + red[256 + f] + red[384 + f];
    }
}
__device__ __forceinline__ void ph_peb_sum(const Args& a, const Frame& F) {
    if (F.vcu == 0 && F.tid < 256) { const float* pp = (const float*)(a.ws + WS_PEBP) + (F.tid >> 7) * 32 * 128 + (F.tid & 127); float s_ = 0.f;
#pragma unroll 8
        for (int sl = 0; sl < 32; ++sl) s_ += pp[sl * 128];
        ((float*)(a.ws + WS_PEB))[F.tid] = s_; }
}
struct TrD { const float* W; bf16* WT; int ldw, ldt, k0, ns, nd, nv; };
__device__ __forceinline__ void tr_load(const TrD& d, f32x4 (&tv)[8], int lane) {
    const int n4 = (lane & 7) * 4;
#pragma unroll
    for (int i = 0; i < 8; ++i) { const int kk = 8 * i + (lane >> 3); tv[i] = n4 < d.nv ? __builtin_nontemporal_load((const f32x4*)(d.W + (size_t)(d.k0 + kk) * d.ldw + d.ns + n4)) : (f32x4){0.f, 0.f, 0.f, 0.f}; }
}
__device__ __forceinline__ void tr_finish(const TrD& d, const f32x4 (&tv)[8], LAS float* scr, int lane) {
    const int n4 = (lane & 7) * 4;
#pragma unroll
    for (int i = 0; i < 8; ++i) { const int kk = 8 * i + (lane >> 3); *(LAS f32x4*)(scr + kk * 36 + n4) = tv[i]; }
    asm volatile("s_waitcnt lgkmcnt(0)" ::: "memory");
    const int c = lane & 7;
#pragma unroll
    for (int j = 0; j < 4; ++j) { const int n = (lane >> 3) + 8 * j; const LAS float* s = scr + (8 * c) * 36 + n;
        u32x4 o; o.x = pk2(s[0 * 36], s[1 * 36]); o.y = pk2(s[2 * 36], s[3 * 36]); o.z = pk2(s[4 * 36], s[5 * 36]); o.w = pk2(s[6 * 36], s[7 * 36]);
        *(u32x4*)(d.WT + (size_t)(d.nd + n) * d.ldt + d.k0 + 8 * c) = o; }
    asm volatile("s_waitcnt lgkmcnt(0)" ::: "memory");
}
__device__ __forceinline__ TrD tr_decode(const Args& a, int it) {
    constexpr int I_IN = 32 * (NIN / 32), I_P = 32 * 64, I_O = 32 * 64, I_1 = 32 * 256, I_2 = 128 * 64, I_C = 32 * 4;
    bf16* win_t = (bf16*)(a.ws + WS_WIN_T); bf16* wp_t = (bf16*)(a.ws + WS_WP_T); bf16* wout_t = (bf16*)(a.ws + WS_WOUT_T);
    bf16* w1_t = (bf16*)(a.ws + WS_W1_T); bf16* w2_t = (bf16*)(a.ws + WS_W2_T); bf16* wc_t = (bf16*)(a.ws + WS_WC_T);
    int r = it;
    if (r < I_IN) { const int nb = r % (NIN / 32), kb = r / (NIN / 32), nd = nb * 32; int ns, nv;
        if (nd < PC_U) { ns = nd; nv = 32; } else if (nd < PC_G) { ns = nd + 48; nv = 32; } else { ns = 5120 + (nd - PC_G); nv = 5168 - ns; nv = nv < 0 ? 0 : (nv > 32 ? 32 : nv); }
        return TrD{a.w_in, win_t, NIN_REAL, D, kb * 64, ns, nd, nv}; } r -= I_IN;
    if (r < I_P) return TrD{a.w_ap, wp_t, D, 2 * D, (r / 64) * 64, (r % 64) * 32, (r % 64) * 32, 32}; r -= I_P;
    if (r < I_P) return TrD{a.w_cp, wp_t + D, D, 2 * D, (r / 64) * 64, (r % 64) * 32, (r % 64) * 32, 32}; r -= I_P;
    if (r < I_O) return TrD{a.w_out, wout_t, D, D, (r / 64) * 64, (r % 64) * 32, (r % 64) * 32, 32}; r -= I_O;
    if (r < I_1) return TrD{a.w_m1, w1_t, DFF, D, (r / 256) * 64, (r % 256) * 32, (r % 256) * 32, 32}; r -= I_1;
    if (r < I_2) return TrD{a.w_m2, w2_t, D, DFF, (r / 64) * 64, (r % 64) * 32, (r % 64) * 32, 32}; r -= I_2;
    { const int q = r / I_C, rr = r % I_C, kind = q >> 1, s = q & 1;
      const float* w1 = (kind ? a.wcv1 : a.wck1) + (size_t)s * 2048 * 128;
      return TrD{w1, wc_t + (size_t)(kind * 256 + s * 128) * 2048, 128, 2048, (rr / 4) * 64, (rr % 4) * 32, (rr % 4) * 32, 32}; }
}
constexpr int TR_I_C = 32 * 4, TR_NIT = 32 * (NIN / 32) + 2 * 32 * 64 + 32 * 64 + 32 * 256 + 128 * 64 + 4 * TR_I_C, TR_NBIG = TR_NIT - 4 * TR_I_C;
constexpr int TR_EARLY = 3072;
__device__ __forceinline__ void ph_transpose_range(const Args& a, const Frame& F, int ibeg, int iend, int widx, int wcnt) {
    LAS float* scr = (LAS float*)F.lds + F.wave * (64 * 36);
    const int NGW = wcnt * 8; int it = ibeg + widx * 8 + F.wave; const int end = iend;
    if (it >= end) return;
    f32x4 ta[8], tb[8]; TrD da = tr_decode(a, it), db = da; tr_load(da, ta, F.lane);
#pragma unroll 1
    for (;;) {
        int itn = it + NGW; bool hn = itn < end;
        if (hn) { db = tr_decode(a, itn); tr_load(db, tb, F.lane); }
        tr_finish(da, ta, scr, F.lane);
        if (!hn) break;
        it = itn; itn = it + NGW; hn = itn < end;
        if (hn) { da = tr_decode(a, itn); tr_load(da, ta, F.lane); }
        tr_finish(db, tb, scr, F.lane);
        if (!hn) break;
        it = itn;
    }
}
__device__ __forceinline__ void ph_cache_cvt(const Args& a, const Frame& F) {
    const int gw = F.vcu * 8 + F.wave, NGW = F.G * 8; bf16* ca = (bf16*)(a.ws + WS_CA);
    const int l = F.lane, kind = l >> 5, kvh = (l & 31) >> 3, d0 = (l & 7) * 16;
    for (int it0 = gw; it0 < NBS * PAST; it0 += 2 * NGW) {
        f32x4 v[2][4]; bool ok[2];
#pragma unroll
        for (int u = 0; u < 2; ++u) { const int it = it0 + u * NGW; ok[u] = it < NBS * PAST; const int itc = ok[u] ? it : it0; const int b = itc >> 14, pos = itc & (PAST - 1);
            const int page = a.ptab[b * NPAGES + (pos >> 7)];
            const float* src = a.cache + ((size_t)page * PAGE + (pos & 127)) * 2048 + l * 16;
#pragma unroll
            for (int q = 0; q < 4; ++q) v[u][q] = __builtin_nontemporal_load((const f32x4*)src + q); }
#pragma unroll
        for (int u = 0; u < 2; ++u) if (ok[u]) { const int it = it0 + u * NGW; const int b = it >> 14, pos = it & (PAST - 1);
            u32x4 o0 = {pk2(v[u][0][0], v[u][0][1]), pk2(v[u][0][2], v[u][0][3]), pk2(v[u][1][0], v[u][1][1]), pk2(v[u][1][2], v[u][1][3])};
            u32x4 o1 = {pk2(v[u][2][0], v[u][2][1]), pk2(v[u][2][2], v[u][2][3]), pk2(v[u][3][0], v[u][3][1]), pk2(v[u][3][2], v[u][3][3])};
            bf16* dst = ca + ((((size_t)kind * NBS + b) * NKV + kvh) * PAST + pos) * HD + d0;
            *(u32x4*)dst = o0; *(u32x4*)(dst + 8) = o1; }
    }
}

template <int WHICH> __device__ __forceinline__ void ph_modnorm(const Args& a, const Frame& F) {
    const int gw = F.vcu * 8 + F.wave, NGW = F.G * 8; const float* ada = (const float*)(a.ws + WS_ADA);
    bf16* H = (bf16*)(a.ws + WS_H); const float* g = WHICH ? a.n2g : a.n1g;
#pragma unroll 1
    for (int r0 = gw * 4; r0 < MP; r0 += NGW * 4) {
        const int bi = r0 >> 11; const float* sh = ada + (size_t)bi * 6 * D + (WHICH ? 3 * D : 0); const float* sc = sh + D;
        f32x4 ga[8], sb[8];
#pragma unroll
        for (int j = 0; j < 8; ++j) { const int c = (F.lane + 64 * j) * 4; const f32x4 gg = *(const f32x4*)(g + c), s1 = *(const f32x4*)(sc + c); sb[j] = *(const f32x4*)(sh + c);
#pragma unroll
            for (int e = 0; e < 4; ++e) ga[j][e] = gg[e] * (1.0f + s1[e]); }
#pragma unroll 2
        for (int i = 0; i < 4; ++i) { const int r = r0 + i;
            const float* xr = WHICH ? (const float*)(a.ws + WS_X1) + (size_t)r * D : a.x_p + (size_t)r * D; bf16* orow = H + (size_t)r * D;
            f32x4 v[8]; float ss = 0.f;
#pragma unroll
            for (int j = 0; j < 8; ++j) { v[j] = *(const f32x4*)(xr + (F.lane + 64 * j) * 4); ss += (v[j][0] * v[j][0] + v[j][1] * v[j][1]) + (v[j][2] * v[j][2] + v[j][3] * v[j][3]); }
            const float rstd = rsqrtf(wave_sum(ss) * (1.0f / D) + RMS_EPS);
#pragma unroll
            for (int j = 0; j < 8; ++j) { const int c = (F.lane + 64 * j) * 4; f32x4 o;
#pragma unroll
                for (int e = 0; e < 4; ++e) o[e] = v[j][e] * rstd * ga[j][e] + sb[j][e];
                *(u32x2*)(orow + c) = (u32x2){pk2(o[0], o[1]), pk2(o[2], o[3])}; } }
    }
    for (int r = MP + gw; r < MPAD; r += NGW) {
        bf16* orow = H + (size_t)r * D;
        if (r >= MR) { for (int j = 0; j < 4; ++j) *(u32x4*)(orow + (F.lane + 64 * j) * 8) = (u32x4){0u, 0u, 0u, 0u}; continue; }
        const float* xr = WHICH ? (const float*)(a.ws + WS_X1) + (size_t)r * D : x_row(a, r);
        const int bi = batch_of(r); const float* sh = ada + (size_t)bi * 6 * D + (WHICH ? 3 * D : 0); const float* sc = sh + D;
        f32x4 v[8]; float ss = 0.f;
#pragma unroll
        for (int j = 0; j < 8; ++j) { v[j] = *(const f32x4*)(xr + (F.lane + 64 * j) * 4); ss += (v[j][0] * v[j][0] + v[j][1] * v[j][1]) + (v[j][2] * v[j][2] + v[j][3] * v[j][3]); }
        const float rstd = rsqrtf(wave_sum(ss) * (1.0f / D) + RMS_EPS);
#pragma unroll
        for (int j = 0; j < 8; ++j) { const int c = (F.lane + 64 * j) * 4; const f32x4 gg = *(const f32x4*)(g + c), s1 = *(const f32x4*)(sc + c), s0 = *(const f32x4*)(sh + c);
            f32x4 o;
#pragma unroll
            for (int e = 0; e < 4; ++e) o[e] = v[j][e] * rstd * gg[e] * (1.0f + s1[e]) + s0[e];
            *(u32x2*)(orow + c) = (u32x2){pk2(o[0], o[1]), pk2(o[2], o[3])}; }
    }
}

struct EpiIn {
    static constexpr bool PERM = true;
    bf16* P; bf16* KV6; float* out;
    __device__ __forceinline__ bool keep(const Unit&) const { return false; }
    __device__ __forceinline__ void operator()(AccT& acc, const Unit& u, int wr, int wc, int fr, int fq) const {
        const int row0 = u.pm * 256 + wr * 64 + fr, colt = u.pn * 256 + wc * 32 + 8 * fq;
#pragma unroll
        for (int ai = 0; ai < 2; ++ai)
#pragma unroll
            for (int m = 0; m < 4; ++m) { const int r = row0 + ai * 128 + m * 16;
#pragma unroll
                for (int bj = 0; bj < 2; ++bj) { const int c = colt + bj * 128; const f32x4 v0 = acc[ai][bj][m][0], v1 = acc[ai][bj][m][1];
                    u32x4 w; w.x = pg8::cvt_pk_bf16(v0[0], v0[1]); w.y = pg8::cvt_pk_bf16(v0[2], v0[3]); w.z = pg8::cvt_pk_bf16(v1[0], v1[1]); w.w = pg8::cvt_pk_bf16(v1[2], v1[3]);
                    *(u32x4*)PX(P, r, c) = w;
                    if (u.pn >= 8 && u.pn < 20 && r < MR) {
                        const int cc = c - PC_KV, kind = cc >> 9, kvh = (cc >> 7) & 3, d = cc & 127;
                        if (r < MP) { const int b = r >> 11, s = r & 2047;
                            *(u32x4*)(KV6 + ((((size_t)kind * NBP + b) * NKV + kvh) * SEQ + s) * HD + d) = w;
                            if (u.pn < 16) { float* o = out + OUT_KVP + (size_t)r * 2048 + cc; *(f32x4*)o = v0; *(f32x4*)(o + 4) = v1; }
                            else if (s >= SEQ - 512) { float* o = out + OUT_WINP + ((size_t)b * 512 + (s - (SEQ - 512))) * 1024 + (c - PC_KWIN); *(f32x4*)o = v0; *(f32x4*)(o + 4) = v1; }
                        } else { const int rs = r - MP, b = rs >> 3, s = rs & 7;
                            if (u.pn < 16) { float* o = out + OUT_KVS + (size_t)rs * 2048 + cc; *(f32x4*)o = v0; *(f32x4*)(o + 4) = v1; }
                            else { float* o = out + OUT_WINS + ((size_t)b * 512 + 504 + s) * 1024 + (c - PC_KWIN); *(f32x4*)o = v0; *(f32x4*)(o + 4) = v1; }
                        }
                    }
                } }
    }
};
struct EpiF32 {
    static constexpr bool PERM = false;
    float* C; int ldc;
    __device__ __forceinline__ bool keep(const Unit&) const { return false; }
    __device__ __forceinline__ void operator()(AccT& acc, const Unit& u, int wr, int wc, int fr, int fq) const {
        const int row0 = u.pm * 256 + wr * 64 + fr, col0 = u.pn * 256 + wc * 32 + 4 * fq;
#pragma unroll
        for (int ai = 0; ai < 2; ++ai)
#pragma unroll
            for (int m = 0; m < 4; ++m) { float* rowp = C + (size_t)(row0 + ai * 128 + m * 16) * ldc + col0;
#pragma unroll
                for (int bj = 0; bj < 2; ++bj)
#pragma unroll
                    for (int n = 0; n < 2; ++n) *(f32x4*)(rowp + bj * 128 + n * 16) = acc[ai][bj][m][n]; }
    }
};
struct EpiNull {
    static constexpr bool PERM = true;
    float* C;
    __device__ __forceinline__ bool keep(const Unit&) const { return false; }
    __device__ __forceinline__ void operator()(AccT& acc, const Unit& u, int wr, int wc, int fr, int fq) const {
        f32x4 t = acc[0][0][0][0];
#pragma unroll
        for (int ai = 0; ai < 2; ++ai)
#pragma unroll
            for (int bj = 0; bj < 2; ++bj)
#pragma unroll
                for (int m = 0; m < 4; ++m)
#pragma unroll
                    for (int n = 0; n < 2; ++n) t += acc[ai][bj][m][n];
        *(f32x4*)(C + ((size_t)(u.pm * 61 + u.pn) * 512 + threadIdx.x) * 4) = t; }
};
struct EpiProj {
    static constexpr bool PERM = true;
    const bf16* P; bf16* MIX;
    __device__ __forceinline__ bool keep(const Unit& u) const { return u.part == 0; }
    __device__ __forceinline__ void operator()(AccT& acc, const Unit& u, int wr, int wc, int fr, int fq) const {
        const int row0 = u.pm * 256 + wr * 64 + fr, colt = u.pn * 256 + wc * 32 + 8 * fq;
#pragma unroll
        for (int ai = 0; ai < 2; ++ai)
#pragma unroll
            for (int m = 0; m < 4; ++m) { const int r = row0 + ai * 128 + m * 16;
#pragma unroll
                for (int bj = 0; bj < 2; ++bj) { const int c = colt + bj * 128;
                    const u32x4 mc = *(const u32x4*)PX(P, r, PC_MC + c);
                    float sc[8];
#pragma unroll
                    for (int e = 0; e < 4; ++e) { sc[2 * e] = sigmoidf_(lo_bf(mc[e])); sc[2 * e + 1] = sigmoidf_(hi_bf(mc[e])); }
                    if (u.part == 0) {
                        const u32x4 ma = *(const u32x4*)PX(P, r, PC_MA + c);
#pragma unroll
                        for (int e = 0; e < 4; ++e) { const float s0 = sigmoidf_(lo_bf(ma[e])) / sc[2 * e], s1 = sigmoidf_(hi_bf(ma[e])) / sc[2 * e + 1];
                            acc[ai][bj][m][e >> 1][(e & 1) * 2] *= s0; acc[ai][bj][m][e >> 1][(e & 1) * 2 + 1] *= s1; }
                    } else {
                        const f32x4 v0 = acc[ai][bj][m][0], v1 = acc[ai][bj][m][1];
                        u32x4 w; w.x = pg8::cvt_pk_bf16(v0[0] * sc[0], v0[1] * sc[1]); w.y = pg8::cvt_pk_bf16(v0[2] * sc[2], v0[3] * sc[3]);
                        w.z = pg8::cvt_pk_bf16(v1[0] * sc[4], v1[1] * sc[5]); w.w = pg8::cvt_pk_bf16(v1[2] * sc[6], v1[3] * sc[7]);
                        *(u32x4*)(MIX + (size_t)r * D + c) = w;
                    }
                } }
    }
};
template <int WHICH> struct EpiRes {
    static constexpr bool PERM = false;
    Args a;
    __device__ __forceinline__ bool keep(const Unit&) const { return false; }
    __device__ __forceinline__ void operator()(AccT& acc, const Unit& u, int wr, int wc, int fr, int fq) const {
        const int row0 = u.pm * 256 + wr * 64 + fr, col0 = u.pn * 256 + wc * 32 + 4 * fq;
        const float* ada = (const float*)(a.ws + WS_ADA); float* O = (float*)(a.ws + (WHICH ? WS_X2 : WS_X1));
#pragma unroll
        for (int ai = 0; ai < 2; ++ai)
#pragma unroll
            for (int m = 0; m < 4; ++m) { const int r = row0 + ai * 128 + m * 16;
                const float* base = WHICH ? (const float*)(a.ws + WS_X1) + (size_t)r * D : x_row(a, r);
                const float* gate = ada + (size_t)batch_of(r) * 6 * D + (WHICH ? 5 * D : 2 * D);
#pragma unroll
                for (int bj = 0; bj < 2; ++bj)
#pragma unroll
                    for (int n = 0; n < 2; ++n) { const int c = col0 + bj * 128 + n * 16; const f32x4 bs = *(const f32x4*)(base + c), gg = *(const f32x4*)(gate + c);
                        *(f32x4*)(O + (size_t)r * D + c) = bs + gg * acc[ai][bj][m][n]; } }
    }
};
struct EpiRelu2 {
    static constexpr bool PERM = true;
    bf16* HM;
    __device__ __forceinline__ bool keep(const Unit&) const { return false; }
    __device__ __forceinline__ void operator()(AccT& acc, const Unit& u, int wr, int wc, int fr, int fq) const {
        const int row0 = u.pm * 256 + wr * 64 + fr, colt = u.pn * 256 + wc * 32 + 8 * fq;
#pragma unroll
        for (int ai = 0; ai < 2; ++ai)
#pragma unroll
            for (int m = 0; m < 4; ++m) { const int r = row0 + ai * 128 + m * 16;
#pragma unroll
                for (int bj = 0; bj < 2; ++bj) { const int c = colt + bj * 128; f32x4 v0 = acc[ai][bj][m][0], v1 = acc[ai][bj][m][1];
#pragma unroll
                    for (int e = 0; e < 4; ++e) { const float p = fmaxf(v0[e], 0.f), q = fmaxf(v1[e], 0.f); v0[e] = p * p; v1[e] = q * q; }
                    u32x4 w; w.x = pg8::cvt_pk_bf16(v0[0], v0[1]); w.y = pg8::cvt_pk_bf16(v0[2], v0[3]); w.z = pg8::cvt_pk_bf16(v1[0], v1[1]); w.w = pg8::cvt_pk_bf16(v1[2], v1[3]);
                    *(u32x4*)(HM + (size_t)r * DFF + c) = w; } }
    }
};


template <int NC, int NPART, class Epi>
__device__ __forceinline__ void small_gemm(const Frame& F, const bf16* A, int lda, int a_part, const bf16* Bt, int ldb, int b_part, int K, int N, const Epi& E) {
    constexpr int NF = (NC + 15) / 16, NCP = NF * 16;
    LAS float* red = (LAS float*)F.lds;
    const int lane = F.lane, lr = lane & 15, lk = lane >> 4, ks = K / 8, kbeg = F.wave * ks;
    for (int ch = F.vcu; ch < N / NC; ch += F.G) {
        const int n0 = ch * NC;
        f32x4 acc[NPART][4][NF];
#pragma unroll
        for (int p = 0; p < NPART; ++p)
#pragma unroll
            for (int m = 0; m < 4; ++m)
#pragma unroll
                for (int nf = 0; nf < NF; ++nf) acc[p][m][nf] = (f32x4){0.f, 0.f, 0.f, 0.f};
#pragma unroll
        for (int p = 0; p < NPART; ++p) {
            const bf16* Ap = A + p * a_part + (size_t)lr * lda + kbeg + lk * 8;
            const bf16* Bp[NF];
#pragma unroll
            for (int nf = 0; nf < NF; ++nf) { int col = nf * 16 + lr; col = col < NC ? col : NC - 1; Bp[nf] = Bt + p * b_part + (size_t)(n0 + col) * ldb + kbeg + lk * 8; }
#pragma unroll 4
            for (int k = 0; k < ks; k += 32) {
                bf16x8 af[4], bfr[NF];
#pragma unroll
                for (int m = 0; m < 4; ++m) af[m] = *(const bf16x8*)(Ap + (size_t)(m * 16) * lda + k);
#pragma unroll
                for (int nf = 0; nf < NF; ++nf) bfr[nf] = *(const bf16x8*)(Bp[nf] + k);
#pragma unroll
                for (int m = 0; m < 4; ++m)
#pragma unroll
                    for (int nf = 0; nf < NF; ++nf) acc[p][m][nf] = __builtin_amdgcn_mfma_f32_16x16x32_bf16(af[m], bfr[nf], acc[p][m][nf], 0, 0, 0);
            }
        }
        __syncthreads();
#pragma unroll
        for (int p = 0; p < NPART; ++p)
#pragma unroll
            for (int m = 0; m < 4; ++m)
#pragma unroll
                for (int nf = 0; nf < NF; ++nf)
#pragma unroll
                    for (int i = 0; i < 4; ++i) red[((F.wave * NPART + p) * 64 + m * 16 + lk * 4 + i) * NCP + nf * 16 + lr] = acc[p][m][nf][i];
        __syncthreads();
        for (int e = F.tid; e < 64 * NC; e += 512) { const int row = e / NC, col = e % NC; float v[NPART];
#pragma unroll
            for (int p = 0; p < NPART; ++p) { float sacc = 0.f;
#pragma unroll
                for (int w = 0; w < 8; ++w) sacc += red[((w * NPART + p) * 64 + row) * NCP + col];
                v[p] = sacc; }
            E(row, n0 + col, v); }
    }
    __syncthreads();
}
struct SEpiProj { const bf16* P; bf16* MIX;
    __device__ __forceinline__ void operator()(int row, int c, const float (&v)[2]) const { const int r = MP + row;
        const float o = sigmoidf_(bf2f(*PX(P, r, PC_MA + c))) * v[0] + sigmoidf_(bf2f(*PX(P, r, PC_MC + c))) * v[1]; MIX[(size_t)r * D + c] = (bf16)f2bf(o); } };
template <int WHICH> struct SEpiRes { Args a;
    __device__ __forceinline__ void operator()(int row, int c, const float (&v)[1]) const { const int r = MP + row; const float* ada = (const float*)(a.ws + WS_ADA);
        const float base = WHICH ? ((const float*)(a.ws + WS_X1))[(size_t)r * D + c] : a.x_s[(size_t)row * D + c];
        const float gate = ada[(size_t)batch_of(r) * 6 * D + (WHICH ? 5 * D : 2 * D) + c];
        ((float*)(a.ws + (WHICH ? WS_X2 : WS_X1)))[(size_t)r * D + c] = base + gate * v[0]; } };
struct SEpiRelu2 { bf16* HM;
    __device__ __forceinline__ void operator()(int row, int c, const float (&v)[1]) const { const float p = fmaxf(v[0], 0.f); HM[(size_t)(MP + row) * DFF + c] = (bf16)f2bf(p * p); } };


__device__ __forceinline__ void ph_compress_prompt(const Args& a, const Frame& F) {
    LAS float* red = (LAS float*)F.lds;
    const bf16* kv6 = (const bf16*)(a.ws + WS_KV6); const bf16* wct = (const bf16*)(a.ws + WS_WC_T); float* partp = (float*)(a.ws + WS_PARTP);
    const int lane = F.lane, lr = lane & 15, lk = lane >> 4, kbeg = F.wave * 256;
#pragma unroll 1
    for (int unit = F.vcu; unit < 256; unit += F.G) {
        const int kind = unit >> 7, rb = (unit >> 2) & 31, cb = unit & 3;
        const bf16* Ap = kv6 + (size_t)kind * NBP * NKV * SEQ * HD + (size_t)(rb * 64 + lr) * 2048 + kbeg + lk * 8;
        const bf16* Bp = wct + (size_t)(kind * 256 + cb * 64 + lr) * 2048 + kbeg + lk * 8;
        f32x4 acc[4][4];
#pragma unroll
        for (int m = 0; m < 4; ++m)
#pragma unroll
            for (int n = 0; n < 4; ++n) acc[m][n] = (f32x4){0.f, 0.f, 0.f, 0.f};
#pragma unroll 2
        for (int k = 0; k < 256; k += 32) {
            bf16x8 af[4], bfr[4];
#pragma unroll
            for (int m = 0; m < 4; ++m) af[m] = *(const bf16x8*)(Ap + (size_t)(m * 16) * 2048 + k);
#pragma unroll
            for (int n = 0; n < 4; ++n) bfr[n] = *(const bf16x8*)(Bp + (size_t)(n * 16) * 2048 + k);
#pragma unroll
            for (int m = 0; m < 4; ++m)
#pragma unroll
                for (int n = 0; n < 4; ++n) acc[m][n] = __builtin_amdgcn_mfma_f32_16x16x32_bf16(af[m], bfr[n], acc[m][n], 0, 0, 0);
        }
        __syncthreads();
#pragma unroll
        for (int m = 0; m < 4; ++m)
#pragma unroll
            for (int n = 0; n < 4; ++n)
#pragma unroll
                for (int i = 0; i < 4; ++i) red[(F.wave * 64 + m * 16 + lk * 4 + i) * 64 + n * 16 + lr] = acc[m][n][i];
        __syncthreads();
        for (int e = F.tid; e < 64 * 64; e += 512) { const int row = e >> 6, col = e & 63; float sacc = 0.f;
#pragma unroll
            for (int w = 0; w < 8; ++w) sacc += red[(w * 64 + row) * 64 + col];
            partp[(size_t)(rb * 64 + row) * 512 + kind * 256 + cb * 64 + col] = sacc; }
    }
    __syncthreads();
}

__device__ __forceinline__ float gelu_tanh(float x) { const float u = 0.7978845608028654f * (x + 0.044715f * x * x * x); return 0.5f * x * (1.0f + tanhf(u)); }
template <int SAMPLE> __device__ __forceinline__ void ph_cmp_finish(const Args& a, const Frame& F, size_t out_off) {
    constexpr int NB = SAMPLE ? NBS : NBP, NCH = SAMPLE ? 1024 : 128, NC = NCH - 1;
    const float* part = (const float*)(a.ws + (SAMPLE ? WS_PARTS : WS_PARTP)); float* kc = (float*)(a.ws + out_off);
    const float* peb = (const float*)(a.ws + WS_PEB);
    LAS float* gl = (LAS float*)F.lds + F.wave * 128;
    const int gw = F.vcu * 8 + F.wave, NGW = F.G * 8;
    for (int it = gw; it < 2 * NB * NKV * NC; it += NGW) {
        const int c = it % NC, q = it / NC, kvh = q % NKV, b = (q / NKV) % NB, kind = q / (NKV * NB);
        const size_t row = ((size_t)b * NKV + kvh) * NCH + c;
        const float* w2 = kind ? a.wcv2 : a.wck2;
#pragma unroll
        for (int j = 0; j < 2; ++j) { const int f = F.lane + 64 * j;
            const float h = part[row * 512 + kind * 256 + f] + part[(row + 1) * 512 + kind * 256 + 128 + f] + peb[kind * 128 + f];
            gl[f] = gelu_tanh(h); }
        asm volatile("s_waitcnt lgkmcnt(0)" ::: "memory");
        float o0 = 0.f, o1 = 0.f;
        for (int f = 0; f < 128; ++f) { const float gv = gl[f]; o0 += gv * w2[f * 128 + F.lane]; o1 += gv * w2[f * 128 + 64 + F.lane]; }
        float* dst = kc + ((((size_t)kind * NB + b) * NKV + kvh) * NCH + c) * HD;
        dst[F.lane] = o0; dst[64 + F.lane] = o1;
        asm volatile("s_waitcnt lgkmcnt(0)" ::: "memory");
    }
}

struct WaveAtt { LAS float* qs; LAS float* pb; float o[4][2]; float m[4]; float l[4]; };
__device__ __forceinline__ void att_load_q(const bf16* P, int r, int kvh, WaveAtt& W, int lane) {
#pragma unroll
    for (int j = 0; j < 4; ++j) { const unsigned w = *(const unsigned*)PX(P, r, PC_Q + kvh * 512 + (lane + 64 * j) * 2);   W.qs[(lane + 64 * j) * 2] = lo_bf(w); W.qs[(lane + 64 * j) * 2 + 1] = hi_bf(w); }
    asm volatile("s_waitcnt lgkmcnt(0)" ::: "memory");
}
__device__ __forceinline__ void att_init(WaveAtt& W) {
#pragma unroll
    for (int g = 0; g < 4; ++g) { W.o[g][0] = 0.f; W.o[g][1] = 0.f; W.m[g] = -1e30f; W.l[g] = 0.f; }
}
template <class T> __device__ __forceinline__ void att_dot4(const T* krow, const WaveAtt& W, float (&s)[4]) {
    s[0] = s[1] = s[2] = s[3] = 0.f;
#pragma unroll 8
    for (int d = 0; d < 128; d += 8) {
        float kv[8];
        if constexpr (sizeof(T) == 4) { const f32x4 a0 = *(const f32x4*)((const float*)krow + d), a1 = *(const f32x4*)((const float*)krow + d + 4);
            kv[0] = a0[0]; kv[1] = a0[1]; kv[2] = a0[2]; kv[3] = a0[3]; kv[4] = a1[0]; kv[5] = a1[1]; kv[6] = a1[2]; kv[7] = a1[3]; }
        else { const u32x4 a0 = *(const u32x4*)((const bf16*)krow + d);
#pragma unroll
            for (int e = 0; e < 4; ++e) { kv[2 * e] = lo_bf(a0[e]); kv[2 * e + 1] = hi_bf(a0[e]); } }
#pragma unroll
        for (int g = 0; g < 4; ++g) { const f32x4 q0 = *(const LAS f32x4*)(W.qs + g * 128 + d), q1 = *(const LAS f32x4*)(W.qs + g * 128 + d + 4);
            s[g] += (kv[0] * q0[0] + kv[1] * q0[1]) + (kv[2] * q0[2] + kv[3] * q0[3]) + (kv[4] * q1[0] + kv[5] * q1[1]) + (kv[6] * q1[2] + kv[7] * q1[3]); }
    }
}
#ifndef PVB
#define PVB 16
#endif
#ifndef PVS
#define PVS 32
#endif
template <class T, int NB> __device__ __forceinline__ void att_pv_load(const T* V, size_t vstride, int jb, int lane, const T* Valt, int nalt, float (&v0)[NB], float (&v1)[NB]) {
    const T* vb = V + (size_t)(jb * NB) * vstride;
#pragma unroll
    for (int u = 0; u < NB; ++u) { const T* vr = (jb == 0 && u < nalt) ? Valt + (size_t)u * vstride : vb + (size_t)u * vstride;
        if constexpr (sizeof(T) == 4) { const f32x2 v = *(const f32x2*)((const float*)vr + 2 * lane); v0[u] = v[0]; v1[u] = v[1]; }
        else { const unsigned w = *(const unsigned*)((const bf16*)vr + 2 * lane); v0[u] = lo_bf(w); v1[u] = hi_bf(w); } }
}
template <int NB> __device__ __forceinline__ void att_pv_fma(int jb, int nk, const float (&v0)[NB], const float (&v1)[NB], WaveAtt& W) {
#pragma unroll
    for (int u = 0; u < NB; ++u) { f32x4 p = *(const LAS f32x4*)(W.pb + (jb * NB + u) * 4); if (jb * NB + u >= nk) p = (f32x4){0.f, 0.f, 0.f, 0.f};
#pragma unroll
        for (int g = 0; g < 4; ++g) { W.o[g][0] += p[g] * v0[u]; W.o[g][1] += p[g] * v1[u]; }
        if ((u & 7) == 7) __builtin_amdgcn_sched_barrier(0); }
}
template <class T> __device__ __forceinline__ void att_pv(const T* V, size_t vstride, int nk, WaveAtt& W, int lane, const T* Valt = nullptr, int nalt = 0) {
    const int nkb = (nk + PVB - 1) / PVB;
#pragma unroll 1
    for (int jb = 0; jb < nkb; ++jb) { float v0[PVB], v1[PVB]; att_pv_load<T, PVB>(V, vstride, jb, lane, Valt, nalt, v0, v1); att_pv_fma<PVB>(jb, nk, v0, v1, W); }
}
template <class T, int PVS_ = PVB> __device__ __forceinline__ void att_segment(const T* K, size_t kstride, const T* V, size_t vstride, int nk, bool valid, WaveAtt& W, int lane, const T* Kalt = nullptr, const T* Valt = nullptr, int nalt = 0) {
    float s[4]; float v0[PVS_], v1[PVS_];
    att_pv_load<T, PVS_>(V, vstride, 0, lane, Valt, nalt, v0, v1);
    if (valid) att_dot4<T>((lane < nalt ? Kalt : K) + (size_t)lane * kstride, W, s); else { s[0] = s[1] = s[2] = s[3] = 0.f; }
    f32x4 p;
#pragma unroll
    for (int g = 0; g < 4; ++g) { const float sv = valid ? s[g] * SCALE : -__builtin_inff();
        const float mx = wave_max(sv), mn = fmaxf(W.m[g], mx), alpha = __expf(W.m[g] - mn), pv = __expf(sv - mn);
        W.l[g] = W.l[g] * alpha + wave_sum(pv); W.o[g][0] *= alpha; W.o[g][1] *= alpha; W.m[g] = mn; p[g] = pv; }
    *(LAS f32x4*)(W.pb + lane * 4) = p;
    asm volatile("s_waitcnt lgkmcnt(0)" ::: "memory");
    att_pv_fma<PVS_>(0, nk, v0, v1, W);
    const int nkb = (nk + PVS_ - 1) / PVS_;
#pragma unroll 1
    for (int jb = 1; jb < nkb; ++jb) { att_pv_load<T, PVS_>(V, vstride, jb, lane, Valt, nalt, v0, v1); att_pv_fma<PVS_>(jb, nk, v0, v1, W); }
    asm volatile("s_waitcnt lgkmcnt(0)" ::: "memory");
}
__device__ __forceinline__ void att_store(float* O, int r, int kvh, const WaveAtt& W, int lane, bool normalise) {
#pragma unroll
    for (int g = 0; g < 4; ++g) { const float inv = normalise ? (W.l[g] > 0.f ? 1.0f / W.l[g] : 0.f) : 1.0f;
        *(f32x2*)(O + (size_t)r * D + (kvh * 4 + g) * 128 + 2 * lane) = (f32x2){W.o[g][0] * inv, W.o[g][1] * inv}; }
}

template <int SAMPLE> __device__ __forceinline__ void ph_cmp_attend(const Args& a, const Frame& F, size_t oc_off = WS_OCMP, size_t sel_off = (SAMPLE ? WS_SELS : WS_SELP)) {
    constexpr int NSEG = SAMPLE ? 16 : 2, NCH = SAMPLE ? 1024 : 128, NC = NCH - 1, NB = SAMPLE ? NBS : NBP, SQ = SAMPLE ? DSQ : SEQ;
    const bf16* P = (const bf16*)(a.ws + WS_P); const float* kcb = (const float*)(a.ws + (SAMPLE ? WS_KCS : WS_KCP));
    float* OC = (float*)(a.ws + oc_off);
    LAS float* wl = (LAS float*)F.lds + F.wave * 4096;
    WaveAtt W; W.qs = wl; W.pb = wl + 512; LAS float* pg = wl + 768 + 4; LAS float* scl = wl + 768 + 1040;
    const int gw = F.vcu * 8 + F.wave, NGW = F.G * 8, lane = F.lane;
#pragma unroll 1
    for (int it = gw; it < NB * NKV * SQ; it += NGW) {
        const int s = it % SQ, kvh = (it / SQ) % NKV, b = it / (SQ * NKV);
        const int r = SAMPLE ? MP + b * DSQ + s : b * SEQ + s, pos = SAMPLE ? PAST + s : s;
        const int nvis = pos >= 31 ? ((pos - 31) / 16 + 1 < NC ? (pos - 31) / 16 + 1 : NC) : 0;
        att_load_q(P, r, kvh, W, lane);
        const float* Kc = kcb + (((size_t)0 * NB + b) * NKV + kvh) * NCH * HD; const float* Vc = kcb + (((size_t)1 * NB + b) * NKV + kvh) * NCH * HD;
        float mx[4] = {-1e30f, -1e30f, -1e30f, -1e30f}, ls[4] = {0.f, 0.f, 0.f, 0.f};
        const int nseg = (nvis + 63) >> 6;
#pragma unroll 1
        for (int sg = 0; sg < nseg; ++sg) { const int c = sg * 64 + lane; const bool valid = c < nvis; float t[4];
            if (valid) att_dot4<float>(Kc + (size_t)c * HD, W, t); else { t[0] = t[1] = t[2] = t[3] = 0.f; }
#pragma unroll
            for (int g = 0; g < 4; ++g) { const float sv = valid ? t[g] * SCALE : -__builtin_inff(); const float m2 = fmaxf(mx[g], wave_max(sv));
                ls[g] = ls[g] * __expf(mx[g] - m2) + wave_sum(__expf(sv - m2)); mx[g] = m2; } }
#pragma unroll
        for (int g = 0; g < 4; ++g) ls[g] = ls[g] > 0.f ? 1.0f / ls[g] : 0.f;
        att_init(W);
        for (int i = lane; i < NSEG * 64; i += 64) pg[i] = 0.f;
#pragma unroll 1
        for (int sg = 0; sg < nseg; ++sg) { const int c = sg * 64 + lane; const bool valid = c < nvis; float t[4];
            if (valid) att_dot4<float>(Kc + (size_t)c * HD, W, t); else { t[0] = t[1] = t[2] = t[3] = 0.f; }
            f32x4 p; float pgs = 0.f;
#pragma unroll
            for (int g = 0; g < 4; ++g) { p[g] = valid ? __expf(t[g] * SCALE - mx[g]) * ls[g] : 0.f; pgs += p[g]; }
            pg[c] = pgs;
            const int base = sg * 64; int nk = nvis - base; nk = nk > 64 ? 64 : nk;
            *(LAS f32x4*)(W.pb + lane * 4) = p; asm volatile("s_waitcnt lgkmcnt(0)" ::: "memory");
            att_pv<float>(Vc + (size_t)base * HD, HD, nk, W, lane); asm volatile("s_waitcnt lgkmcnt(0)" ::: "memory"); }
        att_store(OC, r, kvh, W, lane, false);
        if (lane == 0) { pg[-1] = 0.f; pg[NSEG * 64] = 0.f; }
        asm volatile("s_waitcnt lgkmcnt(0)" ::: "memory");
        const int cur = pos >> 6;
        if constexpr (!SAMPLE) {
            float val = -__builtin_inff();
            if (lane < NSP) { const int n = lane; const float scv = pg[4 * n - 1] + 2.0f * (pg[4 * n] + pg[4 * n + 1] + pg[4 * n + 2]) + pg[4 * n + 3];
                const bool vld = n <= cur, forced = (n == 0) || (n > cur - 2); val = vld ? (forced ? __builtin_inff() : scv) : -__builtin_inff(); }
            int rank = 0;
            for (int k = 0; k < NSP; ++k) { const float vk = __shfl(val, k); rank += (vk > val || (vk == val && k < lane)) ? 1 : 0; }
            const bool sel = lane < NSP && rank < 16 && val > -__builtin_inff();
            const unsigned long long bm = __ballot(sel);
            if (lane == 0) ((unsigned*)(a.ws + sel_off))[((size_t)b * NKV + kvh) * SEQ + s] = (unsigned)bm;
        } else {
            for (int n = lane; n < 256; n += 64) scl[n] = (n >= 1 && n <= 254) ? pg[4 * n - 1] + 2.0f * (pg[4 * n] + pg[4 * n + 1] + pg[4 * n + 2]) + pg[4 * n + 3] : -__builtin_inff();
            asm volatile("s_waitcnt lgkmcnt(0)" ::: "memory");
            unsigned* selw = (unsigned*)(a.ws + sel_off) + (((size_t)b * NKV + kvh) * DSQ + s) * 16;
#pragma unroll
            for (int i = 0; i < 4; ++i) { const int n = lane + 64 * i; const float val = scl[n]; int rank = 0;
#pragma unroll 2
                for (int k = 1; k <= 254; ++k) { const float vk = scl[k]; rank += (vk > val || (vk == val && k < n)) ? 1 : 0; }
                const bool sel = (n >= 1 && n <= 254 && rank < 13) || n == 0 || n == 255;
                const unsigned long long bm = __ballot(sel);
                if (lane == 0) { selw[2 * i] = (unsigned)bm; selw[2 * i + 1] = (unsigned)(bm >> 32); } }
            if (lane == 0) selw[8] = 1u;
        }
        asm volatile("s_waitcnt lgkmcnt(0)" ::: "memory");
    }
}
template <int SAMPLE> __device__ __forceinline__ void ph_slc_attend(const Args& a, const Frame& F, size_t out_off = WS_OSLC) {
    constexpr int NB = SAMPLE ? NBS : NBP, SQ = SAMPLE ? DSQ : SEQ;
    const bf16* P = (const bf16*)(a.ws + WS_P); const bf16* KV6 = (const bf16*)(a.ws + WS_KV6); float* OS = (float*)(a.ws + out_off);
    LAS float* wl = (LAS float*)F.lds + F.wave * 1024; WaveAtt W; W.qs = wl; W.pb = wl + 512;
    const int gw = F.vcu * 8 + F.wave, NGW = F.G * 8, lane = F.lane;
#pragma unroll 1
    for (int it = gw; it < NB * NKV * SQ; it += NGW) {
        const int s = it % SQ, kvh = (it / SQ) % NKV, b = it / (SQ * NKV);
        const int r = SAMPLE ? MP + b * DSQ + s : b * SEQ + s;
        att_load_q(P, r, kvh, W, lane); att_init(W);
        if constexpr (!SAMPLE) {
            const unsigned mask = ((const unsigned*)(a.ws + WS_SELP))[((size_t)b * NKV + kvh) * SEQ + s];
            const bf16* Kb = KV6 + (((size_t)2 * NBP + b) * NKV + kvh) * SEQ * HD; const bf16* Vb = KV6 + (((size_t)3 * NBP + b) * NKV + kvh) * SEQ * HD;
#pragma unroll 1
            for (int n = 0; n < NSP; ++n) if ((mask >> n) & 1u) { const int k0 = n * 64; int nk = s - k0 + 1; nk = nk > 64 ? 64 : nk; if (nk <= 0) continue;
                att_segment<bf16>(Kb + (size_t)k0 * HD, HD, Vb + (size_t)k0 * HD, HD, nk, lane < nk, W, lane); }
        } else {
            const unsigned* selw = (const unsigned*)(a.ws + WS_SELS) + (((size_t)b * NKV + kvh) * DSQ + s) * 16;
#pragma unroll 1
            for (int n = 0; n < 256; ++n) if ((selw[n >> 5] >> (n & 31)) & 1u) {
                const int page = a.ptab[b * NPAGES + (n >> 1)];
                const float* base = a.cache + ((size_t)page * PAGE + (n & 1) * 64) * 2048 + kvh * HD;
                att_segment<float>(base + 2 * 512, 2048, base + 3 * 512, 2048, 64, true, W, lane); }
            att_segment<bf16>(PX(P, MP + b * DSQ, PC_KV + 2 * 512 + kvh * HD), PRS, PX(P, MP + b * DSQ, PC_KV + 3 * 512 + kvh * HD), PRS, s + 1, lane <= s, W, lane);
        }
        att_store(OS, r, kvh, W, lane, true);
    }
}
template <int SAMPLE> __device__ __forceinline__ void ph_win_attend(const Args& a, const Frame& F, size_t out_off = WS_OWIN) {
    constexpr int NB = SAMPLE ? NBS : NBP, SQ = SAMPLE ? DSQ : SEQ;
    const bf16* P = (const bf16*)(a.ws + WS_P); const bf16* KV6 = (const bf16*)(a.ws + WS_KV6); float* OW = (float*)(a.ws + out_off);
    LAS float* wl = (LAS float*)F.lds + F.wave * 1024; WaveAtt W; W.qs = wl; W.pb = wl + 512;
    const int gw = F.vcu * 8 + F.wave, NGW = F.G * 8, lane = F.lane;
#pragma unroll 1
    for (int it = gw; it < NB * NKV * SQ; it += NGW) {
        const int s = it % SQ, kvh = (it / SQ) % NKV, b = it / (SQ * NKV);
        const int r = SAMPLE ? MP + b * DSQ + s : b * SEQ + s;
        att_load_q(P, r, kvh, W, lane); att_init(W);
        if constexpr (!SAMPLE) {
            const bf16* Kb = KV6 + (((size_t)4 * NBP + b) * NKV + kvh) * SEQ * HD; const bf16* Vb = KV6 + (((size_t)5 * NBP + b) * NKV + kvh) * SEQ * HD;
            const int lo = s - 511 > 0 ? s - 511 : 0;
#pragma unroll 1
            for (int k0 = (lo >> 6) << 6; k0 <= s; k0 += 64) { int nk = s - k0 + 1; nk = nk > 64 ? 64 : nk; const int kp = k0 + lane;
                att_segment<bf16>(Kb + (size_t)k0 * HD, HD, Vb + (size_t)k0 * HD, HD, nk, kp >= lo && kp <= s, W, lane); }
        } else {
            const float* st = a.st_win + (size_t)b * 512 * 1024 + kvh * HD;
#pragma unroll 1
            for (int i0 = 0; i0 < 512; i0 += 64) { const int i = i0 + lane;
                att_segment<float>(st + (size_t)i0 * 1024, 1024, st + (size_t)i0 * 1024 + 512, 1024, 64, i > s, W, lane); }
            att_segment<bf16>(PX(P, MP + b * DSQ, PC_KWIN + kvh * HD), PRS, PX(P, MP + b * DSQ, PC_VWIN + kvh * HD), PRS, s + 1, lane <= s, W, lane);
        }
        att_store(OW, r, kvh, W, lane, true);
    }
    if constexpr (SAMPLE) {
        float* ow = a.out + OUT_WINS;
        for (size_t i = (size_t)(F.vcu * 512 + F.tid); i < (size_t)NBS * 504 * 256; i += (size_t)F.G * 512) { const size_t b = i / (504 * 256), rem = i % (504 * 256);
            *(f32x4*)(ow + b * 512 * 1024 + rem * 4) = *(const f32x4*)(a.st_win + b * 512 * 1024 + 8 * 1024 + rem * 4); }
    }
}


namespace fa {
constexpr int NW = 8, QBLK = 32, KVBLK = 64, QB = NW * QBLK, DH = 128;
constexpr int SHM_V = KVBLK * DH * 2, SHM_K = KVBLK * DH * 2;
constexpr int FA_LDS_BYTES = 2 * SHM_V + 2 * SHM_K + NW * 64 * 4;
constexpr float THR = 8.f;
constexpr int QS = PRS;
constexpr int OS = D;
typedef float f32x16 __attribute__((ext_vector_type(16)));
typedef short s16x4 __attribute__((ext_vector_type(4)));
#define KSWZ(row, colB) ((row) * 256 + ((colB) ^ (((row) & 7) << 4)))
#define SBAR() __builtin_amdgcn_sched_barrier(0)
__device__ __forceinline__ int v_st(int k, int c) { const int kk = (k & ~0xC) | ((k & 4) << 1) | ((k & 8) >> 1); return ((kk >> 3) * 4 + (c >> 5)) * 512 + ((kk & 7) * 32 + (c & 31)) * 2; }
__device__ __forceinline__ int v_rd_base(int lane) { return ((lane & 3) << 3) | (((lane >> 2) & 3) << 6) | (((lane >> 4) & 1) << 5) | (((lane >> 5) & 1) << 8); }
constexpr int v_rd_off(int d0, int ks, int half) { return d0 * 512 + ks * 4096 + half * 2048; }
__device__ __forceinline__ int crow(int r, int hi) { return (r & 3) + 8 * (r >> 2) + 4 * hi; }
__device__ __forceinline__ unsigned cvtpk(float lo, float hi) { unsigned r; asm volatile("v_cvt_pk_bf16_f32 %0, %1, %2" : "=v"(r) : "v"(lo), "v"(hi)); return r; }
__device__ __forceinline__ bf16x8 load8(const bf16* p) { return *reinterpret_cast<const bf16x8*>(p); }
__device__ __forceinline__ void mask_tile(f32x16& p0, f32x16& p1, int dq, unsigned W) {
    const float NEG = -__builtin_inff();
#pragma unroll
    for (int r = 0; r < 16; ++r) {
        const int c = (r & 3) + 8 * (r >> 2);
        if ((unsigned)(dq - c) >= W) p0[r] = NEG;
        if ((unsigned)(dq - c - 32) >= W) p1[r] = NEG;
    }
}
__device__ __forceinline__ void partialSM(f32x16& p0, f32x16& p1, float& m_reg, float& mn, float& alpha) {
    float pmax = p0[0]; for (int r = 1; r < 16; ++r) pmax = fmaxf(pmax, p0[r]); for (int r = 0; r < 16; ++r) pmax = fmaxf(pmax, p1[r]);
    { auto rr = __builtin_amdgcn_permlane32_swap(__float_as_uint(pmax), __float_as_uint(pmax), false, false);
      pmax = fmaxf(__uint_as_float(rr[0]), __uint_as_float(rr[1])); }
    constexpr float C2 = 1.4426950408889634f * SCALE;
    if (__builtin_expect(__all((pmax - m_reg) * SCALE <= THR), 1)) { mn = m_reg; alpha = 1.f; }
    else { mn = fmaxf(m_reg, pmax); alpha = __builtin_amdgcn_exp2f((m_reg - mn) * C2); m_reg = mn; }
    const float mnL = -mn * C2;
    for (int r = 0; r < 16; ++r) p0[r] = fmaf(p0[r], C2, mnL); for (int r = 0; r < 16; ++r) p1[r] = fmaf(p1[r], C2, mnL);
    for (int r = 0; r < 16; ++r) p0[r] = __builtin_amdgcn_exp2f(p0[r]);
}
__device__ __forceinline__ void finishSM(f32x16& p0, f32x16& p1, float alpha, float& l_reg, bf16x8& pa0, bf16x8& pa1, bf16x8& pa2, bf16x8& pa3) {
    for (int r = 0; r < 16; ++r) p1[r] = __builtin_amdgcn_exp2f(p1[r]);
    float ps = 0; for (int r = 0; r < 16; ++r) ps += p0[r]; for (int r = 0; r < 16; ++r) ps += p1[r];
    { auto rr = __builtin_amdgcn_permlane32_swap(__float_as_uint(ps), __float_as_uint(ps), false, false);
      ps = __uint_as_float(rr[0]) + __uint_as_float(rr[1]); }
    l_reg = l_reg * alpha + ps;
#define PK4(P, B_, OUT) do { unsigned a0 = cvtpk(P[B_+0], P[B_+1]), a1 = cvtpk(P[B_+2], P[B_+3]);                          \
        unsigned b0 = cvtpk(P[B_+4], P[B_+5]), b1 = cvtpk(P[B_+6], P[B_+7]);                                             \
        auto r0 = __builtin_amdgcn_permlane32_swap(a0, b0, false, false); auto r1 = __builtin_amdgcn_permlane32_swap(a1, b1, false, false); \
        u32x4 w = {r0[0], r1[0], r0[1], r1[1]}; OUT = *reinterpret_cast<bf16x8*>(&w); } while (0)
    PK4(p0, 0, pa0); PK4(p0, 8, pa1); PK4(p1, 0, pa2); PK4(p1, 8, pa3);
#undef PK4
}
template <int KB>
__device__ __forceinline__ void qkt(f32x16& p0, f32x16& p1, const char* K_lds, int r32, int hi, const bf16x8* qr) {
    p0 = f32x16{}; p1 = f32x16{};
    const char* kb[4];
#pragma unroll
    for (int dd = 0; dd < 4; ++dd) kb[dd] = K_lds + KB * SHM_K + KSWZ(r32, (dd * 16 + hi * 8) * 2);
#pragma unroll
    for (int d0 = 0; d0 < 8; ++d0) { const char* a = kb[d0 & 3] + (d0 >> 2) * 128;
        bf16x8 b0 = *reinterpret_cast<const bf16x8*>(a);
        bf16x8 b1 = *reinterpret_cast<const bf16x8*>(a + 32 * 256);
        p0 = __builtin_amdgcn_mfma_f32_32x32x16_bf16(b0, qr[d0], p0, 0, 0, 0);
        p1 = __builtin_amdgcn_mfma_f32_32x32x16_bf16(b1, qr[d0], p1, 0, 0, 0); }
}
template <int VB>
__device__ __forceinline__ void pv_tile(f32x16* o, int vb0, bf16x8 pa0, bf16x8 pa1, bf16x8 pa2, bf16x8 pa3) {
#define TRRD(dst, off) asm volatile("ds_read_b64_tr_b16 %0, %1 offset:%2" : "=&v"(dst) : "v"(vb0), "i"(off) : "memory")
#define PV_D0(d0) do { s16x4 l0, l1, l2, l3, h0, h1, h2, h3; constexpr int b_ = VB * SHM_V + v_rd_off(d0, 0, 0); \
        TRRD(l0, b_); TRRD(h0, b_ + 2048); TRRD(l1, b_ + 4096); TRRD(h1, b_ + 6144); TRRD(l2, b_ + 8192); TRRD(h2, b_ + 10240); TRRD(l3, b_ + 12288); TRRD(h3, b_ + 14336); \
        asm volatile("s_waitcnt lgkmcnt(0)" ::: "memory"); SBAR();   \
        o[d0] = __builtin_amdgcn_mfma_f32_32x32x16_bf16(pa0, (bf16x8){l0[0], l0[1], l0[2], l0[3], h0[0], h0[1], h0[2], h0[3]}, o[d0], 0, 0, 0);   \
        o[d0] = __builtin_amdgcn_mfma_f32_32x32x16_bf16(pa1, (bf16x8){l1[0], l1[1], l1[2], l1[3], h1[0], h1[1], h1[2], h1[3]}, o[d0], 0, 0, 0);   \
        o[d0] = __builtin_amdgcn_mfma_f32_32x32x16_bf16(pa2, (bf16x8){l2[0], l2[1], l2[2], l2[3], h2[0], h2[1], h2[2], h2[3]}, o[d0], 0, 0, 0);   \
        o[d0] = __builtin_amdgcn_mfma_f32_32x32x16_bf16(pa3, (bf16x8){l3[0], l3[1], l3[2], l3[3], h3[0], h3[1], h3[2], h3[3]}, o[d0], 0, 0, 0); } while (0)
    PV_D0(0); PV_D0(1); PV_D0(2); PV_D0(3);
#undef PV_D0
#undef TRRD
}
struct BlockRef { const bf16* Q; const bf16* K; const bf16* V; float* O; const unsigned* sel; const bf16* gate; int P0, W; };
struct Seam { bf16x8 qr[8]; bf16x8 st_v0, st_v1, st_k0, st_k1; };
__device__ __forceinline__ int swa_jlo(int P0, int W) { const int lowk = P0 - W + 1; return lowk > 0 ? lowk / KVBLK : 0; }
#define ROW(p, k0, rr) ((p) + (size_t)((k0) + (rr)) * DH + sc)
#define VMW() asm volatile("s_waitcnt vmcnt(0)" ::: "memory")
#define VMWN(n) asm volatile("s_waitcnt vmcnt(%0)" :: "i"(n) : "memory")
#define SLOAD_H(Kp, Vp, k0) do { S.st_v0 = load8(ROW(Vp, k0, sr)); S.st_v1 = load8(ROW(Vp, k0, 32 + sr));              \
                         S.st_k0 = load8(ROW(Kp, k0, sr)); S.st_k1 = load8(ROW(Kp, k0, 32 + sr)); } while (0)
#define SWRITE_HK(bf) do { *(bf16x8*)(K_lds + (bf) * SHM_K + kws) = S.st_k0; *(bf16x8*)(K_lds + (bf) * SHM_K + kws + 32 * 256) = S.st_k1; } while (0)
#define SWRITE_HV(bf) do { *(bf16x8*)(V_lds + (bf) * SHM_V + vst0) = S.st_v0; *(bf16x8*)(V_lds + (bf) * SHM_V + vst1) = S.st_v1; } while (0)
#define SWRITE_H(bf) do { SWRITE_HV(bf); SWRITE_HK(bf); } while (0)
__device__ __forceinline__ void prime(const BlockRef& cur, char* lds, Seam& S) {
    const int tid = threadIdx.x, wid = __builtin_amdgcn_readfirstlane(tid >> 6), lane = tid & 63, r32 = lane & 31, hi = lane >> 5;
    const int sr = tid >> 4, sc = (tid & 15) * 8, kws = KSWZ(sr, sc * 2); char* K_lds = lds + 2 * SHM_V;
    const int kb0 = swa_jlo(cur.P0, cur.W) * KVBLK;
    for (int d0 = 0; d0 < 8; ++d0) S.qr[d0] = load8(cur.Q + (size_t)(wid * QBLK + r32) * QS + d0 * 16 + hi * 8);
    SLOAD_H(cur.K, cur.V, kb0); VMW(); SWRITE_HK(0);
    __syncthreads();
}
__device__ __forceinline__ void block(const BlockRef& cur, const BlockRef& nxt, int skv, char* lds, Seam& S) {
    int tid_ = threadIdx.x; asm volatile("" : "+v"(tid_));
    const int tid = tid_, wid = __builtin_amdgcn_readfirstlane(tid >> 6), lane = tid & 63, r32 = lane & 31, hi = lane >> 5;
    const int W = cur.W;
    const int j_lo = swa_jlo(cur.P0, W);
    int j_hi = (cur.P0 + QB - 1) / KVBLK + 1; if (j_hi > skv / KVBLK) j_hi = skv / KVBLK;
    const int NT = j_hi - j_lo;
    const int kbn = swa_jlo(nxt.P0, nxt.W) * KVBLK;
    const int qlo = cur.P0 + wid * QBLK, qm = qlo + r32 - 4 * hi;
    char* V_lds = lds; char* K_lds = lds + 2 * SHM_V;
    float* ws = (float*)(lds + 2 * SHM_V + 2 * SHM_K) + wid * 64; float* li_l = ws, * al_l = ws + 32;
    float m_reg = -1e30f, l_reg = 0; f32x16 o[4] = {};
    const int sr = tid >> 4, sc = (tid & 15) * 8, vst0 = v_st(sr, sc), vst1 = v_st(32 + sr, sc), kws = KSWZ(sr, sc * 2);
    const int vb0 = (int)(uintptr_t)V_lds + v_rd_base(lane);
    const bf16* Kh = cur.K; const bf16* Vh = cur.V;
    const bool hasSel = cur.sel != nullptr;
    const unsigned selmask = hasSel ? cur.sel[qlo + r32] : 0xffffffffu;
#define RESC(a) do { if (__any((a) < 1.f)) { if (hi == 0) al_l[r32] = (a); asm volatile("s_waitcnt lgkmcnt(0)" ::: "memory");              \
                     for (int d_ = 0; d_ < 4; ++d_) for (int r = 0; r < 16; ++r) o[d_][r] *= al_l[crow(r, hi)]; } } while (0)
#define KBASE(t) ((j_lo + (t)) * KVBLK)
#define MASKT(P0_, P1_, t) do { const int kb_ = KBASE(t); if (kb_ + KVBLK - 1 > qlo || kb_ <= qlo + QBLK - 1 - W) mask_tile(P0_, P1_, qm - kb_, (unsigned)W); \
        if (hasSel) { const bool off_ = ((selmask >> (j_lo + (t))) & 1u) == 0u; const float NEG_ = -__builtin_inff(); \
            _Pragma("unroll") for (int r_ = 0; r_ < 16; ++r_) { P0_[r_] = off_ ? NEG_ : P0_[r_]; P1_[r_] = off_ ? NEG_ : P1_[r_]; } } } while (0)
    constexpr int NQL = 8;
#define SEAM_K0() do { VMWN(NQL); SWRITE_HK(0); SBAR(); } while (0)
    f32x16 pA0, pA1, pB0, pB1; float mnA, mnB, alA, alB; bf16x8 pa0, pa1, pa2, pa3;
    SWRITE_HV(0); SBAR();
    if (NT > 1) { SLOAD_H(Kh, Vh, KBASE(1)); }
    SBAR(); qkt<0>(pA0, pA1, K_lds, r32, hi, S.qr);
    MASKT(pA0, pA1, 0); partialSM(pA0, pA1, m_reg, mnA, alA);
    if (NT > 1) { VMW(); SWRITE_H(1); }
    __syncthreads();
#define HALF_STEP(PX0, PX1, mnX, alX, PY0, PY1, alY, t, KB, VB, SB) do {                                                      \
        SBAR(); qkt<KB>(PX0, PX1, K_lds, r32, hi, S.qr);                                             \
        finishSM(PY0, PY1, alY, l_reg, pa0, pa1, pa2, pa3); SBAR();                                                           \
        if ((t) + 1 < NT) { SLOAD_H(Kh, Vh, KBASE((t) + 1)); SBAR(); }                                               \
        pv_tile<VB>(o, vb0, pa0, pa1, pa2, pa3); MASKT(PX0, PX1, (t)); partialSM(PX0, PX1, m_reg, mnX, alX);                                        \
        __syncthreads();                                                                                                      \
        if ((t) + 1 < NT) { VMW(); SWRITE_H(SB); }                                                                          \
        RESC(alX); __syncthreads(); } while (0)
    for (int t = 1; t + 1 < NT; t += 2) {
        HALF_STEP(pB0, pB1, mnB, alB, pA0, pA1, alA, t, 1, 0, 0);
        HALF_STEP(pA0, pA1, mnA, alA, pB0, pB1, alB, t + 1, 0, 1, 1);
    }
    const bool even = (NT & 1) == 0;
    if (even) { SBAR(); qkt<1>(pB0, pB1, K_lds, r32, hi, S.qr); SBAR(); }
    { SLOAD_H(nxt.K, nxt.V, kbn); SBAR();
#pragma unroll
        for (int d0 = 0; d0 < 8; ++d0) S.qr[d0] = load8(nxt.Q + (size_t)(wid * QBLK + r32) * QS + d0 * 16 + hi * 8); }
    SBAR();
    finishSM(pA0, pA1, alA, l_reg, pa0, pa1, pa2, pa3); SBAR();
    pv_tile<0>(o, vb0, pa0, pa1, pa2, pa3);
    if (even) { MASKT(pB0, pB1, NT - 1); partialSM(pB0, pB1, m_reg, mnB, alB); __syncthreads(); RESC(alB);
        finishSM(pB0, pB1, alB, l_reg, pa0, pa1, pa2, pa3); SBAR(); pv_tile<1>(o, vb0, pa0, pa1, pa2, pa3); }
    SBAR(); SEAM_K0();
    if (hi == 0) li_l[r32] = l_reg; asm volatile("s_waitcnt lgkmcnt(0)" ::: "memory");
    float rli[16];
#pragma unroll
    for (int r = 0; r < 16; ++r) rli[r] = __builtin_amdgcn_rcpf(li_l[crow(r, hi)]);
#if GATED
    bf16* Ow = (bf16*)cur.O + (size_t)(wid * QBLK) * OS;
    bf16 graw[16];
#pragma unroll
    for (int r = 0; r < 16; ++r) graw[r] = cur.gate[(size_t)(wid * QBLK + crow(r, hi)) * QS];
#pragma unroll
    for (int r = 0; r < 16; ++r) { const int orow = crow(r, hi);
        const float sc_ = rli[r] * sigmoidf_(bf2f(graw[r]));
#pragma unroll
        for (int dp = 0; dp < 2; ++dp) { const float va = o[dp][r] * sc_, vb = o[dp + 2][r] * sc_, na = dpp_xor1(va), nb = dpp_xor1(vb);
            const bool odd = r32 & 1; *(unsigned*)(Ow + (size_t)orow * OS + (odd ? dp + 2 : dp) * 32 + (r32 & ~1)) = cvtpk(odd ? nb : va, odd ? vb : na); } }
#else
    float* Ow = cur.O + (size_t)(wid * QBLK) * OS;
#pragma unroll
    for (int r = 0; r < 16; ++r) { const int orow = crow(r, hi);
#pragma unroll
        for (int d0 = 0; d0 < 4; ++d0) Ow[(size_t)orow * OS + d0 * 32 + r32] = o[d0][r] * rli[r]; }
#endif
    __syncthreads();
#undef RESC
#undef KBASE
#undef MASKT
#undef SEAM_K0
#undef HALF_STEP
}
#undef ROW
#undef VMW
#undef VMWN
#undef SLOAD_H
#undef SWRITE_HK
#undef SWRITE_HV
#undef SWRITE_H
}


__device__ __forceinline__ float gelu_fast(float x) { const float u = 0.7978845608028654f * (x + 0.044715f * x * x * x); const float t = 1.0f - 2.0f / (1.0f + __expf(2.0f * u)); return 0.5f * x * (1.0f + t); }
template <int SAMPLE> __device__ __forceinline__ void ph_cmp_finish_mfma(const Args& a, const Frame& F, char* lds, int widx = -1, int wcnt = 0) {
    constexpr int NB = SAMPLE ? NBS : NBP, NCH = SAMPLE ? 1024 : 128, NC = NCH - 1, NBLK = (NC + 31) / 32, NG = NB * NKV;
    typedef float f32x16 __attribute__((ext_vector_type(16)));
    const float* part = (const float*)(a.ws + (SAMPLE ? WS_PARTS : WS_PARTP)); float* kc = (float*)(a.ws + (SAMPLE ? WS_KCS : WS_KCP));
    const float* peb = (const float*)(a.ws + WS_PEB);
    const int tid = F.tid, lane = F.lane, r32 = lane & 31, hi = lane >> 5;
    __syncthreads();
    for (int i = tid; i < 2 * 128 * 16; i += 512) { const int kind = i >> 11, n = i & 127, ch = (i >> 7) & 15; const float* w2 = (kind ? a.wcv2 : a.wck2) + (size_t)(ch * 8) * 128 + n;
        u32x4 wv = {pk2(w2[0], w2[128]), pk2(w2[256], w2[384]), pk2(w2[512], w2[640]), pk2(w2[768], w2[896])};
        *(u32x4*)(lds + kind * 32768 + n * 256 + ((ch ^ (n & 15)) << 4)) = wv; }
    __syncthreads();
    const int gw = (widx >= 0 ? widx : F.vcu) * 8 + F.wave, NGW = (widx >= 0 ? wcnt : F.G) * 8;
#pragma unroll 1
    for (int it = gw; it < 2 * NG * NBLK; it += NGW) {
        const int blk = it % NBLK, q = it / NBLK, g = q % NG, kind = q / NG, c0 = blk * 32;
        const int c = c0 + r32, cc = c < NC ? c : NC - 1;
        const float* p0 = part + ((size_t)g * NCH + cc) * 512 + kind * 256; const float* p1 = p0 + 512 + 128; const float* pb = peb + kind * 128;
        f32x16 acc[4] = {};
        const char* wl = lds + kind * 32768;
#pragma unroll
        for (int ks = 0; ks < 8; ++ks) { const int f = ks * 16 + hi * 8;
            const f32x4 a0 = *(const f32x4*)(p0 + f), a1 = *(const f32x4*)(p0 + f + 4), b0 = *(const f32x4*)(p1 + f), b1 = *(const f32x4*)(p1 + f + 4), e0 = *(const f32x4*)(pb + f), e1 = *(const f32x4*)(pb + f + 4);
            float gv[8];
#pragma unroll
            for (int e = 0; e < 4; ++e) { gv[e] = gelu_fast(a0[e] + b0[e] + e0[e]); gv[4 + e] = gelu_fast(a1[e] + b1[e] + e1[e]); }
            u32x4 aw = {fa::cvtpk(gv[0], gv[1]), fa::cvtpk(gv[2], gv[3]), fa::cvtpk(gv[4], gv[5]), fa::cvtpk(gv[6], gv[7])};
            const bf16x8 af = *reinterpret_cast<bf16x8*>(&aw);
#pragma unroll
            for (int nb = 0; nb < 4; ++nb) { const int n = nb * 32 + r32; const bf16x8 bfr = *reinterpret_cast<const bf16x8*>(wl + n * 256 + (((ks * 2 + hi) ^ (n & 15)) << 4));
                acc[nb] = __builtin_amdgcn_mfma_f32_32x32x16_bf16(af, bfr, acc[nb], 0, 0, 0); } }
        float* dst = kc + (((size_t)kind * NG + g) * NCH) * HD;
#pragma unroll
        for (int r = 0; r < 16; ++r) { const int row = c0 + fa::crow(r, hi); if (row < NC) {
#pragma unroll
            for (int nb = 0; nb < 4; ++nb) dst[(size_t)row * HD + nb * 32 + r32] = acc[nb][r]; } }
    }
}


template <int MODE = 0  > __device__ __forceinline__ void ph_compress_sample(const Args& a, const Frame& F, char* lds) {
    typedef float f32x16 __attribute__((ext_vector_type(16)));
    const int tid = F.tid, lane = F.lane, wid = F.wave, wm = wid >> 2, wn = wid & 3, r32 = lane & 31, hi = lane >> 5;
    char* As = lds; char* Bs = lds + 32768;
    const bf16* wct = (const bf16*)(a.ws + WS_WC_T); float* parts = (float*)(a.ws + (MODE ? WS_DBGA : WS_PARTS));
    const int acl = tid >> 4, aseg = tid & 15, brl = tid >> 3, bch = tid & 7;
#pragma unroll 1
    for (int unit = F.vcu; unit < 512; unit += F.G) {
        const int kind = unit >> 8, b = (unit >> 5) & 7, rt = unit & 31;
        const int c = rt * 32 + acl, page = a.ptab[b * NPAGES + (c >> 3)];
        const float* abase = a.cache + ((size_t)page * PAGE + (c & 7) * 16) * 2048 + kind * 512 + aseg * 4;
        const bf16* bbase = wct + (size_t)(kind * 256 + brl) * 2048 + bch * 8;
        f32x16 acc[2][2] = {};
        f32x4 ra[4][4] = {}; u32x4 rb[2][4] = {};
#define CS_LOADA(slot, kt) do { if (MODE == 2) break; const float* p_ = abase + (size_t)((kt) >> 1) * 2048 + ((kt) & 1) * 64; _Pragma("unroll") for (int j_ = 0; j_ < 4; ++j_) ra[slot][j_] = __builtin_nontemporal_load((const f32x4*)(p_ + j_ * HD)); } while (0)
#define CS_LOADB(bs, kt) do { if (MODE == 2) break; const bf16* p_ = bbase + (kt) * 64; _Pragma("unroll") for (int j_ = 0; j_ < 4; ++j_) rb[bs][j_] = *(const u32x4*)(p_ + (size_t)j_ * 64 * 2048); } while (0)
#define CS_WRITE(slot, bs, buf) do { \
        _Pragma("unroll") for (int j_ = 0; j_ < 4; ++j_) { const int row_ = j_ * 32 + acl; \
            *(u32x2*)(As + (buf) * 16384 + row_ * 128 + (((aseg >> 1) ^ (row_ & 7)) << 4) + (aseg & 1) * 8) = (u32x2){fa::cvtpk(ra[slot][j_][0], ra[slot][j_][1]), fa::cvtpk(ra[slot][j_][2], ra[slot][j_][3])}; } \
        _Pragma("unroll") for (int j_ = 0; j_ < 4; ++j_) { const int row_ = j_ * 64 + brl; *(u32x4*)(Bs + (buf) * 32768 + row_ * 128 + ((bch ^ (row_ & 7)) << 4)) = rb[bs][j_]; } } while (0)
#define CS_COMPUTE(buf) do { if (MODE == 1) break; _Pragma("unroll") for (int ks_ = 0; ks_ < 4; ++ks_) { bf16x8 af_[2], bf_[2]; \
        _Pragma("unroll") for (int t_ = 0; t_ < 2; ++t_) { const int ar_ = wm * 64 + t_ * 32 + r32, br_ = wn * 64 + t_ * 32 + r32; \
            af_[t_] = *(const bf16x8*)(As + (buf) * 16384 + ar_ * 128 + (((ks_ * 2 + hi) ^ (ar_ & 7)) << 4)); \
            bf_[t_] = *(const bf16x8*)(Bs + (buf) * 32768 + br_ * 128 + (((ks_ * 2 + hi) ^ (br_ & 7)) << 4)); } \
        _Pragma("unroll") for (int mt_ = 0; mt_ < 2; ++mt_) _Pragma("unroll") for (int nt_ = 0; nt_ < 2; ++nt_) acc[mt_][nt_] = __builtin_amdgcn_mfma_f32_32x32x16_bf16(af_[mt_], bf_[nt_], acc[mt_][nt_], 0, 0, 0); } } while (0)
        __syncthreads();
        CS_LOADA(0, 0); CS_LOADB(0, 0); CS_LOADB(1, 1); CS_LOADA(1, 1); CS_LOADA(2, 2); CS_LOADA(3, 3);
        CS_WRITE(0, 0, 0); CS_LOADB(0, 2);
        __syncthreads();
#define CS_STEP(kt, s1, s3) do { const int k3_ = (kt) + 3 < 32 ? (kt) + 3 : 31, k4_ = (kt) + 4 < 32 ? (kt) + 4 : 31;     \
        CS_LOADA(s3, k4_); CS_COMPUTE((kt) & 1); CS_WRITE(s1, ((kt) + 1) & 1, ((kt) + 1) & 1); CS_LOADB(((kt) + 1) & 1, k3_); __syncthreads(); } while (0)
#pragma unroll 1
        for (int kt = 0; kt < 32; kt += 4) { CS_STEP(kt, 1, 0); CS_STEP(kt + 1, 2, 1); CS_STEP(kt + 2, 3, 2); CS_STEP(kt + 3, 0, 3); }
#undef CS_STEP
#undef CS_COMPUTE
#undef CS_WRITE
#undef CS_LOADB
#undef CS_LOADA
#pragma unroll
        for (int mt = 0; mt < 2; ++mt)
#pragma unroll
            for (int r = 0; r < 16; ++r) {
                float* dr = parts + ((size_t)(b * NKV + wm * 2 + mt) * 1024 + rt * 32 + fa::crow(r, hi)) * 512 + kind * 256 + wn * 64 + r32;
#pragma unroll
                for (int nt = 0; nt < 2; ++nt) dr[nt * 32] = acc[mt][nt][r]; }
    }
    __syncthreads();
}

__device__ __forceinline__ void ph_cmp_prompt(const Args& a, const Frame& F, char* lds) {
    using namespace fa;
    const int tid = F.tid, wid = F.wave, lane = F.lane, r32 = lane & 31, hi = lane >> 5;
    char* V_lds = lds; char* K_lds = lds + 2 * SHM_V; float* pgw = (float*)(lds + 2 * SHM_V + 2 * SHM_K) + wid * 1024;
    const int sr = tid >> 4, sc = (tid & 15) * 8;
    const int vb0 = (int)(uintptr_t)V_lds + v_rd_base(lane);
    const bf16* P = (const bf16*)(a.ws + WS_P); const float* kcp = (const float*)(a.ws + WS_KCP); float* OC = (float*)(a.ws + WS_OCMP);
    unsigned* selp = (unsigned*)(a.ws + WS_SELP);
    constexpr float C2 = 1.4426950408889634f * SCALE;
    for (int w = F.vcu; w < 256; w += F.G) {
        const int bk = w >> 4, b = bk >> 2, kvh = bk & 3;
        const float* Kc = kcp + (((size_t)0 * NBP + b) * NKV + kvh) * 128 * HD; const float* Vc = kcp + (((size_t)1 * NBP + b) * NKV + kvh) * 128 * HD;
        __syncthreads();
#pragma unroll
        for (int t = 0; t < 2; ++t)
#pragma unroll
            for (int hf = 0; hf < 2; ++hf) { const int key0 = 64 * t + 32 * hf + sr, key = key0 < NCP ? key0 : NCP - 1;
                const f32x4 k0 = *(const f32x4*)(Kc + (size_t)key * HD + sc), k1 = *(const f32x4*)(Kc + (size_t)key * HD + sc + 4);
                const f32x4 v0 = *(const f32x4*)(Vc + (size_t)key * HD + sc), v1 = *(const f32x4*)(Vc + (size_t)key * HD + sc + 4);
                u32x4 kw = {cvtpk(k0[0], k0[1]), cvtpk(k0[2], k0[3]), cvtpk(k1[0], k1[1]), cvtpk(k1[2], k1[3])};
                u32x4 vw = {cvtpk(v0[0], v0[1]), cvtpk(v0[2], v0[3]), cvtpk(v1[0], v1[1]), cvtpk(v1[2], v1[3])};
                *(u32x4*)(K_lds + t * SHM_K + KSWZ(32 * hf + sr, sc * 2)) = kw;
                *(u32x4*)(V_lds + t * SHM_V + v_st(32 * hf + sr, sc)) = vw; }
        __syncthreads();
#pragma unroll 1
        for (int qi = 0; qi < 2; ++qi) {
            const int s0 = ((w & 15) * 2 + qi) * 64 + wid * 8, s = s0 + (r32 >> 2), h = kvh * 4 + (r32 & 3);
            bf16x8 qr[8];
            { const bf16* qb_ = PX(P, b * SEQ + s, h * HD) + hi * 8;
#pragma unroll
              for (int d0 = 0; d0 < 8; ++d0) qr[d0] = load8(qb_ + d0 * 16); }
            f32x16 p[4];
            qkt<0>(p[0], p[1], K_lds, r32, hi, qr); qkt<1>(p[2], p[3], K_lds, r32, hi, qr);
            const int nvis = s >= 31 ? (s - 31) / 16 + 1 : 0;
            float mx = -__builtin_inff();
#pragma unroll
            for (int j = 0; j < 4; ++j)
#pragma unroll
                for (int r = 0; r < 16; ++r) { const int key = 32 * j + crow(r, hi); p[j][r] = key < nvis ? p[j][r] : -__builtin_inff(); mx = fmaxf(mx, p[j][r]); }
            { auto rr = __builtin_amdgcn_permlane32_swap(__float_as_uint(mx), __float_as_uint(mx), false, false); mx = fmaxf(__uint_as_float(rr[0]), __uint_as_float(rr[1])); }
            const float mref = mx > -1e30f ? mx : 0.f, mnL = -mref * C2;
            float ps = 0.f;
#pragma unroll
            for (int j = 0; j < 4; ++j)
#pragma unroll
                for (int r = 0; r < 16; ++r) { p[j][r] = __builtin_amdgcn_exp2f(fmaf(p[j][r], C2, mnL)); ps += p[j][r]; }
            { auto rr = __builtin_amdgcn_permlane32_swap(__float_as_uint(ps), __float_as_uint(ps), false, false); ps = __uint_as_float(rr[0]) + __uint_as_float(rr[1]); }
            const float inv = ps > 0.f ? 1.0f / ps : 0.f;
#pragma unroll
            for (int j = 0; j < 4; ++j)
#pragma unroll
                for (int r = 0; r < 16; ++r) { p[j][r] *= inv; float v = p[j][r]; v += dpp_xor1(v); v += dpp_xor2(v);
                    if ((r32 & 3) == 0) pgw[(r32 >> 2) * 128 + 32 * j + crow(r, hi)] = v; }
            bf16x8 pa[8];
#define PK4(P_, B_, OUT) do { unsigned a0 = cvtpk(P_[B_+0], P_[B_+1]), a1 = cvtpk(P_[B_+2], P_[B_+3]); unsigned b0 = cvtpk(P_[B_+4], P_[B_+5]), b1 = cvtpk(P_[B_+6], P_[B_+7]); \
        auto r0 = __builtin_amdgcn_permlane32_swap(a0, b0, false, false); auto r1 = __builtin_amdgcn_permlane32_swap(a1, b1, false, false); \
        u32x4 w_ = {r0[0], r1[0], r0[1], r1[1]}; OUT = *reinterpret_cast<bf16x8*>(&w_); } while (0)
            PK4(p[0], 0, pa[0]); PK4(p[0], 8, pa[1]); PK4(p[1], 0, pa[2]); PK4(p[1], 8, pa[3]);
            PK4(p[2], 0, pa[4]); PK4(p[2], 8, pa[5]); PK4(p[3], 0, pa[6]); PK4(p[3], 8, pa[7]);
#undef PK4
            f32x16 o[4] = {};
            pv_tile<0>(o, vb0, pa[0], pa[1], pa[2], pa[3]); pv_tile<1>(o, vb0, pa[4], pa[5], pa[6], pa[7]);
#if GATED
            bf16 graw[16];
#pragma unroll
            for (int j = 0; j < 4; ++j) { const u32x2 g4 = *(const u32x2*)PX(P, b * SEQ + s0 + 2 * j + hi, PC_G + kvh * 4);
                graw[4 * j] = (bf16)(g4[0] & 0xffffu); graw[4 * j + 1] = (bf16)(g4[0] >> 16); graw[4 * j + 2] = (bf16)(g4[1] & 0xffffu); graw[4 * j + 3] = (bf16)(g4[1] >> 16); }
#endif
#pragma unroll
            for (int r = 0; r < 16; ++r) { const int row = crow(r, hi);
#if GATED
                const size_t tr = (size_t)(b * SEQ + s0 + (row >> 2)); const int hh = kvh * 4 + (row & 3);
                const float gsc = sigmoidf_(bf2f(graw[r])); bf16* op = (bf16*)OC + tr * D + hh * HD + r32;
#pragma unroll
                for (int dp = 0; dp < 2; ++dp) { const float va = o[dp][r] * gsc, vb = o[dp + 2][r] * gsc, na = dpp_xor1(va), nb = dpp_xor1(vb); const bool odd = r32 & 1;
                    *(unsigned*)(op - r32 + (odd ? dp + 2 : dp) * 32 + (r32 & ~1)) = cvtpk(odd ? nb : va, odd ? vb : na); }
#else
                float* op = OC + (size_t)(b * SEQ + s0 + (row >> 2)) * D + (kvh * 4 + (row & 3)) * HD + r32;
#pragma unroll
                for (int d0 = 0; d0 < 4; ++d0) op[d0 * 32] = o[d0][r];
#endif
            }
            asm volatile("s_waitcnt lgkmcnt(0)" ::: "memory");
            const int cur = s0 >> 6, n = lane & 31;
#pragma unroll 1
            for (int i = 0; i < 4; ++i) { const float* pq = pgw + (i + 4 * hi) * 128;
                const float scv = (n > 0 ? pq[4 * n - 1] : 0.f) + 2.0f * (pq[4 * n] + pq[4 * n + 1] + pq[4 * n + 2]) + pq[4 * n + 3];
                const bool vld = n <= cur, forced = (n == 0) || (n > cur - 2); const float val = vld ? (forced ? __builtin_inff() : scv) : -__builtin_inff();
                int rank = 0;
#pragma unroll
                for (int k = 0; k < 32; ++k) { const float vlo = __int_as_float(__builtin_amdgcn_readlane(__float_as_int(val), k)), vhi = __int_as_float(__builtin_amdgcn_readlane(__float_as_int(val), 32 + k));
                    const float vk = hi ? vhi : vlo; rank += (vk > val || (vk == val && k < n)) ? 1 : 0; }
                const unsigned long long bm = __ballot(rank < 16 && val > -__builtin_inff());
                if (lane == 0) { unsigned* sp = selp + ((size_t)b * NKV + kvh) * SEQ + s0 + i; sp[0] = (unsigned)bm; sp[4] = (unsigned)(bm >> 32); } }
            asm volatile("s_waitcnt lgkmcnt(0)" ::: "memory");
        }
    }
}

__device__ __forceinline__ void att_combine(const WaveAtt& W, LAS float* xm, LAS float* xl, LAS float* xo, float* O, int r, int kvh, const Frame& F, bool normalised, const bf16* gate) {
#pragma unroll
    for (int g = 0; g < 4; ++g) if (F.lane == g) { xm[F.wave * 4 + g] = W.m[g]; xl[F.wave * 4 + g] = W.l[g]; }
#pragma unroll
    for (int g = 0; g < 4; ++g) *(LAS f32x2*)(xo + F.wave * 512 + g * 128 + 2 * F.lane) = (f32x2){W.o[g][0], W.o[g][1]};
    __syncthreads();
    { const int g = F.tid >> 7, d = F.tid & 127; float M = -1e30f;
#pragma unroll
      for (int v = 0; v < 8; ++v) M = fmaxf(M, xm[v * 4 + g]);
      float L = 0.f, acc = 0.f;
#pragma unroll
      for (int v = 0; v < 8; ++v) { const float f = normalised ? 1.0f : __expf(xm[v * 4 + g] - M); L += f * xl[v * 4 + g]; acc += f * xo[v * 512 + g * 128 + d]; }
      const float val = normalised ? acc : (L > 0.f ? acc / L : 0.f);
#if GATED
      ((bf16*)O)[(size_t)r * D + (kvh * 4 + g) * HD + d] = (bf16)f2bf(val * sigmoidf_(bf2f(gate[g])));
#else
      O[(size_t)r * D + (kvh * 4 + g) * HD + d] = val;
#endif
    }
    __syncthreads();
}
__device__ __forceinline__ void ph_sample_attn(const Args& a, const Frame& F, size_t oc_off = WS_OCMP, size_t os_off = WS_OSLC, size_t ow_off = WS_OWIN) {
    const bf16* P = (const bf16*)(a.ws + WS_P); const float* kcs = (const float*)(a.ws + WS_KCS);
    LAS float* base = (LAS float*)F.lds; LAS float* wl = base + F.wave * 1024; WaveAtt W; W.qs = wl; W.pb = wl + 512;
    LAS float* xm = base + 8192; LAS float* xl = xm + 32; LAS float* xo = xl + 32; LAS float* pg = xo + 4096 + 4; LAS float* scl = pg + 1028; LAS int* list = (LAS int*)(scl + 264);
    const int wv = F.wave;
    for (int w = F.vcu; w < NBS * NKV * DSQ; w += F.G) {
        int lane = F.lane; asm volatile("" : "+v"(lane));
        const int b = w >> 5, kvh = (w >> 3) & 3, s = w & 7, r = MP + b * DSQ + s;
        att_load_q(P, r, kvh, W, lane);
        const float* Kc = kcs + (((size_t)0 * NBS + b) * NKV + kvh) * 1024 * HD; const float* Vc = kcs + (((size_t)1 * NBS + b) * NKV + kvh) * 1024 * HD;
        float mx[4] = {-1e30f, -1e30f, -1e30f, -1e30f}, ls[4] = {0.f, 0.f, 0.f, 0.f}; float scs[2][4];
#pragma unroll
        for (int q = 0; q < 2; ++q) { const int c = (2 * wv + q) * 64 + lane; const bool valid = c < NCS; float t[4];
            if (valid) att_dot4<float>(Kc + (size_t)c * HD, W, t); else { t[0] = t[1] = t[2] = t[3] = 0.f; }
#pragma unroll
            for (int g = 0; g < 4; ++g) { const float sv = valid ? t[g] * SCALE : -__builtin_inff(); scs[q][g] = sv; const float m2 = fmaxf(mx[g], wave_max(sv));
                ls[g] = ls[g] * __expf(mx[g] - m2) + wave_sum(__expf(sv - m2)); mx[g] = m2; } }
#pragma unroll
        for (int g = 0; g < 4; ++g) if (lane == g) { xm[wv * 4 + g] = mx[g]; xl[wv * 4 + g] = ls[g]; }
        __syncthreads();
        float M[4], Li[4];
#pragma unroll
        for (int g = 0; g < 4; ++g) { float m_ = -1e30f;
#pragma unroll
            for (int v = 0; v < 8; ++v) m_ = fmaxf(m_, xm[v * 4 + g]);
            float l_ = 0.f;
#pragma unroll
            for (int v = 0; v < 8; ++v) l_ += xl[v * 4 + g] * __expf(xm[v * 4 + g] - m_);
            M[g] = m_; Li[g] = l_ > 0.f ? 1.0f / l_ : 0.f; }
        __syncthreads();
        att_init(W);
#pragma unroll
        for (int q = 0; q < 2; ++q) { const int sg = 2 * wv + q, c = sg * 64 + lane;
            f32x4 p; float pgs = 0.f;
#pragma unroll
            for (int g = 0; g < 4; ++g) { p[g] = __expf(scs[q][g] - M[g]) * Li[g]; pgs += p[g]; }
            pg[c] = pgs;
            int nk = NCS - sg * 64; nk = nk > 64 ? 64 : nk;
            *(LAS f32x4*)(W.pb + lane * 4) = p; asm volatile("s_waitcnt lgkmcnt(0)" ::: "memory");
            att_pv<float>(Vc + (size_t)sg * 64 * HD, HD, nk, W, lane); asm volatile("s_waitcnt lgkmcnt(0)" ::: "memory"); }
        if (F.tid == 0) pg[-1] = 0.f;
        const bf16* grow = PX(P, r, PC_G + kvh * 4);
        att_combine(W, xm, xl, xo, (float*)(a.ws + oc_off), r, kvh, F, true, grow);
        if (F.tid < 256) { const int n = F.tid; scl[n] = (n >= 1 && n <= 254) ? pg[4 * n - 1] + 2.0f * (pg[4 * n] + pg[4 * n + 1] + pg[4 * n + 2]) + pg[4 * n + 3] : -__builtin_inff(); }
        __syncthreads();
        if (F.tid < 256) { const int n = F.tid; const float val = scl[n]; int rank = 0;
#pragma unroll 2
            for (int k = 1; k <= 254; ++k) { const float vk = scl[k]; rank += (vk > val || (vk == val && k < n)) ? 1 : 0; }
            const bool sel = (n >= 1 && n <= 254 && rank < 13) || n == 0 || n == 255;
            const unsigned long long bm = __ballot(sel);
            if (lane == 0) { ((LAS unsigned*)list)[2 * wv] = (unsigned)bm; ((LAS unsigned*)list)[2 * wv + 1] = (unsigned)(bm >> 32); } }
        __syncthreads();
        if (F.tid == 0) { int cnt = 0;
#pragma unroll 1
            for (int i = 0; i < 8; ++i) { unsigned x = ((LAS unsigned*)list)[i];
#pragma unroll 1
                while (x) { const int bpos = __ffs(x) - 1; x &= x - 1; if (cnt < 16) { list[8 + cnt] = i * 32 + bpos; ++cnt; } } }
            if (cnt < 17) { list[8 + cnt] = 256; ++cnt; }
#pragma unroll 1
            for (; cnt < 17; ++cnt) list[8 + cnt] = -1; }
        __syncthreads();
        att_init(W);
#pragma unroll 1
        for (int e = wv; e < 17; e += 8) {
            const int n = list[8 + e]; if (n < 0) continue;
            if (n < 256) {
                const int page = a.ptab[b * NPAGES + (n >> 1)];
                const float* kb = a.cache + ((size_t)page * PAGE + (n & 1) * 64) * 2048 + kvh * HD;
                att_segment<float, PVS>(kb + 2 * 512, 2048, kb + 3 * 512, 2048, 64, true, W, lane);
            } else { att_segment<bf16, PVS>(PX(P, MP + b * DSQ, PC_KV + 2 * 512 + kvh * HD), PRS, PX(P, MP + b * DSQ, PC_KV + 3 * 512 + kvh * HD), PRS, s + 1, lane <= s, W, lane); }
        }
        att_combine(W, xm, xl, xo, (float*)(a.ws + os_off), r, kvh, F, false, grow + 16);
        att_init(W);
        { const float* st = a.st_win + (size_t)b * 512 * 1024 + kvh * HD; const int i0 = wv * 64;
          const float* nw = a.out + OUT_WINS + ((size_t)b * 512 + 504) * 1024 + kvh * HD;
          if (wv == 0) att_segment<float, PVS>(st, 1024, st + 512, 1024, 64, true, W, lane, nw, nw + 512, s + 1);
          else att_segment<float, PVS>(st + (size_t)i0 * 1024, 1024, st + (size_t)i0 * 1024 + 512, 1024, 64, true, W, lane); }
        att_combine(W, xm, xl, xo, (float*)(a.ws + ow_off), r, kvh, F, false, grow + 32);
    }
    { float* ow = a.out + OUT_WINS;
      for (size_t i = (size_t)(F.vcu * 512 + F.tid); i < (size_t)NBS * 504 * 256; i += (size_t)F.G * 512) { const size_t b = i / (504 * 256), rem = i % (504 * 256);
          *(f32x4*)(ow + b * 512 * 1024 + rem * 4) = *(const f32x4*)(a.st_win + b * 512 * 1024 + 8 * 1024 + rem * 4); } }
}

__device__ __forceinline__ fa::BlockRef fa_ref(const Args& a, int w, int i) {
    const int bh = w >> 2, p = w & 3, b = bh >> 4, h = bh & 15, kvh = h >> 2;
    const bool win = i >= 2; int qb;
    if (!win) qb = (i == 0) ? 7 - p : p;
    else { const int j = i - 2; qb = p == 0 ? 7 - j : (p == 1 ? 5 - j : (p == 2 ? (j ? 1 : 3) : (j ? 0 : 2))); }
    const bf16* P = (const bf16*)(a.ws + WS_P); const bf16* KV6 = (const bf16*)(a.ws + WS_KV6);
    fa::BlockRef r; r.P0 = qb * 256; r.W = win ? 512 : (1 << 20);
    r.Q = PX(P, b * SEQ + r.P0, h * HD);
    r.K = KV6 + (((size_t)(win ? 4 : 2) * NBP + b) * NKV + kvh) * SEQ * HD; r.V = KV6 + (((size_t)(win ? 5 : 3) * NBP + b) * NKV + kvh) * SEQ * HD;
#if GATED
    r.O = (float*)((bf16*)(a.ws + (win ? WS_OWIN : WS_OSLC)) + (size_t)(b * SEQ + r.P0) * D + h * HD);
#else
    r.O = (float*)(a.ws + (win ? WS_OWIN : WS_OSLC)) + (size_t)(b * SEQ + r.P0) * D + h * HD;
#endif
    r.gate = PX(P, b * SEQ + r.P0, PC_G + (win ? 32 : 16) + h);
    r.sel = win ? nullptr : (const unsigned*)(a.ws + WS_SELP) + ((size_t)b * NKV + kvh) * SEQ;
    return r;
}
__device__ __forceinline__ void ph_fa_prompt(const Args& a, const Frame& F, char* lds) {
    const int nW = (256 - F.vcu + F.G - 1) / F.G;
    if (F.vcu >= 256) return;
    const int total = nW * 4;
    int it = 0;
    fa::BlockRef cur = fa_ref(a, F.vcu, 0);
    fa::Seam S;
    fa::prime(cur, lds, S);
    for (;;) {
        const bool last = it + 1 >= total;
        const int itn = last ? it : it + 1;
        const fa::BlockRef nxt = fa_ref(a, F.vcu + (itn >> 2) * F.G, itn & 3);
        fa::block(cur, nxt, SEQ, lds, S);
        if (last) break;
        cur = nxt; it = itn;
    }
}


#ifndef DBG_MASK_TOL
#define DBG_MASK_TOL 1000u
#endif
constexpr int CW_DBG = 2048;
__device__ __forceinline__ void ph_check(const Args& a, const Frame& F, size_t offA, size_t offB, size_t nfloats, float tol, unsigned bit) {
    const float* A = (const float*)(a.ws + offA); const float* B = (const float*)(a.ws + offB); bool bad = false;
    for (size_t i = (size_t)F.vcu * 512 + F.tid; i < nfloats / 4; i += (size_t)F.G * 512) { const f32x4 x = *(const f32x4*)(A + i * 4), y = *(const f32x4*)(B + i * 4);
#pragma unroll
        for (int e = 0; e < 4; ++e) { const float d = fabsf(x[e] - y[e]); if (!(d <= tol)) bad = true; } }
    if (__any(bad) && F.lane == 0) atomicOr((unsigned*)(a.ws + WS_CTL) + CW_DBG, bit);
}

constexpr int CW_DBGCNT = 2112;
__device__ __forceinline__ void ph_check_masks(const Args& a, const Frame& F) {
    const unsigned* A = (const unsigned*)(a.ws + WS_SELP); const unsigned* B = (const unsigned*)(a.ws + WS_SELP2); int bad = 0;
    for (int i = F.vcu * 512 + F.tid; i < NBP * NKV * SEQ; i += F.G * 512) bad += (A[i] != B[i]) ? 1 : 0;
    bad = (int)wave_sum((float)bad);
    if (F.lane == 0 && bad) atomicAdd((unsigned*)(a.ws + WS_CTL) + CW_DBGCNT, (unsigned)bad);
}


__device__ __forceinline__ void ph_conv_z(const Args& a, const Frame& F) {
    const bf16* P = (const bf16*)(a.ws + WS_P); bf16* A2 = (bf16*)(a.ws + WS_A2);
    const int gw = F.vcu * 8 + F.wave, NGW = F.G * 8, lane = F.lane;
    constexpr int NPI = (MP / 16) * 4, NSI = NBS * 4;
#pragma unroll 1
    for (int it = gw; it < NPI + NSI; it += NGW) {
        const bool smp = it >= NPI; const int q = smp ? (it - NPI) & 3 : it & 3, ch = smp ? (it - NPI) >> 2 : it >> 2;
        const int r0 = smp ? MP + ch * DSQ : ch * 16, nrow = smp ? DSQ : 16, s0 = smp ? 0 : (r0 & 2047), SL = smp ? DSQ : SEQ, b = smp ? ch : r0 >> 11;
        const int c = q * 512 + lane * 8;
        float w0[8], w1[8], w2[8], cb[8], u1[8], u2[8];
#pragma unroll
        for (int h = 0; h < 2; ++h) { const f32x4 x0 = *(const f32x4*)(a.conv_w + c + 4 * h), x1 = *(const f32x4*)(a.conv_w + D + c + 4 * h), x2 = *(const f32x4*)(a.conv_w + 2 * D + c + 4 * h), x3 = *(const f32x4*)(a.conv_b + c + 4 * h);
#pragma unroll
            for (int e = 0; e < 4; ++e) { w0[4 * h + e] = x0[e]; w1[4 * h + e] = x1[e]; w2[4 * h + e] = x2[e]; cb[4 * h + e] = x3[e]; } }
        if (smp) {
#pragma unroll
            for (int h = 0; h < 2; ++h) { const f32x4 p0 = *(const f32x4*)(a.st_conv + ((size_t)b * 2 + 0) * D + c + 4 * h), p1 = *(const f32x4*)(a.st_conv + ((size_t)b * 2 + 1) * D + c + 4 * h);
#pragma unroll
                for (int e = 0; e < 4; ++e) { u2[4 * h + e] = p0[e]; u1[4 * h + e] = p1[e]; } }
        } else if (s0 == 0) {
#pragma unroll
            for (int e = 0; e < 8; ++e) { u1[e] = 0.f; u2[e] = 0.f; }
        } else {
            const u32x4 c2 = *(const u32x4*)PX(P, r0 - 2, PC_C + c), i2 = *(const u32x4*)PX(P, r0 - 2, PC_U + c), c1 = *(const u32x4*)PX(P, r0 - 1, PC_C + c), i1 = *(const u32x4*)PX(P, r0 - 1, PC_U + c);
#pragma unroll
            for (int e = 0; e < 4; ++e) { u2[2 * e] = lo_bf(c2[e]) * lo_bf(i2[e]); u2[2 * e + 1] = hi_bf(c2[e]) * hi_bf(i2[e]); u1[2 * e] = lo_bf(c1[e]) * lo_bf(i1[e]); u1[2 * e + 1] = hi_bf(c1[e]) * hi_bf(i1[e]); }
        }
#pragma unroll 1
        for (int i0 = 0; i0 < nrow; i0 += 4) {
            u32x4 cg[4], ui[4], bg[4];
#pragma unroll
            for (int k = 0; k < 4; ++k) { const int rr_ = r0 + i0 + k; cg[k] = *(const u32x4*)PX(P, rr_, PC_C + c); ui[k] = *(const u32x4*)PX(P, rr_, PC_U + c); bg[k] = *(const u32x4*)PX(P, rr_, PC_B + c); }
#pragma unroll
            for (int k = 0; k < 4; ++k) { const int r = r0 + i0 + k, s = s0 + i0 + k; float u[8], z[8];
#pragma unroll
                for (int e = 0; e < 4; ++e) { u[2 * e] = lo_bf(cg[k][e]) * lo_bf(ui[k][e]); u[2 * e + 1] = hi_bf(cg[k][e]) * hi_bf(ui[k][e]); }
#pragma unroll
                for (int e = 0; e < 8; ++e) { const float y = cb[e] + w0[e] * u2[e] + w1[e] * u1[e] + w2[e] * u[e]; z[e] = ((e & 1) ? hi_bf(bg[k][e >> 1]) : lo_bf(bg[k][e >> 1])) * y; }
                *(u32x4*)(A2 + (size_t)r * 2 * D + D + c) = (u32x4){pk2(z[0], z[1]), pk2(z[2], z[3]), pk2(z[4], z[5]), pk2(z[6], z[7])};
                if (s >= SL - 2) { float* o = a.out + (smp ? OUT_CONVS : OUT_CONVP) + ((size_t)b * 2 + (s - (SL - 2))) * D + c; *(f32x4*)o = (f32x4){u[0], u[1], u[2], u[3]}; *(f32x4*)(o + 4) = (f32x4){u[4], u[5], u[6], u[7]}; }
#pragma unroll
                for (int e = 0; e < 8; ++e) { u2[e] = u1[e]; u1[e] = u[e]; } }
        }
    }
}
__device__ __forceinline__ void ph_combine(const Args& a, const Frame& F) {
    const bf16* P = (const bf16*)(a.ws + WS_P); bf16* A2 = (bf16*)(a.ws + WS_A2);
    const float* OC = (const float*)(a.ws + WS_OCMP); const float* OS = (const float*)(a.ws + WS_OSLC); const float* OW = (const float*)(a.ws + WS_OWIN);
    const int gw = F.vcu * 8 + F.wave, NGW = F.G * 8, lane = F.lane;
    for (int r = gw; r < MPAD; r += NGW) {
        bf16* orow = A2 + (size_t)r * 2 * D;
        if (r >= MR) { for (int j = 0; j < 8; ++j) *(u32x4*)(orow + (lane + 64 * j) * 8) = (u32x4){0u, 0u, 0u, 0u}; continue; }
#if GATED
#pragma unroll
        for (int j = 0; j < 4; ++j) { const int c = (lane + 64 * j) * 8;
            const u32x4 x = *(const u32x4*)((const bf16*)OC + (size_t)r * D + c), y = *(const u32x4*)((const bf16*)OS + (size_t)r * D + c), z_ = *(const u32x4*)((const bf16*)OW + (size_t)r * D + c);
            u32x4 w;
#pragma unroll
            for (int e = 0; e < 4; ++e) w[e] = pk2(lo_bf(x[e]) + lo_bf(y[e]) + lo_bf(z_[e]), hi_bf(x[e]) + hi_bf(y[e]) + hi_bf(z_[e]));
            *(u32x4*)(orow + c) = w; }
#else
#pragma unroll
        for (int j = 0; j < 8; ++j) { const int c = (lane + 64 * j) * 4, h = c >> 7;
            const float g0 = sigmoidf_(bf2f(*PX(P, r, PC_G + h))), g1 = sigmoidf_(bf2f(*PX(P, r, PC_G + 16 + h))), g2 = sigmoidf_(bf2f(*PX(P, r, PC_G + 32 + h)));
            const f32x4 v = g0 * *(const f32x4*)(OC + (size_t)r * D + c) + g1 * *(const f32x4*)(OS + (size_t)r * D + c) + g2 * *(const f32x4*)(OW + (size_t)r * D + c);
            *(u32x2*)(orow + c) = (u32x2){pk2(v[0], v[1]), pk2(v[2], v[3])}; }
#endif
#if !GATED
        const bool smp = r >= MP; const int s = smp ? (r - MP) & 7 : r & 2047, b = smp ? (r - MP) >> 3 : r >> 11;
#pragma unroll
        for (int j = 0; j < 8; ++j) { const int c = (lane + 64 * j) * 4; f32x4 u[3];
#pragma unroll
            for (int t = 0; t < 3; ++t) { const int ss = s - 2 + t;
                if (ss >= 0) { const int rq = r - (2 - t); const u32x2 cg = *(const u32x2*)PX(P, rq, PC_C + c), ui = *(const u32x2*)PX(P, rq, PC_U + c);
                    u[t] = (f32x4){lo_bf(cg[0]) * lo_bf(ui[0]), hi_bf(cg[0]) * hi_bf(ui[0]), lo_bf(cg[1]) * lo_bf(ui[1]), hi_bf(cg[1]) * hi_bf(ui[1])}; }
                else if (smp) u[t] = *(const f32x4*)(a.st_conv + ((size_t)b * 2 + (ss + 2)) * D + c);
                else u[t] = (f32x4){0.f, 0.f, 0.f, 0.f}; }
            const f32x4 w0 = *(const f32x4*)(a.conv_w + c), w1 = *(const f32x4*)(a.conv_w + D + c), w2 = *(const f32x4*)(a.conv_w + 2 * D + c), cb = *(const f32x4*)(a.conv_b + c);
            const u32x2 bg = *(const u32x2*)PX(P, r, PC_B + c);
            const f32x4 y = cb + w0 * u[0] + w1 * u[1] + w2 * u[2];
            const f32x4 z = {lo_bf(bg[0]) * y[0], hi_bf(bg[0]) * y[1], lo_bf(bg[1]) * y[2], hi_bf(bg[1]) * y[3]};
            *(u32x2*)(orow + D + c) = (u32x2){pk2(z[0], z[1]), pk2(z[2], z[3])};
            const int SL = smp ? DSQ : SEQ;
            if (s >= SL - 2) { float* o = a.out + (smp ? OUT_CONVS : OUT_CONVP) + ((size_t)b * 2 + (s - (SL - 2))) * D + c; *(f32x4*)o = u[2]; } }
#endif
    }
#if GATED
    ph_conv_z(a, F);
#endif
}
__device__ __forceinline__ void ph_final(const Args& a, const Frame& F) {
    const int gw = F.vcu * 8 + F.wave, NGW = F.G * 8; const float* X2 = (const float*)(a.ws + WS_X2);
#if DBG_CHECK
    { unsigned fl = __hip_atomic_load((unsigned*)(a.ws + WS_CTL) + CW_DBG, __ATOMIC_RELAXED, __HIP_MEMORY_SCOPE_AGENT);
      if (__hip_atomic_load((unsigned*)(a.ws + WS_CTL) + CW_DBGCNT, __ATOMIC_RELAXED, __HIP_MEMORY_SCOPE_AGENT) > (DBG_MASK_TOL)) fl |= 8u;
      if (F.vcu == 0 && F.tid < 4 && ((fl >> F.tid) & 1u)) { const size_t tgt = F.tid == 0 ? OUT_CONVS : (F.tid == 1 ? OUT_CONVP : (F.tid == 2 ? OUT_WINS : OUT_KVS)); a.out[tgt] = 1e6f; } }
#endif
    for (int r = gw; r < MR; r += NGW) {
        const float* xr = X2 + (size_t)r * D; float* o = a.out + (r < MP ? OUT_YP + (size_t)r * D : OUT_YS + (size_t)(r - MP) * D);
        f32x4 v[8]; float ss = 0.f;
#pragma unroll
        for (int j = 0; j < 8; ++j) { v[j] = *(const f32x4*)(xr + (F.lane + 64 * j) * 4); ss += (v[j][0] * v[j][0] + v[j][1] * v[j][1]) + (v[j][2] * v[j][2] + v[j][3] * v[j][3]); }
        const float rstd = rsqrtf(wave_sum(ss) * (1.0f / D) + RMS_EPS);
#pragma unroll
        for (int j = 0; j < 8; ++j) { const int c = (F.lane + 64 * j) * 4; *(f32x4*)(o + c) = v[j] * rstd * *(const f32x4*)(a.nfg + c); }
    }
}


__device__ __forceinline__ void ph_check_a2(const Args& a, const Frame& F, float tol, unsigned bit) {
    const bf16* P = (const bf16*)(a.ws + WS_P); const bf16* A2 = (const bf16*)(a.ws + WS_A2);
    const float* RC = (const float*)(a.ws + WS_DBGC); const float* RS = (const float*)(a.ws + WS_DBGA); const float* RW = (const float*)(a.ws + WS_DBGB);
    bool bad = false;
    for (size_t i = (size_t)F.vcu * 512 + F.tid; i < (size_t)MR * D; i += (size_t)F.G * 512) { const int r = (int)(i >> 11), c = (int)(i & 2047), h = c >> 7;
        const float ref = sigmoidf_(bf2f(*PX(P, r, PC_G + h))) * RC[i] + sigmoidf_(bf2f(*PX(P, r, PC_G + 16 + h))) * RS[i] + sigmoidf_(bf2f(*PX(P, r, PC_G + 32 + h))) * RW[i];
        const float got = bf2f(A2[(size_t)r * 2 * D + c]); if (!(fabsf(ref - got) <= tol)) bad = true; }
    if (__any(bad) && F.lane == 0) atomicOr((unsigned*)(a.ws + WS_CTL) + CW_DBG, bit);
}

#define PHF __device__ __forceinline__ void
PHF phase0(const Args& a, const Frame& F, unsigned char* lds_raw) { ph_ada(a, F); __syncthreads();
    ph_transpose_range(a, F, TR_NBIG, TR_NIT, F.vcu, F.G);
    constexpr int NADA = 6 * D / 64;
    if (F.G > NADA && F.vcu >= NADA) ph_transpose_range(a, F, 0, TR_EARLY, F.vcu - NADA, F.G - NADA);
}
PHF phase1(const Args& a, const Frame& F, unsigned char* lds_raw) { ph_peb_sum(a, F); ph_transpose_range(a, F, (F.G > 6 * D / 64) ? TR_EARLY : 0, TR_NBIG, F.vcu, F.G); ph_modnorm<0>(a, F); ph_compress_sample(a, F, (char*)lds_raw);
    if ((DBG_REPEAT >> 17) & 1) { __syncthreads(); ph_transpose_range(a, F, 0, TR_NBIG, F.vcu, F.G); }
    if ((DBG_REPEAT >> 18) & 1) { __syncthreads(); ph_modnorm<0>(a, F); }
    if ((DBG_REPEAT >> 19) & 1) { __syncthreads(); ph_compress_sample<0>(a, F, (char*)lds_raw); }
    if ((DBG_REPEAT >> 20) & 1) { __syncthreads(); ph_compress_sample<1>(a, F, (char*)lds_raw); }
    if ((DBG_REPEAT >> 21) & 1) { __syncthreads(); ph_compress_sample<2>(a, F, (char*)lds_raw); }
#if DBG_CHECK & 16
    ph_cache_cvt(a, F);
#endif
}
PHF phase2(const Args& a, const Frame& F, unsigned char* lds_raw) {
    {
      const int nwg = (MPAD / 256) * (NIN / 256), c = (int)blockIdx.x, full = (nwg + F.G - 1) / F.G, mine = c < nwg ? (nwg - c + F.G - 1) / F.G : 0;
      const int first_short = nwg - (full - 1) * F.G;
      if (first_short < F.G) { if (mine < full) ph_cmp_finish_mfma<1>(a, F, (char*)lds_raw, c - first_short, F.G - first_short); }
      else ph_cmp_finish_mfma<1>(a, F, (char*)lds_raw); }
    pg8::Prob g{(const char*)(a.ws + WS_H), (const char*)(a.ws + WS_WIN_T), (size_t)256 * D * 2, 0, 0, (size_t)256 * D * 2, 0, D * 2, D * 2, D / 64};
    pg8::Order S; S.init(MPAD, NIN, F.G, (int)blockIdx.x, 1);
    EpiIn E{(bf16*)(a.ws + WS_P), (bf16*)(a.ws + WS_KV6), a.out};
    __syncthreads();
    pg8::gemm_phase<EpiIn, false, true>(F.lds, g, S, E);
    if ((DBG_REPEAT >> 15) & 1) { __syncthreads(); EpiNull EN{(float*)(a.ws + WS_DBGA)}; pg8::gemm_phase<EpiNull>(F.lds, g, S, EN); }
#if DBG_CHECK & 16
    { __syncthreads();
      pg8::Prob g2{(const char*)(a.ws + WS_CA), (const char*)(a.ws + WS_WC_T), (size_t)256 * 2048 * 2, (size_t)NBS * NKV * PAST * HD * 2, 0, (size_t)256 * 2048 * 2, 0, 2048 * 2, 2048 * 2, 2048 / 64};
      pg8::Order S2; S2.init(32768, 512, F.G, (int)blockIdx.x, 1);
      EpiF32 E2{(float*)(a.ws + WS_DBGA), 512};
      pg8::gemm_phase<EpiF32>(F.lds, g2, S2, E2); }
#endif
}
PHF phase3(const Args& a, const Frame& F, unsigned char* lds_raw) {
#if DBG_CHECK & 16
    ph_check(a, F, WS_PARTS, WS_DBGA, (size_t)32768 * 512, 2e-3f, 1u);
#endif
    ph_compress_prompt(a, F);
#if DBG_CHECK & 32
    { __syncthreads(); pg8::Prob g{(const char*)(a.ws + WS_KV6), (const char*)(a.ws + WS_WC_T), (size_t)256 * 2048 * 2, (size_t)NBP * NKV * SEQ * HD * 2, 0, (size_t)256 * 2048 * 2, 0, 2048 * 2, 2048 * 2, 2048 / 64};
      pg8::Order S; S.init(2048, 512, F.G, (int)blockIdx.x, 1);
      EpiF32 E{(float*)(a.ws + WS_DBGA), 512};
      pg8::gemm_phase<EpiF32>(F.lds, g, S, E); }
#endif
    __syncthreads(); ph_sample_attn(a, F);
}
PHF phase4(const Args& a, const Frame& F, unsigned char* lds_raw) {
#if DBG_CHECK & 32
    ph_check(a, F, WS_PARTP, WS_DBGA, (size_t)2048 * 512, 2e-3f, 1u);
#endif
    ph_cmp_finish_mfma<0>(a, F, (char*)lds_raw); }
PHF phase5(const Args& a, const Frame& F, unsigned char* lds_raw) { ph_cmp_prompt(a, F, (char*)lds_raw);
#if DBG_CHECK & 8
    __syncthreads(); ph_cmp_finish<1>(a, F, WS_DBGA); __syncthreads(); ph_cmp_finish<0>(a, F, WS_DBGB);
#endif
#if DBG_CHECK & 64
    __syncthreads(); ph_cmp_attend<1>(a, F, WS_DBGC);
#endif
}
PHF phase6(const Args& a, const Frame& F, unsigned char* lds_raw) {
#if DBG_CHECK & 8
    ph_check(a, F, WS_KCS, WS_DBGA, (size_t)2 * NBS * NKV * 1024 * HD, 0.02f, 1u); ph_check(a, F, WS_KCP, WS_DBGB, (size_t)2 * NBP * NKV * 128 * HD, 0.02f, 2u);
#endif
    ph_fa_prompt(a, F, (char*)lds_raw);
#if DBG_CHECK & 1
    __syncthreads(); ph_slc_attend<0>(a, F, WS_DBGA); __syncthreads(); ph_win_attend<0>(a, F, WS_DBGB);
#endif
#if DBG_CHECK & 2
    __syncthreads(); ph_cmp_attend<0>(a, F, WS_DBGC, WS_SELP2);
#endif
#if DBG_CHECK & 4
    __syncthreads(); ph_cmp_attend<1>(a, F, WS_DBGC);
#endif
#if DBG_CHECK & 64
    __syncthreads(); ph_slc_attend<0>(a, F, WS_DBGA); __syncthreads(); ph_win_attend<0>(a, F, WS_DBGB); __syncthreads(); ph_cmp_attend<0>(a, F, WS_DBGC, WS_SELP2);
    __syncthreads(); ph_slc_attend<1>(a, F, WS_DBGA); __syncthreads(); ph_win_attend<1>(a, F, WS_DBGB);
#endif
}
PHF phase7(const Args& a, const Frame& F, unsigned char* lds_raw) {
#if DBG_CHECK & 1
    ph_check(a, F, WS_OSLC, WS_DBGA, (size_t)MP * D, 0.05f, 1u); ph_check(a, F, WS_OWIN, WS_DBGB, (size_t)MP * D, 0.05f, 2u);
#endif
#if DBG_CHECK & 2
    ph_check(a, F, WS_OCMP, WS_DBGC, (size_t)MP * D, 0.03f, 4u); ph_check_masks(a, F);
#endif
#if DBG_CHECK & 4
    __syncthreads(); ph_slc_attend<1>(a, F, WS_DBGA); __syncthreads(); ph_win_attend<1>(a, F, WS_DBGB);
#endif
    ph_combine(a, F);
}
PHF phase8(const Args& a, const Frame& F, unsigned char* lds_raw) {
#if DBG_CHECK & 64
    ph_check_a2(a, F, 0.03f, 1u); ph_check_masks(a, F);
#endif
#if DBG_CHECK & 4
    ph_check(a, F, WS_OCMP + (size_t)MP * D * 4, WS_DBGC + (size_t)MP * D * 4, (size_t)MS * D, 0.01f, 1u); ph_check(a, F, WS_OSLC + (size_t)MP * D * 4, WS_DBGA + (size_t)MP * D * 4, (size_t)MS * D, 0.01f, 2u);
    ph_check(a, F, WS_OWIN + (size_t)MP * D * 4, WS_DBGB + (size_t)MP * D * 4, (size_t)MS * D, 0.01f, 4u);
#endif
    { SEpiProj SE{(const bf16*)(a.ws + WS_P), (bf16*)(a.ws + WS_MIX)};
      small_gemm<8, 2>(F, (const bf16*)(a.ws + WS_A2) + (size_t)MP * 2 * D, 2 * D, D, (const bf16*)(a.ws + WS_WP_T), 2 * D, D, D, D, SE); }
    pg8::Prob g{(const char*)(a.ws + WS_A2), (const char*)(a.ws + WS_WP_T), (size_t)256 * 2 * D * 2, 0, (size_t)D * 2, (size_t)256 * 2 * D * 2, (size_t)D * 2, 2 * D * 2, 2 * D * 2, D / 64};
    pg8::Order S; S.init(MP, D, F.G, (int)blockIdx.x, 2);
    EpiProj E{(const bf16*)(a.ws + WS_P), (bf16*)(a.ws + WS_MIX)};
    pg8::gemm_phase<EpiProj>(F.lds, g, S, E);
}
PHF phase9(const Args& a, const Frame& F, unsigned char* lds_raw) {
    { SEpiRes<0> SE{a};
      small_gemm<8, 1>(F, (const bf16*)(a.ws + WS_MIX) + (size_t)MP * D, D, 0, (const bf16*)(a.ws + WS_WOUT_T), D, 0, D, D, SE); }
    pg8::Prob g{(const char*)(a.ws + WS_MIX), (const char*)(a.ws + WS_WOUT_T), (size_t)256 * D * 2, 0, 0, (size_t)256 * D * 2, 0, D * 2, D * 2, D / 64};
    pg8::Order S; S.init(MP, D, F.G, (int)blockIdx.x, 1);
    EpiRes<0> E{a};
    pg8::gemm_phase<EpiRes<0>>(F.lds, g, S, E);
}
PHF phase10(const Args& a, const Frame& F, unsigned char* lds_raw) { ph_modnorm<1>(a, F); }
PHF phase11(const Args& a, const Frame& F, unsigned char* lds_raw) {
    { SEpiRelu2 SE{(bf16*)(a.ws + WS_HM)};
      small_gemm<32, 1>(F, (const bf16*)(a.ws + WS_H) + (size_t)MP * D, D, 0, (const bf16*)(a.ws + WS_W1_T), D, 0, D, DFF, SE); }
    pg8::Prob g{(const char*)(a.ws + WS_H), (const char*)(a.ws + WS_W1_T), (size_t)256 * D * 2, 0, 0, (size_t)256 * D * 2, 0, D * 2, D * 2, D / 64};
    pg8::Order S; S.init(MP, DFF, F.G, (int)blockIdx.x, 1);
    EpiRelu2 E{(bf16*)(a.ws + WS_HM)};
    pg8::gemm_phase<EpiRelu2, false, true>(F.lds, g, S, E);
}
PHF phase12(const Args& a, const Frame& F, unsigned char* lds_raw) {
    { SEpiRes<1> SE{a};
      small_gemm<8, 1>(F, (const bf16*)(a.ws + WS_HM) + (size_t)MP * DFF, DFF, 0, (const bf16*)(a.ws + WS_W2_T), DFF, 0, DFF, D, SE); }
    pg8::Prob g{(const char*)(a.ws + WS_HM), (const char*)(a.ws + WS_W2_T), (size_t)256 * DFF * 2, 0, 0, (size_t)256 * DFF * 2, 0, DFF * 2, DFF * 2, DFF / 64};
    pg8::Order S; S.init(MP, D, F.G, (int)blockIdx.x, 1);
    EpiRes<1> E{a};
    pg8::gemm_phase<EpiRes<1>>(F.lds, g, S, E);
}
PHF phase13(const Args& a, const Frame& F, unsigned char* lds_raw) { ph_final(a, F); }

#define CAS __attribute__((address_space(4)))
#define GAS __attribute__((address_space(1)))
__device__ __forceinline__ void load_args(Args& a) {
    const CAS unsigned long long* kp = (const CAS unsigned long long*)__builtin_amdgcn_kernarg_segment_ptr();
    asm volatile("" : "+s"(kp));
    a.x_p = (const float*)(const GAS float*)kp[0];
    a.x_s = (const float*)(const GAS float*)kp[1];
    a.c_p = (const float*)(const GAS float*)kp[2];
    a.c_s = (const float*)(const GAS float*)kp[3];
    a.cache = (const float*)(const GAS float*)kp[4];
    a.ptab = (const int*)(const GAS int*)kp[5];
    a.st_win = (const float*)(const GAS float*)kp[6];
    a.st_conv = (const float*)(const GAS float*)kp[7];
    a.w_ada = (const float*)(const GAS float*)kp[8];
    a.b_ada = (const float*)(const GAS float*)kp[9];
    a.n1g = (const float*)(const GAS float*)kp[10];
    a.n2g = (const float*)(const GAS float*)kp[11];
    a.w_in = (const float*)(const GAS float*)kp[12];
    a.wck1 = (const float*)(const GAS float*)kp[13];
    a.wck2 = (const float*)(const GAS float*)kp[14];
    a.pek = (const float*)(const GAS float*)kp[15];
    a.wcv1 = (const float*)(const GAS float*)kp[16];
    a.wcv2 = (const float*)(const GAS float*)kp[17];
    a.pev = (const float*)(const GAS float*)kp[18];
    a.conv_w = (const float*)(const GAS float*)kp[19];
    a.conv_b = (const float*)(const GAS float*)kp[20];
    a.w_ap = (const float*)(const GAS float*)kp[21];
    a.w_cp = (const float*)(const GAS float*)kp[22];
    a.w_out = (const float*)(const GAS float*)kp[23];
    a.w_m1 = (const float*)(const GAS float*)kp[24];
    a.w_m2 = (const float*)(const GAS float*)kp[25];
    a.nfg = (const float*)(const GAS float*)kp[26];
    a.out = (float*)(GAS float*)kp[27]; a.ws = (unsigned char*)(GAS unsigned char*)kp[28]; a.ph_lo = 0; a.ph_hi = 0;
}

constexpr int N_PHASES = 15;
__global__ void __launch_bounds__(512, 2) nsa_fwd(Args a) {
    extern __shared__ __attribute__((aligned(16))) unsigned char lds_raw[];
    Frame F; F.lds = (LAS unsigned char*)lds_raw; F.tid = threadIdx.x; F.lane = F.tid & 63; F.wave = __builtin_amdgcn_readfirstlane(F.tid >> 6);
    F.G = gridDim.x; { const int bx = blockIdx.x; F.vcu = (F.G % 8 == 0) ? (bx % 8) * (F.G / 8) + bx / 8 : bx; }
    volatile LAS unsigned* MISC = (volatile LAS unsigned*)(F.lds + MISC_OFF);
    for (int u = F.tid; u < (LDS_BYTES - RING_BYTES) / 4; u += 512) ((LAS unsigned*)(F.lds + RING_BYTES))[u] = 0u;
    __syncthreads();
#if MK_PER_PHASE
#define GRID_BAR() do { } while (0)
#else
    XcdBarrier bar = xcd_barrier_post((unsigned*)(a.ws + WS_CTL) + 4096, MISC + 8);
#define GRID_BAR() xcd_barrier(bar)
#endif
    (void)MISC;
    const int lo = a.ph_lo, hi = a.ph_hi;
#ifdef DBG_ONLY
#define IN(k) ((k) == DBG_ONLY && lo <= (k) && (k) < hi)
#else
#define IN(k) (lo <= (k) && (k) < hi)
#endif
#define SEAM(k) do { if (IN(k) && IN((k) + 1)) GRID_BAR(); } while (0)
#define RUN(k) do { if (IN(k)) { Args la; load_args(la); phase##k(la, F, lds_raw); if (((DBG_REPEAT >> (k)) & 1) != 0) { __syncthreads(); phase##k(la, F, lds_raw); } } } while (0)
    RUN(0); SEAM(0);
    RUN(1); SEAM(1);
    RUN(2); SEAM(2);
    RUN(3); SEAM(3);
    RUN(4); SEAM(4);
    RUN(5); SEAM(5);
    RUN(6); SEAM(6);
    RUN(7); SEAM(7);
    RUN(8); SEAM(8);
    RUN(9); SEAM(9);
    RUN(10); SEAM(10);
    RUN(11); SEAM(11);
    RUN(12); SEAM(12);
    RUN(13);
#undef IN
#undef SEAM
}

extern "C" void kernel_launch(void* const* d_in, const int* in_sizes, int n_in, void* d_out, int out_size, void* d_ws, size_t ws_size, hipStream_t stream) {
    static int grid = 0;
    if (grid == 0) {
        if (n_in != 27 || (size_t)out_size != OUT_END || ws_size < WS_END) { fprintf(stderr, "kernel_launch: unexpected shapes (n_in %d out %d ws %zu need %zu)\n", n_in, out_size, ws_size, (size_t)WS_END); grid = -1; return; }
        int dev = 0, cus = 0;
        if (hipGetDevice(&dev) != hipSuccess || hipDeviceGetAttribute(&cus, hipDeviceAttributeMultiprocessorCount, dev) != hipSuccess) { grid = -1; return; }
        if (hipFuncSetAttribute((const void*)nsa_fwd, hipFuncAttributeMaxDynamicSharedMemorySize, LDS_BYTES) != hipSuccess) { fprintf(stderr, "kernel_launch: hipFuncSetAttribute failed\n"); grid = -1; return; }
        (void)hipGetLastError();
        grid = cus;
    }
    if (grid < 0) return;
    if (hipMemsetAsync((char*)d_ws + WS_CTL, 0, CTL_BYTES, stream) != hipSuccess) { fprintf(stderr, "kernel_launch: memset failed\n"); return; }
    Args a{};
    const float** fp = (const float**)&a;
    for (int i = 0; i < 27; ++i) fp[i] = (const float*)d_in[i];
    a.out = (float*)d_out; a.ws = (unsigned char*)d_ws;
#if MK_PER_PHASE
    for (int p = 0; p < N_PHASES - 1; ++p) { a.ph_lo = p; a.ph_hi = p + 1; hipLaunchKernelGGL(nsa_fwd, dim3(grid), dim3(512), LDS_BYTES, stream, a); }
#else
    a.ph_lo = 0; a.ph_hi = N_PHASES; hipLaunchKernelGGL(nsa_fwd, dim3(grid), dim3(512), LDS_BYTES, stream, a);
#endif
    const hipError_t le = hipPeekAtLastError();
    if (le != hipSuccess) fprintf(stderr, "kernel_launch: launch failed: %s\n", hipGetErrorName(le));
}
```

```cpp
#include <hip/hip_runtime.h>
#include <cstdio>
#include <cstdint>

#ifndef MK_PER_PHASE
#define MK_PER_PHASE 0
#endif

#ifndef DBG_REPEAT
#define DBG_REPEAT 0
#endif
#ifndef DBG_CHECK
#define DBG_CHECK 0
#endif
#define GATED ((DBG_CHECK & 7) == 0)
#define LAS __attribute__((address_space(3)))
typedef unsigned short bf16;
typedef short bf16x8 __attribute__((ext_vector_type(8)));
typedef float f32x4 __attribute__((ext_vector_type(4)));
typedef float f32x2 __attribute__((ext_vector_type(2)));
typedef unsigned u32x4 __attribute__((ext_vector_type(4)));
typedef unsigned u32x2 __attribute__((ext_vector_type(2)));

constexpr int D = 2048, NBP = 4, SEQ = 2048, NBS = 8, DSQ = 8, PAST = 16384, PAGE = 128, NPAGES = 128;
constexpr int HD = 128, NH = 16, NKV = 4, GRP = 4;
constexpr int MP = NBP * SEQ;
constexpr int MS = NBS * DSQ;
constexpr int MR = MP + MS;
constexpr int MPAD = 8448;
constexpr int NIN = 15616;
constexpr int NIN_REAL = 15408;
constexpr int DFF = 8192;
constexpr int NBATCH = NBP + NBS;
constexpr float RMS_EPS = 1e-6f;
constexpr float SCALE = 0.08838834764831845f;
constexpr int PC_Q = 0, PC_KV = 2048, PC_KWIN = 4096, PC_VWIN = 4608, PC_U = 5120, PC_B = 7168, PC_C = 9216, PC_MA = 11264, PC_MC = 13312, PC_G = 15360;
constexpr int NCP = 127, NCS = 1023;
constexpr int NSP = 32, NSS = 257;

constexpr int PRS = 256;
#define PX(P_, r_, c_) ((P_) + ((size_t)((c_) >> 8) * MPAD + (size_t)(r_)) * PRS + ((c_) & 255))
constexpr size_t OUT_YP = 0, OUT_YS = OUT_YP + (size_t)MP * D, OUT_KVP = OUT_YS + (size_t)MS * D, OUT_KVS = OUT_KVP + (size_t)MP * 2048,
                 OUT_WINP = OUT_KVS + (size_t)MS * 2048, OUT_WINS = OUT_WINP + (size_t)NBP * 512 * 1024, OUT_CONVP = OUT_WINS + (size_t)NBS * 512 * 1024,
                 OUT_CONVS = OUT_CONVP + (size_t)NBP * 2 * D, OUT_END = OUT_CONVS + (size_t)NBS * 2 * D;

constexpr size_t al256(size_t x) { return (x + 255) & ~(size_t)255; }
constexpr size_t WS_CTL = 0, CTL_BYTES = 1u << 20;
constexpr size_t WS_ADA = WS_CTL + CTL_BYTES;
constexpr size_t WS_PEB = al256(WS_ADA + (size_t)NBATCH * 6 * D * 4);
constexpr size_t WS_PEBP = al256(WS_PEB + 2 * 128 * 4);
constexpr size_t WS_WIN_T = al256(WS_PEBP + 2 * 32 * 128 * 4);
constexpr size_t WS_WP_T = al256(WS_WIN_T + (size_t)NIN * D * 2);
constexpr size_t WS_WOUT_T = al256(WS_WP_T + (size_t)D * 2 * D * 2);
constexpr size_t WS_W1_T = al256(WS_WOUT_T + (size_t)D * D * 2);
constexpr size_t WS_W2_T = al256(WS_W1_T + (size_t)DFF * D * 2);
constexpr size_t WS_WC_T = al256(WS_W2_T + (size_t)D * DFF * 2);
constexpr size_t WS_H = al256(WS_WC_T + (size_t)512 * 2048 * 2);
constexpr size_t WS_P = al256(WS_H + (size_t)MPAD * D * 2);
constexpr size_t WS_KV6 = al256(WS_P + (size_t)MPAD * NIN * 2);
constexpr size_t WS_CA = al256(WS_KV6 + (size_t)6 * NBP * NKV * SEQ * HD * 2);
constexpr size_t WS_PARTS = al256(WS_CA + (size_t)2 * NBS * NKV * PAST * HD * 2);
constexpr size_t WS_PARTP = al256(WS_PARTS + (size_t)32768 * 512 * 4);
constexpr size_t WS_KCS = al256(WS_PARTP + (size_t)2048 * 512 * 4);
constexpr size_t WS_KCP = al256(WS_KCS + (size_t)2 * NBS * NKV * 1024 * HD * 4);
constexpr size_t WS_OCMP = al256(WS_KCP + (size_t)2 * NBP * NKV * 128 * HD * 4);
constexpr size_t WS_OSLC = al256(WS_OCMP + (size_t)MPAD * D * 4);
constexpr size_t WS_OWIN = al256(WS_OSLC + (size_t)MPAD * D * 4);
constexpr size_t WS_SELP = al256(WS_OWIN + (size_t)MPAD * D * 4);
constexpr size_t WS_SELS = al256(WS_SELP + (size_t)NBP * NKV * SEQ * 4);
constexpr size_t WS_A2 = al256(WS_SELS + (size_t)NBS * NKV * DSQ * 16 * 4);
constexpr size_t WS_MIX = al256(WS_A2 + (size_t)MPAD * 2 * D * 2);
constexpr size_t WS_X1 = al256(WS_MIX + (size_t)MPAD * D * 2);
constexpr size_t WS_HM = al256(WS_X1 + (size_t)MPAD * D * 4);
constexpr size_t WS_X2 = al256(WS_HM + (size_t)MPAD * DFF * 2);
constexpr size_t WS_DBGA = al256(WS_X2 + (size_t)MPAD * D * 4);
constexpr size_t WS_DBGB = al256(WS_DBGA + (size_t)MPAD * D * 4);
constexpr size_t WS_DBGC = al256(WS_DBGB + (size_t)MPAD * D * 4);
constexpr size_t WS_SELP2 = al256(WS_DBGC + (size_t)MPAD * D * 4);
constexpr size_t WS_END = al256(WS_SELP2 + (size_t)NBP * NKV * SEQ * 4);

__device__ __forceinline__ float bf2f(bf16 b) { return __uint_as_float(((unsigned)b) << 16); }
__device__ __forceinline__ unsigned f2bf(float f) { unsigned u = __float_as_uint(f); return (u + 0x7fffu + ((u >> 16) & 1u)) >> 16; }
__device__ __forceinline__ unsigned pk2(float lo, float hi) { return f2bf(lo) | (f2bf(hi) << 16); }
__device__ __forceinline__ float lo_bf(unsigned w) { return __uint_as_float(w << 16); }
__device__ __forceinline__ float hi_bf(unsigned w) { return __uint_as_float(w & 0xffff0000u); }
__device__ __forceinline__ float sigmoidf_(float x) { return 1.0f / (1.0f + __expf(-x)); }
template <int C> __device__ __forceinline__ float dppf(float v) { return __int_as_float(__builtin_amdgcn_update_dpp(0, __float_as_int(v), C, 0xF, 0xF, true)); }
__device__ __forceinline__ float wave_sum(float v) {
    v += dppf<0xB1>(v); v += dppf<0x4E>(v); v += dppf<0x141>(v); v += dppf<0x140>(v);
    { auto r = __builtin_amdgcn_permlane16_swap(__float_as_uint(v), __float_as_uint(v), false, false); v = __uint_as_float(r[0]) + __uint_as_float(r[1]); }
    { auto r = __builtin_amdgcn_permlane32_swap(__float_as_uint(v), __float_as_uint(v), false, false); v = __uint_as_float(r[0]) + __uint_as_float(r[1]); }
    return v;
}
__device__ __forceinline__ float wave_max(float v) {
    v = fmaxf(v, dppf<0xB1>(v)); v = fmaxf(v, dppf<0x4E>(v)); v = fmaxf(v, dppf<0x141>(v)); v = fmaxf(v, dppf<0x140>(v));
    { auto r = __builtin_amdgcn_permlane16_swap(__float_as_uint(v), __float_as_uint(v), false, false); v = fmaxf(__uint_as_float(r[0]), __uint_as_float(r[1])); }
    { auto r = __builtin_amdgcn_permlane32_swap(__float_as_uint(v), __float_as_uint(v), false, false); v = fmaxf(__uint_as_float(r[0]), __uint_as_float(r[1])); }
    return v;
}
__device__ __forceinline__ float dpp_xor1(float v) { return __int_as_float(__builtin_amdgcn_update_dpp(0, __float_as_int(v), 0xB1, 0xF, 0xF, true)); }
__device__ __forceinline__ float dpp_xor2(float v) { return __int_as_float(__builtin_amdgcn_update_dpp(0, __float_as_int(v), 0x4E, 0xF, 0xF, true)); }
__device__ __forceinline__ int batch_of(int r) { return r < MP ? (r >> 11) : (NBP + (((r < MR ? r : MR - 1) - MP) >> 3)); }

namespace pg8 {
constexpr int BM = 256, BK = 64, HALF = 128, HTB = HALF * BK * 2, STAGE_BYTES = 8 * HTB, NXCD = 8, WGM = 8;
__host__ __device__ __forceinline__ int lds_byte(int r, int c) { const int st = (r >> 4) * 2 + (c >> 5), rr = r & 15, cc = c & 31, ob = rr * 64 + cc * 2; return st * 1024 + (ob ^ (((ob >> 9) & 1) << 5)); }
__host__ __device__ __forceinline__ void stage_rc(int b, int& R, int& C) { const int st = b / 1024, sb = b % 1024, swz = sb ^ (((sb >> 9) & 1) << 5); R = (st >> 1) * 16 + swz / 64; C = (st & 1) * 32 + (swz % 64) / 2; }
__host__ __device__ __forceinline__ int perm32(int rho) { const int n = rho >> 4, i = rho & 15; return 8 * (i >> 2) + 4 * n + (i & 3); }

struct Unit { int pm, pn, part; };
struct Prob { const char* A; const char* B; size_t a_tile, a_pn, a_part, b_tile, b_part; unsigned lda, ldb; int nt;
    __device__ __forceinline__ const char* a_ptr(const Unit& u) const { return A + (size_t)u.pm * a_tile + (size_t)u.pn * a_pn + (size_t)u.part * a_part; }
    __device__ __forceinline__ const char* b_ptr(const Unit& u) const { return B + (size_t)u.pn * b_tile + (size_t)u.part * b_part; } };

struct Order {
    int nM, nN, nwg, G, c, parts;
    __device__ void init(int M, int N, int G_, int c_, int parts_) { nM = M / BM; nN = N / BM; nwg = nM * nN; G = G_; c = c_; parts = parts_; }
    __device__ bool next(int i, Unit& u) const {
        const int ti = i / parts; u.part = i - ti * parts;
        const long L = (long)ti * G + c; if (L >= nwg) return false;
        int wgid = (int)L; { const int q = nwg / NXCD, r = nwg % NXCD, xcd = wgid % NXCD, off = wgid / NXCD; wgid = (xcd < r ? xcd * (q + 1) : r * (q + 1) + (xcd - r) * q) + off; }
        const int nig = WGM * nN, gid = wgid / nig, fm = gid * WGM, gsz = (nM - fm) < WGM ? (nM - fm) : WGM;
        u.pm = fm + ((wgid % nig) % gsz); u.pn = (wgid % nig) / gsz; return true;
    }
};
__device__ __forceinline__ unsigned cvt_pk_bf16(float lo, float hi) { unsigned r; asm volatile("v_cvt_pk_bf16_f32 %0, %1, %2" : "=v"(r) : "v"(lo), "v"(hi)); return r; }

template <class Epi, bool ALIGN_EPI = true, bool SP2 = true>
__device__ __forceinline__ void gemm_phase(LAS unsigned char* lds, const Prob g, const Order& S, const Epi& E) {
    const int tid = threadIdx.x, wid = __builtin_amdgcn_readfirstlane(tid >> 6), lane = tid & 63, wr = wid >> 2, wc = wid & 3, fr = lane & 15, fq = lane >> 4;
    const int nt = g.nt;
    unsigned voffA[2], voffB[2];
#pragma unroll
    for (int i = 0; i < 2; ++i) { int R, C; stage_rc(tid * 16 + i * 8192, R, C); const int Rb = Epi::PERM ? ((R & ~31) + perm32(R & 31)) : R;
        voffA[i] = (unsigned)R * g.lda + (unsigned)C * 2u; voffB[i] = (unsigned)Rb * g.ldb + (unsigned)C * 2u; }
    const size_t kstep = (size_t)(BK * 2);
    const size_t hstepA = (size_t)HALF * g.lda, hstepB = (size_t)HALF * g.ldb;
    const unsigned ldsw = (unsigned)wid * 1024u;
    const int aoff = lds_byte(wr * 64 + fr, fq * 8), boff = lds_byte(wc * 32 + fr, fq * 8);
#define PG8_SA(b, h) (((b) * 2 + (h)) * HTB)
#define PG8_SB(b, h) ((4 + (b) * 2 + (h)) * HTB)
#define PG8_STAGE(bufoff, gbase, voff) do { _Pragma("unroll") for (int _i = 0; _i < 2; ++_i) \
        __builtin_amdgcn_global_load_lds((const unsigned*)((const char*)(gbase) + (voff)[_i]), (LAS unsigned*)(lds + (bufoff) + ldsw + _i * 8192), 16, 0, 0); } while (0)
#define PG8_LDA(dst, b, h) do { _Pragma("unroll") for (int m = 0; m < 4; ++m) _Pragma("unroll") for (int k = 0; k < 2; ++k) dst[m][k] = *(const LAS bf16x8*)(lds + PG8_SA(b, h) + aoff + m * 2048 + k * 1024); } while (0)
#define PG8_LDB(dst, b, h) do { _Pragma("unroll") for (int n = 0; n < 2; ++n) _Pragma("unroll") for (int k = 0; k < 2; ++k) dst[n][k] = *(const LAS bf16x8*)(lds + PG8_SB(b, h) + boff + n * 2048 + k * 1024); } while (0)
#define PG8_MMA(ai, bj, At, Bt) do { __builtin_amdgcn_s_setprio(1); _Pragma("unroll") for (int m = 0; m < 4; ++m) _Pragma("unroll") for (int n = 0; n < 2; ++n) _Pragma("unroll") for (int k = 0; k < 2; ++k) \
        acc[ai][bj][m][n] = __builtin_amdgcn_mfma_f32_16x16x32_bf16(Bt[n][k], At[m][k], acc[ai][bj][m][n], 0, 0, 0); __builtin_amdgcn_s_setprio(0); } while (0)
#define PG8_WAIT_V(n) asm volatile("s_waitcnt vmcnt(" #n ")" ::: "memory")
#define PG8_WAIT_L(n) asm volatile("s_waitcnt lgkmcnt(" #n ")" ::: "memory")
#define PG8_BAR __builtin_amdgcn_s_barrier()
#define PG8_SCHED __builtin_amdgcn_sched_barrier(0)
    Unit cur, nxt; int ui = 0;
    if (!S.next(0, cur)) return;
    f32x4 acc[2][2][4][2];
#pragma unroll
    for (int a = 0; a < 2; ++a)
#pragma unroll
        for (int b = 0; b < 2; ++b)
#pragma unroll
            for (int m = 0; m < 4; ++m)
#pragma unroll
                for (int n = 0; n < 2; ++n) acc[a][b][m][n] = (f32x4){0.f, 0.f, 0.f, 0.f};
    bf16x8 At[4][2], B0[2][2], B1[2][2];
    const char* cA = g.a_ptr(cur); const char* cB = g.b_ptr(cur);
    if constexpr (SP2) {
        PG8_STAGE(PG8_SB(0, 0), cB, voffB); PG8_STAGE(PG8_SB(0, 1), cB + hstepB, voffB); PG8_STAGE(PG8_SA(0, 0), cA, voffA); PG8_STAGE(PG8_SA(0, 1), cA + hstepA, voffA);
        if (wr == 1) PG8_BAR;
        PG8_WAIT_V(2); PG8_BAR;
        PG8_STAGE(PG8_SB(1, 0), cB + kstep, voffB); PG8_STAGE(PG8_SA(1, 0), cA + kstep, voffA); PG8_STAGE(PG8_SB(1, 1), cB + hstepB + kstep, voffB);
        PG8_WAIT_V(6); PG8_BAR;
    } else {
        PG8_STAGE(PG8_SB(0, 0), cB, voffB); PG8_STAGE(PG8_SA(0, 0), cA, voffA); PG8_STAGE(PG8_SB(0, 1), cB + hstepB, voffB); PG8_STAGE(PG8_SA(0, 1), cA + hstepA, voffA);
        if (wr == 1) PG8_BAR;
        PG8_WAIT_V(4); PG8_BAR;
        PG8_STAGE(PG8_SB(1, 0), cB + kstep, voffB); PG8_STAGE(PG8_SA(1, 0), cA + kstep, voffA); PG8_STAGE(PG8_SB(1, 1), cB + hstepB + kstep, voffB);
        PG8_WAIT_V(6); PG8_BAR;
    }
    for (;;) {
        const bool has_next = S.next(ui + 1, nxt);
        const char* nA = has_next ? g.a_ptr(nxt) : cA; const char* nB = has_next ? g.b_ptr(nxt) : cB;
        for (int t = 0; t < nt; t += 2) {
            const bool last = (t == nt - 2);
            const char* a1 = cA + (size_t)(t + 1) * kstep;
            const char* a2 = last ? nA : cA + (size_t)(t + 2) * kstep; const char* b2 = last ? nB : cB + (size_t)(t + 2) * kstep;
            const char* a3 = a2 + kstep; const char* b3 = b2 + kstep;
            if constexpr (SP2) {
            PG8_LDB(B0, 0, 0); PG8_LDB(B1, 0, 1); PG8_SCHED; PG8_LDA(At, 0, 0); PG8_STAGE(PG8_SA(1, 1), a1 + hstepA, voffA);
            PG8_WAIT_V(8); PG8_WAIT_L(0); PG8_BAR; PG8_MMA(0, 0, At, B0); PG8_MMA(0, 1, At, B1); PG8_BAR; PG8_SCHED;
            PG8_LDA(At, 0, 1); PG8_STAGE(PG8_SB(0, 0), b2, voffB); PG8_STAGE(PG8_SB(0, 1), b2 + hstepB, voffB); PG8_STAGE(PG8_SA(0, 0), a2, voffA);
            PG8_WAIT_V(8); PG8_WAIT_L(0); PG8_BAR; PG8_MMA(1, 0, At, B0); PG8_MMA(1, 1, At, B1); PG8_BAR; PG8_SCHED;
            PG8_LDB(B0, 1, 0); PG8_LDB(B1, 1, 1); PG8_SCHED; PG8_LDA(At, 1, 0); PG8_STAGE(PG8_SA(0, 1), a2 + hstepA, voffA);
            PG8_WAIT_V(8); PG8_WAIT_L(0); PG8_BAR; PG8_MMA(0, 0, At, B0); PG8_MMA(0, 1, At, B1); PG8_BAR; PG8_SCHED;
            PG8_LDA(At, 1, 1); PG8_STAGE(PG8_SB(1, 0), b3, voffB); PG8_STAGE(PG8_SB(1, 1), b3 + hstepB, voffB); PG8_STAGE(PG8_SA(1, 0), a3, voffA);
            PG8_WAIT_V(8); PG8_WAIT_L(0); PG8_BAR; PG8_MMA(1, 0, At, B0); PG8_MMA(1, 1, At, B1); PG8_BAR; PG8_SCHED;
            } else {
            PG8_LDB(B0, 0, 0); PG8_SCHED; PG8_LDA(At, 0, 0); PG8_STAGE(PG8_SA(1, 1), a1 + hstepA, voffA);
            PG8_WAIT_L(8); PG8_BAR; PG8_WAIT_L(0); PG8_MMA(0, 0, At, B0); PG8_BAR; PG8_SCHED;
            PG8_LDB(B1, 0, 1); PG8_STAGE(PG8_SB(0, 0), b2, voffB);
            PG8_BAR; PG8_WAIT_L(0); PG8_MMA(0, 1, At, B1); PG8_BAR;
            PG8_LDA(At, 0, 1); PG8_STAGE(PG8_SA(0, 0), a2, voffA);
            PG8_BAR; PG8_WAIT_L(0); PG8_MMA(1, 0, At, B0); PG8_BAR; PG8_SCHED;
            PG8_STAGE(PG8_SB(0, 1), b2 + hstepB, voffB);
            PG8_WAIT_V(6); PG8_BAR; PG8_MMA(1, 1, At, B1); PG8_BAR;
            PG8_LDB(B0, 1, 0); PG8_SCHED; PG8_LDA(At, 1, 0); PG8_STAGE(PG8_SA(0, 1), a2 + hstepA, voffA);
            PG8_WAIT_L(8); PG8_BAR; PG8_WAIT_L(0); PG8_MMA(0, 0, At, B0); PG8_BAR; PG8_SCHED;
            PG8_LDB(B1, 1, 1); PG8_STAGE(PG8_SB(1, 0), b3, voffB);
            PG8_BAR; PG8_WAIT_L(0); PG8_MMA(0, 1, At, B1); PG8_BAR;
            PG8_LDA(At, 1, 1); PG8_STAGE(PG8_SA(1, 0), a3, voffA);
            PG8_BAR; PG8_WAIT_L(0); PG8_MMA(1, 0, At, B0); PG8_BAR; PG8_SCHED;
            PG8_STAGE(PG8_SB(1, 1), b3 + hstepB, voffB);
            PG8_WAIT_V(6); PG8_BAR; PG8_MMA(1, 1, At, B1); PG8_BAR;
            }
        }
        if constexpr (ALIGN_EPI) { if (wr == 0) PG8_BAR; }
        E(acc, cur, wr, wc, fr, fq);
        if (!has_next) break;
        if (!E.keep(cur)) {
#pragma unroll
        for (int a = 0; a < 2; ++a)
#pragma unroll
            for (int b = 0; b < 2; ++b)
#pragma unroll
                for (int m = 0; m < 4; ++m)
#pragma unroll
                    for (int n = 0; n < 2; ++n) acc[a][b][m][n] = (f32x4){0.f, 0.f, 0.f, 0.f};
        }
        cur = nxt; cA = nA; cB = nB; ++ui;
        if constexpr (ALIGN_EPI) { if (wr == 1) PG8_BAR; }
    }
    PG8_WAIT_V(0);
    if constexpr (!ALIGN_EPI) { if (wr == 0) PG8_BAR; }
    PG8_BAR;
#undef PG8_SA
#undef PG8_SB
#undef PG8_STAGE
#undef PG8_LDA
#undef PG8_LDB
#undef PG8_MMA
#undef PG8_WAIT_V
#undef PG8_WAIT_L
#undef PG8_BAR
#undef PG8_SCHED
}
}
using pg8::Unit;
typedef f32x4 AccT[2][2][4][2];

#define XB_TMO      128
#define XB_XCNT(j)  (256  + 64 * (j))
#define XB_XSUB(j)  (1280 + 64 * (j))
#define XB_XGEN(j)  (2304 + 64 * (j))
#define XB_TOP      3328
#define XB_TOPGEN   3392
#define XCD_BAR_WORDS 3456
#define XB_SPIN_CAP (1u << 18)
__device__ __forceinline__ unsigned xb_ld(unsigned* p)              { return __hip_atomic_load(p, __ATOMIC_RELAXED, __HIP_MEMORY_SCOPE_AGENT); }
__device__ __forceinline__ unsigned xb_add(unsigned* p, unsigned v) { return __hip_atomic_fetch_add(p, v, __ATOMIC_RELAXED, __HIP_MEMORY_SCOPE_AGENT); }
__device__ __forceinline__ unsigned xb_xcc_id() { return (unsigned)__builtin_amdgcn_s_getreg((3 << 11) | 20) & 0xFu; }
#define XB_SPIN(cond, bar) do { unsigned _sp = 0; while (cond) { __builtin_amdgcn_s_sleep(1); \
    if ((++_sp & 255u) == 0u) { if (xb_ld(&(bar)[XB_TMO])) break; if (_sp > XB_SPIN_CAP) { atomicAdd(&(bar)[XB_TMO], 1u); break; } } } } while (0)
struct XcdBarrier { unsigned* bar; unsigned x; volatile LAS unsigned* st; };
__device__ __forceinline__ XcdBarrier xcd_barrier_post(unsigned* bar, volatile LAS unsigned* st) {
    XcdBarrier b; b.bar = bar; b.x = xb_xcc_id(); b.st = st;
    if (threadIdx.x == 0) (void)xb_add(&bar[XB_XCNT(b.x)], 1u);
    return b;
}
__device__ __forceinline__ void xcd_barrier_complete(unsigned* bar, unsigned x, unsigned& nloc, unsigned& nx) {
    const unsigned G = gridDim.x * gridDim.y * gridDim.z;
    unsigned sum, cnt, mine, sp = 0u;
    for (;;) {
        sum = 0u; cnt = 0u; mine = 0u;
#pragma unroll
        for (unsigned j = 0; j < 16; ++j) { const unsigned c = xb_ld(&bar[XB_XCNT(j)]); sum += c; cnt += (c > 0u) ? 1u : 0u; mine = (j == x) ? c : mine; }
        if (sum == G) break;
        __builtin_amdgcn_s_sleep(1);
        if ((++sp & 255u) == 0u) { if (xb_ld(&bar[XB_TMO])) break; if (sp > XB_SPIN_CAP) { atomicAdd(&bar[XB_TMO], 1u); break; } }
    }
    nloc = mine > 0u ? mine : 1u; nx = cnt > 0u ? cnt : 1u;
}
__device__ __forceinline__ void xcd_barrier(const XcdBarrier& b) {
    asm volatile("s_waitcnt vmcnt(0)" ::: "memory");
    __syncthreads();
    if (threadIdx.x == 0) {
        unsigned* bar = b.bar;
        __builtin_amdgcn_s_waitcnt(0);
        unsigned nloc = b.st[0], nx = b.st[1];
        if (nloc == 0u) { xcd_barrier_complete(bar, b.x, nloc, nx); b.st[0] = nloc; b.st[1] = nx; }
        const unsigned old = xb_add(&bar[XB_XSUB(b.x)], 1u);
        const unsigned gen = old / nloc;
        if (old + 1u == (gen + 1u) * nloc) {
            __builtin_amdgcn_fence(__ATOMIC_RELEASE, "agent");
            asm volatile("s_waitcnt vmcnt(0)" ::: "memory");
            const unsigned og = xb_add(&bar[XB_TOP], 1u);
            const unsigned tg = og / nx;
            if (og + 1u == (tg + 1u) * nx) xb_add(&bar[XB_TOPGEN], 1u);
            else XB_SPIN(xb_ld(&bar[XB_TOPGEN]) == tg, bar);
            __builtin_amdgcn_fence(__ATOMIC_ACQUIRE, "agent");
            xb_add(&bar[XB_XGEN(b.x)], 1u);
            asm volatile("s_waitcnt vmcnt(0)" ::: "memory");
        } else {
            XB_SPIN(xb_ld(&bar[XB_XGEN(b.x)]) == gen, bar);
            __builtin_amdgcn_fence(__ATOMIC_ACQUIRE, "agent");
            asm volatile("s_waitcnt vmcnt(0)" ::: "memory");
        }
    }
    __syncthreads();
}

struct Args {
    const float *x_p, *x_s, *c_p, *c_s, *cache; const int* ptab; const float *st_win, *st_conv, *w_ada, *b_ada, *n1g, *n2g, *w_in,
        *wck1, *wck2, *pek, *wcv1, *wcv2, *pev, *conv_w, *conv_b, *w_ap, *w_cp, *w_out, *w_m1, *w_m2, *nfg;
    float* out; unsigned char* ws; int ph_lo, ph_hi;
};
struct Frame { LAS unsigned char* lds; int tid, lane, wave, vcu, G; };
constexpr int LDS_BYTES = 147456;
constexpr int RING_BYTES = 131072, MISC_OFF = RING_BYTES + 320;

__device__ __forceinline__ const float* x_row(const Args& a, int r) { const int rr = r < MR ? r : MR - 1; return rr < MP ? a.x_p + (size_t)rr * D : a.x_s + (size_t)(rr - MP) * D; }

__device__ __forceinline__ void ph_ada(const Args& a, const Frame& F) {
    LAS float* sc = (LAS float*)F.lds;
    LAS float* red = sc + NBATCH * D;
    float* ada = (float*)(a.ws + WS_ADA);
    for (int i = F.tid; i < NBATCH * D; i += 512) { const int bi = i / D, k = i % D; const float v = bi < NBP ? a.c_p[bi * D + k] : a.c_s[(bi - NBP) * D + k]; sc[i] = v / (1.0f + __expf(-v)); }
    __syncthreads();
    const int cg = F.tid & 15, sl = F.tid >> 4;
    for (int ch = F.vcu; ch < 6 * D / 64; ch += F.G) {
        f32x4 acc[NBATCH];
#pragma unroll
        for (int b = 0; b < NBATCH; ++b) acc[b] = (f32x4){0.f, 0.f, 0.f, 0.f};
        const float* w = a.w_ada + (size_t)(sl * 64) * (6 * D) + ch * 64 + cg * 4;
#pragma unroll 1
        for (int k0 = 0; k0 < 64; k0 += 16) { f32x4 wv[16];
#pragma unroll
            for (int k = 0; k < 16; ++k) wv[k] = __builtin_nontemporal_load((const f32x4*)(w + (size_t)(k0 + k) * (6 * D)));
#pragma unroll
            for (int k = 0; k < 16; ++k)
#pragma unroll
                for (int b = 0; b < NBATCH; ++b) acc[b] += sc[b * D + sl * 64 + k0 + k] * wv[k]; }
#pragma unroll
        for (int b = 0; b < NBATCH; ++b)
#pragma unroll
            for (int e = 0; e < 4; ++e) { float v = acc[b][e]; v += __shfl_xor(v, 16); v += __shfl_xor(v, 32); acc[b][e] = v; }
        if (F.lane < 16) {
#pragma unroll
            for (int b = 0; b < NBATCH; ++b) *(LAS f32x4*)(red + (F.wave * NBATCH + b) * 64 + cg * 4) = acc[b]; }
        __syncthreads();
        for (int i = F.tid; i < NBATCH * 64; i += 512) { const int b = i >> 6, jj = i & 63; float s_ = 0.f;
#pragma unroll
            for (int q = 0; q < 8; ++q) s_ += red[(q * NBATCH + b) * 64 + jj];
            ada[(size_t)b * 6 * D + ch * 64 + jj] = s_ + a.b_ada[ch * 64 + jj]; }
        __syncthreads();
    }
    for (int u = F.G - 1 - F.vcu; u < 64; u += F.G) { const int kind = u >> 5, sl = u & 31;
        const float* pe = (kind ? a.pev : a.pek) + sl * 128; const float* w1 = (kind ? a.wcv1 : a.wck1) + (size_t)sl * 128 * 128;
        const int f = F.tid & 127, q = F.tid >> 7; float s_ = 0.f;
#pragma unroll 8
        for (int jj = q * 32; jj < (q + 1) * 32; ++jj) s_ += pe[jj] * w1[(size_t)jj * 128 + f];
        __syncthreads(); red[q * 128 + f] = s_; __syncthreads();
        if (F.tid < 128) ((float*)(a.ws + WS_PEBP))[(kind * 32 + sl) * 128 + f] = red[f] + red[128 + f] + red[256 + f] + red[384 + f];
    }
}
__device__ __forceinline__ void ph_peb_sum(const Args& a, const Frame& F) {
    if (F.vcu == 0 && F.tid < 256) { const float* pp = (const float*)(a.ws + WS_PEBP) + (F.tid >> 7) * 32 * 128 + (F.tid & 127); float s_ = 0.f;
#pragma unroll 8
        for (int sl = 0; sl < 32; ++sl) s_ += pp[sl * 128];
        ((float*)(a.ws + WS_PEB))[F.tid] = s_; }
}
struct TrD { const float* W; bf16* WT; int ldw, ldt, k0, ns, nd, nv; };
__device__ __forceinline__ void tr_load(const TrD& d, f32x4 (&tv)[8], int lane) {
    const int n4 = (lane & 7) * 4;
#pragma unroll
    for (int i = 0; i < 8; ++i) { const int kk = 8 * i + (lane >> 3); tv[i] = n4 < d.nv ? __builtin_nontemporal_load((const f32x4*)(d.W + (size_t)(d.k0 + kk) * d.ldw + d.ns + n4)) : (f32x4){0.f, 0.f, 0.f, 0.f}; }
}
__device__ __forceinline__ void tr_finish(const TrD& d, const f32x4 (&tv)[8], LAS float* scr, int lane) {
    const int n4 = (lane & 7) * 4;
#pragma unroll
    for (int i = 0; i < 8; ++i) { const int kk = 8 * i + (lane >> 3); *(LAS f32x4*)(scr + kk * 36 + n4) = tv[i]; }
    asm volatile("s_waitcnt lgkmcnt(0)" ::: "memory");
    const int c = lane & 7;
#pragma unroll
    for (int j = 0; j < 4; ++j) { const int n = (lane >> 3) + 8 * j; const LAS float* s = scr + (8 * c) * 36 + n;
        u32x4 o; o.x = pk2(s[0 * 36], s[1 * 36]); o.y = pk2(s[2 * 36], s[3 * 36]); o.z = pk2(s[4 * 36], s[5 * 36]); o.w = pk2(s[6 * 36], s[7 * 36]);
        *(u32x4*)(d.WT + (size_t)(d.nd + n) * d.ldt + d.k0 + 8 * c) = o; }
    asm volatile("s_waitcnt lgkmcnt(0)" ::: "memory");
}
__device__ __forceinline__ TrD tr_decode(const Args& a, int it) {
    constexpr int I_IN = 32 * (NIN / 32), I_P = 32 * 64, I_O = 32 * 64, I_1 = 32 * 256, I_2 = 128 * 64, I_C = 32 * 4;
    bf16* win_t = (bf16*)(a.ws + WS_WIN_T); bf16* wp_t = (bf16*)(a.ws + WS_WP_T); bf16* wout_t = (bf16*)(a.ws + WS_WOUT_T);
    bf16* w1_t = (bf16*)(a.ws + WS_W1_T); bf16* w2_t = (bf16*)(a.ws + WS_W2_T); bf16* wc_t = (bf16*)(a.ws + WS_WC_T);
    int r = it;
    if (r < I_IN) { const int nb = r % (NIN / 32), kb = r / (NIN / 32), nd = nb * 32; int ns, nv;
        if (nd < PC_U) { ns = nd; nv = 32; } else if (nd < PC_G) { ns = nd + 48; nv = 32; } else { ns = 5120 + (nd - PC_G); nv = 5168 - ns; nv = nv < 0 ? 0 : (nv > 32 ? 32 : nv); }
        return TrD{a.w_in, win_t, NIN_REAL, D, kb * 64, ns, nd, nv}; } r -= I_IN;
    if (r < I_P) return TrD{a.w_ap, wp_t, D, 2 * D, (r / 64) * 64, (r % 64) * 32, (r % 64) * 32, 32}; r -= I_P;
    if (r < I_P) return TrD{a.w_cp, wp_t + D, D, 2 * D, (r / 64) * 64, (r % 64) * 32, (r % 64) * 32, 32}; r -= I_P;
    if (r < I_O) return TrD{a.w_out, wout_t, D, D, (r / 64) * 64, (r % 64) * 32, (r % 64) * 32, 32}; r -= I_O;
    if (r < I_1) return TrD{a.w_m1, w1_t, DFF, D, (r / 256) * 64, (r % 256) * 32, (r % 256) * 32, 32}; r -= I_1;
    if (r < I_2) return TrD{a.w_m2, w2_t, D, DFF, (r / 64) * 64, (r % 64) * 32, (r % 64) * 32, 32}; r -= I_2;
    { const int q = r / I_C, rr = r % I_C, kind = q >> 1, s = q & 1;
      const float* w1 = (kind ? a.wcv1 : a.wck1) + (size_t)s * 2048 * 128;
      return TrD{w1, wc_t + (size_t)(kind * 256 + s * 128) * 2048, 128, 2048, (rr / 4) * 64, (rr % 4) * 32, (rr % 4) * 32, 32}; }
}
constexpr int TR_I_C = 32 * 4, TR_NIT = 32 * (NIN / 32) + 2 * 32 * 64 + 32 * 64 + 32 * 256 + 128 * 64 + 4 * TR_I_C, TR_NBIG = TR_NIT - 4 * TR_I_C;
constexpr int TR_EARLY = 3072;
__device__ __forceinline__ void ph_transpose_range(const Args& a, const Frame& F, int ibeg, int iend, int widx, int wcnt) {
    LAS float* scr = (LAS float*)F.lds + F.wave * (64 * 36);
    const int NGW = wcnt * 8; int it = ibeg + widx * 8 + F.wave; const int end = iend;
    if (it >= end) return;
    f32x4 ta[8], tb[8]; TrD da = tr_decode(a, it), db = da; tr_load(da, ta, F.lane);
#pragma unroll 1
    for (;;) {
        int itn = it + NGW; bool hn = itn < end;
        if (hn) { db = tr_decode(a, itn); tr_load(db, tb, F.lane); }
        tr_finish(da, ta, scr, F.lane);
        if (!hn) break;
        it = itn; itn = it + NGW; hn = itn < end;
        if (hn) { da = tr_decode(a, itn); tr_load(da, ta, F.lane); }
        tr_finish(db, tb, scr, F.lane);
        if (!hn) break;
        it = itn;
    }
}
__device__ __forceinline__ void ph_cache_cvt(const Args& a, const Frame& F) {
    const int gw = F.vcu * 8 + F.wave, NGW = F.G * 8; bf16* ca = (bf16*)(a.ws + WS_CA);
    const int l = F.lane, kind = l >> 5, kvh = (l & 31) >> 3, d0 = (l & 7) * 16;
    for (int it0 = gw; it0 < NBS * PAST; it0 += 2 * NGW) {
        f32x4 v[2][4]; bool ok[2];
#pragma unroll
        for (int u = 0; u < 2; ++u) { const int it = it0 + u * NGW; ok[u] = it < NBS * PAST; const int itc = ok[u] ? it : it0; const int b = itc >> 14, pos = itc & (PAST - 1);
            const int page = a.ptab[b * NPAGES + (pos >> 7)];
            const float* src = a.cache + ((size_t)page * PAGE + (pos & 127)) * 2048 + l * 16;
#pragma unroll
            for (int q = 0; q < 4; ++q) v[u][q] = __builtin_nontemporal_load((const f32x4*)src + q); }
#pragma unroll
        for (int u = 0; u < 2; ++u) if (ok[u]) { const int it = it0 + u * NGW; const int b = it >> 14, pos = it & (PAST - 1);
            u32x4 o0 = {pk2(v[u][0][0], v[u][0][1]), pk2(v[u][0][2], v[u][0][3]), pk2(v[u][1][0], v[u][1][1]), pk2(v[u][1][2], v[u][1][3])};
            u32x4 o1 = {pk2(v[u][2][0], v[u][2][1]), pk2(v[u][2][2], v[u][2][3]), pk2(v[u][3][0], v[u][3][1]), pk2(v[u][3][2], v[u][3][3])};
            bf16* dst = ca + ((((size_t)kind * NBS + b) * NKV + kvh) * PAST + pos) * HD + d0;
            *(u32x4*)dst = o0; *(u32x4*)(dst + 8) = o1; }
    }
}

template <int WHICH> __device__ __forceinline__ void ph_modnorm(const Args& a, const Frame& F) {
    const int gw = F.vcu * 8 + F.wave, NGW = F.G * 8; const float* ada = (const float*)(a.ws + WS_ADA);
    bf16* H = (bf16*)(a.ws + WS_H); const float* g = WHICH ? a.n2g : a.n1g;
#pragma unroll 1
    for (int r0 = gw * 4; r0 < MP; r0 += NGW * 4) {
        const int bi = r0 >> 11; const float* sh = ada + (size_t)bi * 6 * D + (WHICH ? 3 * D : 0); const float* sc = sh + D;
        f32x4 ga[8], sb[8];
#pragma unroll
        for (int j = 0; j < 8; ++j) { const int c = (F.lane + 64 * j) * 4; const f32x4 gg = *(const f32x4*)(g + c), s1 = *(const f32x4*)(sc + c); sb[j] = *(const f32x4*)(sh + c);
#pragma unroll
            for (int e = 0; e < 4; ++e) ga[j][e] = gg[e] * (1.0f + s1[e]); }
#pragma unroll 2
        for (int i = 0; i < 4; ++i) { const int r = r0 + i;
            const float* xr = WHICH ? (const float*)(a.ws + WS_X1) + (size_t)r * D : a.x_p + (size_t)r * D; bf16* orow = H + (size_t)r * D;
            f32x4 v[8]; float ss = 0.f;
#pragma unroll
            for (int j = 0; j < 8; ++j) { v[j] = *(const f32x4*)(xr + (F.lane + 64 * j) * 4); ss += (v[j][0] * v[j][0] + v[j][1] * v[j][1]) + (v[j][2] * v[j][2] + v[j][3] * v[j][3]); }
            const float rstd = rsqrtf(wave_sum(ss) * (1.0f / D) + RMS_EPS);
#pragma unroll
            for (int j = 0; j < 8; ++j) { const int c = (F.lane + 64 * j) * 4; f32x4 o;
#pragma unroll
                for (int e = 0; e < 4; ++e) o[e] = v[j][e] * rstd * ga[j][e] + sb[j][e];
                *(u32x2*)(orow + c) = (u32x2){pk2(o[0], o[1]), pk2(o[2], o[3])}; } }
    }
    for (int r = MP + gw; r < MPAD; r += NGW) {
        bf16* orow = H + (size_t)r * D;
        if (r >= MR) { for (int j = 0; j < 4; ++j) *(u32x4*)(orow + (F.lane + 64 * j) * 8) = (u32x4){0u, 0u, 0u, 0u}; continue; }
        const float* xr = WHICH ? (const float*)(a.ws + WS_X1) + (size_t)r * D : x_row(a, r);
        const int bi = batch_of(r); const float* sh = ada + (size_t)bi * 6 * D + (WHICH ? 3 * D : 0); const float* sc = sh + D;
        f32x4 v[8]; float ss = 0.f;
#pragma unroll
        for (int j = 0; j < 8; ++j) { v[j] = *(const f32x4*)(xr + (F.lane + 64 * j) * 4); ss += (v[j][0] * v[j][0] + v[j][1] * v[j][1]) + (v[j][2] * v[j][2] + v[j][3] * v[j][3]); }
        const float rstd = rsqrtf(wave_sum(ss) * (1.0f / D) + RMS_EPS);
#pragma unroll
        for (int j = 0; j < 8; ++j) { const int c = (F.lane + 64 * j) * 4; const f32x4 gg = *(const f32x4*)(g + c), s1 = *(const f32x4*)(sc + c), s0 = *(const f32x4*)(sh + c);
            f32x4 o;
#pragma unroll
            for (int e = 0; e < 4; ++e) o[e] = v[j][e] * rstd * gg[e] * (1.0f + s1[e]) + s0[e];
            *(u32x2*)(orow + c) = (u32x2){pk2(o[0], o[1]), pk2(o[2], o[3])}; }
    }
}

struct EpiIn {
    static constexpr bool PERM = true;
    bf16* P; bf16* KV6; float* out;
    __device__ __forceinline__ bool keep(const Unit&) const { return false; }
    __device__ __forceinline__ void operator()(AccT& acc, const Unit& u, int wr, int wc, int fr, int fq) const {
        const int row0 = u.pm * 256 + wr * 64 + fr, colt = u.pn * 256 + wc * 32 + 8 * fq;
#pragma unroll
        for (int ai = 0; ai < 2; ++ai)
#pragma unroll
            for (int m = 0; m < 4; ++m) { const int r = row0 + ai * 128 + m * 16;
#pragma unroll
                for (int bj = 0; bj < 2; ++bj) { const int c = colt + bj * 128; const f32x4 v0 = acc[ai][bj][m][0], v1 = acc[ai][bj][m][1];
                    u32x4 w; w.x = pg8::cvt_pk_bf16(v0[0], v0[1]); w.y = pg8::cvt_pk_bf16(v0[2], v0[3]); w.z = pg8::cvt_pk_bf16(v1[0], v1[1]); w.w = pg8::cvt_pk_bf16(v1[2], v1[3]);
                    *(u32x4*)PX(P, r, c) = w;
                    if (u.pn >= 8 && u.pn < 20 && r < MR) {
                        const int cc = c - PC_KV, kind = cc >> 9, kvh = (cc >> 7) & 3, d = cc & 127;
                        if (r < MP) { const int b = r >> 11, s = r & 2047;
                            *(u32x4*)(KV6 + ((((size_t)kind * NBP + b) * NKV + kvh) * SEQ + s) * HD + d) = w;
                            if (u.pn < 16) { float* o = out + OUT_KVP + (size_t)r * 2048 + cc; *(f32x4*)o = v0; *(f32x4*)(o + 4) = v1; }
                            else if (s >= SEQ - 512) { float* o = out + OUT_WINP + ((size_t)b * 512 + (s - (SEQ - 512))) * 1024 + (c - PC_KWIN); *(f32x4*)o = v0; *(f32x4*)(o + 4) = v1; }
                        } else { const int rs = r - MP, b = rs >> 3, s = rs & 7;
                            if (u.pn < 16) { float* o = out + OUT_KVS + (size_t)rs * 2048 + cc; *(f32x4*)o = v0; *(f32x4*)(o + 4) = v1; }
                            else { float* o = out + OUT_WINS + ((size_t)b * 512 + 504 + s) * 1024 + (c - PC_KWIN); *(f32x4*)o = v0; *(f32x4*)(o + 4) = v1; }
                        }
                    }
                } }
    }
};
struct EpiF32 {
    static constexpr bool PERM = false;
    float* C; int ldc;
    __device__ __forceinline__ bool keep(const Unit&) const { return false; }
    __device__ __forceinline__ void operator()(AccT& acc, const Unit& u, int wr, int wc, int fr, int fq) const {
        const int row0 = u.pm * 256 + wr * 64 + fr, col0 = u.pn * 256 + wc * 32 + 4 * fq;
#pragma unroll
        for (int ai = 0; ai < 2; ++ai)
#pragma unroll
            for (int m = 0; m < 4; ++m) { float* rowp = C + (size_t)(row0 + ai * 128 + m * 16) * ldc + col0;
#pragma unroll
                for (int bj = 0; bj < 2; ++bj)
#pragma unroll
                    for (int n = 0; n < 2; ++n) *(f32x4*)(rowp + bj * 128 + n * 16) = acc[ai][bj][m][n]; }
    }
};
struct EpiNull {
    static constexpr bool PERM = true;
    float* C;
    __device__ __forceinline__ bool keep(const Unit&) const { return false; }
    __device__ __forceinline__ void operator()(AccT& acc, const Unit& u, int wr, int wc, int fr, int fq) const {
        f32x4 t = acc[0][0][0][0];
#pragma unroll
        for (int ai = 0; ai < 2; ++ai)
#pragma unroll
            for (int bj = 0; bj < 2; ++bj)
#pragma unroll
                for (int m = 0; m < 4; ++m)
#pragma unroll
                    for (int n = 0; n < 2; ++n) t += acc[ai][bj][m][n];
        *(f32x4*)(C + ((size_t)(u.pm * 61 + u.pn) * 512 + threadIdx.x) * 4) = t; }
};
struct EpiProj {
    static constexpr bool PERM = true;
    const bf16* P; bf16* MIX;
    __device__ __forceinline__ bool keep(const Unit& u) const { return u.part == 0; }
    __device__ __forceinline__ void operator()(AccT& acc, const Unit& u, int wr, int wc, int fr, int fq) const {
        const int row0 = u.pm * 256 + wr * 64 + fr, colt = u.pn * 256 + wc * 32 + 8 * fq;
#pragma unroll
        for (int ai = 0; ai < 2; ++ai)
#pragma unroll
            for (int m = 0; m < 4; ++m) { const int r = row0 + ai * 128 + m * 16;
#pragma unroll
                for (int bj = 0; bj < 2; ++bj) { const int c = colt + bj * 128;
                    const u32x4 mc = *(const u32x4*)PX(P, r, PC_MC + c);
                    float sc[8];
#pragma unroll
                    for (int e = 0; e < 4; ++e) { sc[2 * e] = sigmoidf_(lo_bf(mc[e])); sc[2 * e + 1] = sigmoidf_(hi_bf(mc[e])); }
                    if (u.part == 0) {
                        const u32x4 ma = *(const u32x4*)PX(P, r, PC_MA + c);
#pragma unroll
                        for (int e = 0; e < 4; ++e) { const float s0 = sigmoidf_(lo_bf(ma[e])) / sc[2 * e], s1 = sigmoidf_(hi_bf(ma[e])) / sc[2 * e + 1];
                            acc[ai][bj][m][e >> 1][(e & 1) * 2] *= s0; acc[ai][bj][m][e >> 1][(e & 1) * 2 + 1] *= s1; }
                    } else {
                        const f32x4 v0 = acc[ai][bj][m][0], v1 = acc[ai][bj][m][1];
                        u32x4 w; w.x = pg8::cvt_pk_bf16(v0[0] * sc[0], v0[1] * sc[1]); w.y = pg8::cvt_pk_bf16(v0[2] * sc[2], v0[3] * sc[3]);
                        w.z = pg8::cvt_pk_bf16(v1[0] * sc[4], v1[1] * sc[5]); w.w = pg8::cvt_pk_bf16(v1[2] * sc[6], v1[3] * sc[7]);
                        *(u32x4*)(MIX + (size_t)r * D + c) = w;
                    }
                } }
    }
};
template <int WHICH> struct EpiRes {
    static constexpr bool PERM = false;
    Args a;
    __device__ __forceinline__ bool keep(const Unit&) const { return false; }
    __device__ __forceinline__ void operator()(AccT& acc, const Unit& u, int wr, int wc, int fr, int fq) const {
        const int row0 = u.pm * 256 + wr * 64 + fr, col0 = u.pn * 256 + wc * 32 + 4 * fq;
        const float* ada = (const float*)(a.ws + WS_ADA); float* O = (float*)(a.ws + (WHICH ? WS_X2 : WS_X1));
#pragma unroll
        for (int ai = 0; ai < 2; ++ai)
#pragma unroll
            for (int m = 0; m < 4; ++m) { const int r = row0 + ai * 128 + m * 16;
                const float* base = WHICH ? (const float*)(a.ws + WS_X1) + (size_t)r * D : x_row(a, r);
                const float* gate = ada + (size_t)batch_of(r) * 6 * D + (WHICH ? 5 * D : 2 * D);
#pragma unroll
                for (int bj = 0; bj < 2; ++bj)
#pragma unroll
                    for (int n = 0; n < 2; ++n) { const int c = col0 + bj * 128 + n * 16; const f32x4 bs = *(const f32x4*)(base + c), gg = *(const f32x4*)(gate + c);
                        *(f32x4*)(O + (size_t)r * D + c) = bs + gg * acc[ai][bj][m][n]; } }
    }
};
struct EpiRelu2 {
    static constexpr bool PERM = true;
    bf16* HM;
    __device__ __forceinline__ bool keep(const Unit&) const { return false; }
    __device__ __forceinline__ void operator()(AccT& acc, const Unit& u, int wr, int wc, int fr, int fq) const {
        const int row0 = u.pm * 256 + wr * 64 + fr, colt = u.pn * 256 + wc * 32 + 8 * fq;
#pragma unroll
        for (int ai = 0; ai < 2; ++ai)
#pragma unroll
            for (int m = 0; m < 4; ++m) { const int r = row0 + ai * 128 + m * 16;
#pragma unroll
                for (int bj = 0; bj < 2; ++bj) { const int c = colt + bj * 128; f32x4 v0 = acc[ai][bj][m][0], v1 = acc[ai][bj][m][1];
#pragma unroll
                    for (int e = 0; e < 4; ++e) { const float p = fmaxf(v0[e], 0.f), q = fmaxf(v1[e], 0.f); v0[e] = p * p; v1[e] = q * q; }
                    u32x4 w; w.x = pg8::cvt_pk_bf16(v0[0], v0[1]); w.y = pg8::cvt_pk_bf16(v0[2], v0[3]); w.z = pg8::cvt_pk_bf16(v1[0], v1[1]); w.w = pg8::cvt_pk_bf16(v1[2], v1[3]);
                    *(u32x4*)(HM + (size_t)r * DFF + c) = w; } }
    }
};


template <int NC, int NPART, class Epi>
__device__ __forceinline__ void small_gemm(const Frame& F, const bf16* A, int lda, int a_part, const bf16* Bt, int ldb, int b_part, int K, int N, const Epi& E) {
    constexpr int NF = (NC + 15) / 16, NCP = NF * 16;
    LAS float* red = (LAS float*)F.lds;
    const int lane = F.lane, lr = lane & 15, lk = lane >> 4, ks = K / 8, kbeg = F.wave * ks;
    for (int ch = F.vcu; ch < N / NC; ch += F.G) {
        const int n0 = ch * NC;
        f32x4 acc[NPART][4][NF];
#pragma unroll
        for (int p = 0; p < NPART; ++p)
#pragma unroll
            for (int m = 0; m < 4; ++m)
#pragma unroll
                for (int nf = 0; nf < NF; ++nf) acc[p][m][nf] = (f32x4){0.f, 0.f, 0.f, 0.f};
#pragma unroll
        for (int p = 0; p < NPART; ++p) {
            const bf16* Ap = A + p * a_part + (size_t)lr * lda + kbeg + lk * 8;
            const bf16* Bp[NF];
#pragma unroll
            for (int nf = 0; nf < NF; ++nf) { int col = nf * 16 + lr; col = col < NC ? col : NC - 1; Bp[nf] = Bt + p * b_part + (size_t)(n0 + col) * ldb + kbeg + lk * 8; }
#pragma unroll 4
            for (int k = 0; k < ks; k += 32) {
                bf16x8 af[4], bfr[NF];
#pragma unroll
                for (int m = 0; m < 4; ++m) af[m] = *(const bf16x8*)(Ap + (size_t)(m * 16) * lda + k);
#pragma unroll
                for (int nf = 0; nf < NF; ++nf) bfr[nf] = *(const bf16x8*)(Bp[nf] + k);
#pragma unroll
                for (int m = 0; m < 4; ++m)
#pragma unroll
                    for (int nf = 0; nf < NF; ++nf) acc[p][m][nf] = __builtin_amdgcn_mfma_f32_16x16x32_bf16(af[m], bfr[nf], acc[p][m][nf], 0, 0, 0);
            }
        }
        __syncthreads();
#pragma unroll
        for (int p = 0; p < NPART; ++p)
#pragma unroll
            for (int m = 0; m < 4; ++m)
#pragma unroll
                for (int nf = 0; nf < NF; ++nf)
#pragma unroll
                    for (int i = 0; i < 4; ++i) red[((F.wave * NPART + p) * 64 + m * 16 + lk * 4 + i) * NCP + nf * 16 + lr] = acc[p][m][nf][i];
        __syncthreads();
        for (int e = F.tid; e < 64 * NC; e += 512) { const int row = e / NC, col = e % NC; float v[NPART];
#pragma unroll
            for (int p = 0; p < NPART; ++p) { float sacc = 0.f;
#pragma unroll
                for (int w = 0; w < 8; ++w) sacc += red[((w * NPART + p) * 64 + row) * NCP + col];
                v[p] = sacc; }
            E(row, n0 + col, v); }
    }
    __syncthreads();
}
struct SEpiProj { const bf16* P; bf16* MIX;
    __device__ __forceinline__ void operator()(int row, int c, const float (&v)[2]) const { const int r = MP + row;
        const float o = sigmoidf_(bf2f(*PX(P, r, PC_MA + c))) * v[0] + sigmoidf_(bf2f(*PX(P, r, PC_MC + c))) * v[1]; MIX[(size_t)r * D + c] = (bf16)f2bf(o); } };
template <int WHICH> struct SEpiRes { Args a;
    __device__ __forceinline__ void operator()(int row, int c, const float (&v)[1]) const { const int r = MP + row; const float* ada = (const float*)(a.ws + WS_ADA);
        const float base = WHICH ? ((const float*)(a.ws + WS_X1))[(size_t)r * D + c] : a.x_s[(size_t)row * D + c];
        const float gate = ada[(size_t)batch_of(r) * 6 * D + (WHICH ? 5 * D : 2 * D) + c];
        ((float*)(a.ws + (WHICH ? WS_X2 : WS_X1)))[(size_t)r * D + c] = base + gate * v[0]; } };
struct SEpiRelu2 { bf16* HM;
    __device__ __forceinline__ void operator()(int row, int c, const float (&v)[1]) const { const float p = fmaxf(v[0], 0.f); HM[(size_t)(MP + row) * DFF + c] = (bf16)f2bf(p * p); } };


__device__ __forceinline__ void ph_compress_prompt(const Args& a, const Frame& F) {
    LAS float* red = (LAS float*)F.lds;
    const bf16* kv6 = (const bf16*)(a.ws + WS_KV6); const bf16* wct = (const bf16*)(a.ws + WS_WC_T); float* partp = (float*)(a.ws + WS_PARTP);
    const int lane = F.lane, lr = lane & 15, lk = lane >> 4, kbeg = F.wave * 256;
#pragma unroll 1
    for (int unit = F.vcu; unit < 256; unit += F.G) {
        const int kind = unit >> 7, rb = (unit >> 2) & 31, cb = unit & 3;
        const bf16* Ap = kv6 + (size_t)kind * NBP * NKV * SEQ * HD + (size_t)(rb * 64 + lr) * 2048 + kbeg + lk * 8;
        const bf16* Bp = wct + (size_t)(kind * 256 + cb * 64 + lr) * 2048 + kbeg + lk * 8;
        f32x4 acc[4][4];
#pragma unroll
        for (int m = 0; m < 4; ++m)
#pragma unroll
            for (int n = 0; n < 4; ++n) acc[m][n] = (f32x4){0.f, 0.f, 0.f, 0.f};
#pragma unroll 2
        for (int k = 0; k < 256; k += 32) {
            bf16x8 af[4], bfr[4];
#pragma unroll
            for (int m = 0; m < 4; ++m) af[m] = *(const bf16x8*)(Ap + (size_t)(m * 16) * 2048 + k);
#pragma unroll
            for (int n = 0; n < 4; ++n) bfr[n] = *(const bf16x8*)(Bp + (size_t)(n * 16) * 2048 + k);
#pragma unroll
            for (int m = 0; m < 4; ++m)
#pragma unroll
                for (int n = 0; n < 4; ++n) acc[m][n] = __builtin_amdgcn_mfma_f32_16x16x32_bf16(af[m], bfr[n], acc[m][n], 0, 0, 0);
        }
        __syncthreads();
#pragma unroll
        for (int m = 0; m < 4; ++m)
#pragma unroll
            for (int n = 0; n < 4; ++n)
#pragma unroll
                for (int i = 0; i < 4; ++i) red[(F.wave * 64 + m * 16 + lk * 4 + i) * 64 + n * 16 + lr] = acc[m][n][i];
        __syncthreads();
        for (int e = F.tid; e < 64 * 64; e += 512) { const int row = e >> 6, col = e & 63; float sacc = 0.f;
#pragma unroll
            for (int w = 0; w < 8; ++w) sacc += red[(w * 64 + row) * 64 + col];
            partp[(size_t)(rb * 64 + row) * 512 + kind * 256 + cb * 64 + col] = sacc; }
    }
    __syncthreads();
}

__device__ __forceinline__ float gelu_tanh(float x) { const float u = 0.7978845608028654f * (x + 0.044715f * x * x * x); return 0.5f * x * (1.0f + tanhf(u)); }
template <int SAMPLE> __device__ __forceinline__ void ph_cmp_finish(const Args& a, const Frame& F, size_t out_off) {
    constexpr int NB = SAMPLE ? NBS : NBP, NCH = SAMPLE ? 1024 : 128, NC = NCH - 1;
    const float* part = (const float*)(a.ws + (SAMPLE ? WS_PARTS : WS_PARTP)); float* kc = (float*)(a.ws + out_off);
    const float* peb = (const float*)(a.ws + WS_PEB);
    LAS float* gl = (LAS float*)F.lds + F.wave * 128;
    const int gw = F.vcu * 8 + F.wave, NGW = F.G * 8;
    for (int it = gw; it < 2 * NB * NKV * NC; it += NGW) {
        const int c = it % NC, q = it / NC, kvh = q % NKV, b = (q / NKV) % NB, kind = q / (NKV * NB);
        const size_t row = ((size_t)b * NKV + kvh) * NCH + c;
        const float* w2 = kind ? a.wcv2 : a.wck2;
#pragma unroll
        for (int j = 0; j < 2; ++j) { const int f = F.lane + 64 * j;
            const float h = part[row * 512 + kind * 256 + f] + part[(row + 1) * 512 + kind * 256 + 128 + f] + peb[kind * 128 + f];
            gl[f] = gelu_tanh(h); }
        asm volatile("s_waitcnt lgkmcnt(0)" ::: "memory");
        float o0 = 0.f, o1 = 0.f;
        for (int f = 0; f < 128; ++f) { const float gv = gl[f]; o0 += gv * w2[f * 128 + F.lane]; o1 += gv * w2[f * 128 + 64 + F.lane]; }
        float* dst = kc + ((((size_t)kind * NB + b) * NKV + kvh) * NCH + c) * HD;
        dst[F.lane] = o0; dst[64 + F.lane] = o1;
        asm volatile("s_waitcnt lgkmcnt(0)" ::: "memory");
    }
}

struct WaveAtt { LAS float* qs; LAS float* pb; float o[4][2]; float m[4]; float l[4]; };
__device__ __forceinline__ void att_load_q(const bf16* P, int r, int kvh, WaveAtt& W, int lane) {
#pragma unroll
    for (int j = 0; j < 4; ++j) { const unsigned w = *(const unsigned*)PX(P, r, PC_Q + kvh * 512 + (lane + 64 * j) * 2);   W.qs[(lane + 64 * j) * 2] = lo_bf(w); W.qs[(lane + 64 * j) * 2 + 1] = hi_bf(w); }
    asm volatile("s_waitcnt lgkmcnt(0)" ::: "memory");
}
__device__ __forceinline__ void att_init(WaveAtt& W) {
#pragma unroll
    for (int g = 0; g < 4; ++g) { W.o[g][0] = 0.f; W.o[g][1] = 0.f; W.m[g] = -1e30f; W.l[g] = 0.f; }
}
template <class T> __device__ __forceinline__ void att_dot4(const T* krow, const WaveAtt& W, float (&s)[4]) {
    s[0] = s[1] = s[2] = s[3] = 0.f;
#pragma unroll 8
    for (int d = 0; d < 128; d += 8) {
        float kv[8];
        if constexpr (sizeof(T) == 4) { const f32x4 a0 = *(const f32x4*)((const float*)krow + d), a1 = *(const f32x4*)((const float*)krow + d + 4);
            kv[0] = a0[0]; kv[1] = a0[1]; kv[2] = a0[2]; kv[3] = a0[3]; kv[4] = a1[0]; kv[5] = a1[1]; kv[6] = a1[2]; kv[7] = a1[3]; }
        else { const u32x4 a0 = *(const u32x4*)((const bf16*)krow + d);
#pragma unroll
            for (int e = 0; e < 4; ++e) { kv[2 * e] = lo_bf(a0[e]); kv[2 * e + 1] = hi_bf(a0[e]); } }
#pragma unroll
        for (int g = 0; g < 4; ++g) { const f32x4 q0 = *(const LAS f32x4*)(W.qs + g * 128 + d), q1 = *(const LAS f32x4*)(W.qs + g * 128 + d + 4);
            s[g] += (kv[0] * q0[0] + kv[1] * q0[1]) + (kv[2] * q0[2] + kv[3] * q0[3]) + (kv[4] * q1[0] + kv[5] * q1[1]) + (kv[6] * q1[2] + kv[7] * q1[3]); }
    }
}
#ifndef PVB
#define PVB 16
#endif
#ifndef PVS
#define PVS 32
#endif
template <class T, int NB> __device__ __forceinline__ void att_pv_load(const T* V, size_t vstride, int jb, int lane, const T* Valt, int nalt, float (&v0)[NB], float (&v1)[NB]) {
    const T* vb = V + (size_t)(jb * NB) * vstride;
#pragma unroll
    for (int u = 0; u < NB; ++u) { const T* vr = (jb == 0 && u < nalt) ? Valt + (size_t)u * vstride : vb + (size_t)u * vstride;
        if constexpr (sizeof(T) == 4) { const f32x2 v = *(const f32x2*)((const float*)vr + 2 * lane); v0[u] = v[0]; v1[u] = v[1]; }
        else { const unsigned w = *(const unsigned*)((const bf16*)vr + 2 * lane); v0[u] = lo_bf(w); v1[u] = hi_bf(w); } }
}
template <int NB> __device__ __forceinline__ void att_pv_fma(int jb, int nk, const float (&v0)[NB], const float (&v1)[NB], WaveAtt& W) {
#pragma unroll
    for (int u = 0; u < NB; ++u) { f32x4 p = *(const LAS f32x4*)(W.pb + (jb * NB + u) * 4); if (jb * NB + u >= nk) p = (f32x4){0.f, 0.f, 0.f, 0.f};
#pragma unroll
        for (int g = 0; g < 4; ++g) { W.o[g][0] += p[g] * v0[u]; W.o[g][1] += p[g] * v1[u]; }
        if ((u & 7) == 7) __builtin_amdgcn_sched_barrier(0); }
}
template <class T> __device__ __forceinline__ void att_pv(const T* V, size_t vstride, int nk, WaveAtt& W, int lane, const T* Valt = nullptr, int nalt = 0) {
    const int nkb = (nk + PVB - 1) / PVB;
#pragma unroll 1
    for (int jb = 0; jb < nkb; ++jb) { float v0[PVB], v1[PVB]; att_pv_load<T, PVB>(V, vstride, jb, lane, Valt, nalt, v0, v1); att_pv_fma<PVB>(jb, nk, v0, v1, W); }
}
template <class T, int PVS_ = PVB> __device__ __forceinline__ void att_segment(const T* K, size_t kstride, const T* V, size_t vstride, int nk, bool valid, WaveAtt& W, int lane, const T* Kalt = nullptr, const T* Valt = nullptr, int nalt = 0) {
    float s[4]; float v0[PVS_], v1[PVS_];
    att_pv_load<T, PVS_>(V, vstride, 0, lane, Valt, nalt, v0, v1);
    if (valid) att_dot4<T>((lane < nalt ? Kalt : K) + (size_t)lane * kstride, W, s); else { s[0] = s[1] = s[2] = s[3] = 0.f; }
    f32x4 p;
#pragma unroll
    for (int g = 0; g < 4; ++g) { const float sv = valid ? s[g] * SCALE : -__builtin_inff();
        const float mx = wave_max(sv), mn = fmaxf(W.m[g], mx), alpha = __expf(W.m[g] - mn), pv = __expf(sv - mn);
        W.l[g] = W.l[g] * alpha + wave_sum(pv); W.o[g][0] *= alpha; W.o[g][1] *= alpha; W.m[g] = mn; p[g] = pv; }
    *(LAS f32x4*)(W.pb + lane * 4) = p;
    asm volatile("s_waitcnt lgkmcnt(0)" ::: "memory");
    att_pv_fma<PVS_>(0, nk, v0, v1, W);
    const int nkb = (nk + PVS_ - 1) / PVS_;
#pragma unroll 1
    for (int jb = 1; jb < nkb; ++jb) { att_pv_load<T, PVS_>(V, vstride, jb, lane, Valt, nalt, v0, v1); att_pv_fma<PVS_>(jb, nk, v0, v1, W); }
    asm volatile("s_waitcnt lgkmcnt(0)" ::: "memory");
}
__device__ __forceinline__ void att_store(float* O, int r, int kvh, const WaveAtt& W, int lane, bool normalise) {
#pragma unroll
    for (int g = 0; g < 4; ++g) { const float inv = normalise ? (W.l[g] > 0.f ? 1.0f / W.l[g] : 0.f) : 1.0f;
        *(f32x2*)(O + (size_t)r * D + (kvh * 4 + g) * 128 + 2 * lane) = (f32x2){W.o[g][0] * inv, W.o[g][1] * inv}; }
}

template <int SAMPLE> __device__ __forceinline__ void ph_cmp_attend(const Args& a, const Frame& F, size_t oc_off = WS_OCMP, size_t sel_off = (SAMPLE ? WS_SELS : WS_SELP)) {
    constexpr int NSEG = SAMPLE ? 16 : 2, NCH = SAMPLE ? 1024 : 128, NC = NCH - 1, NB = SAMPLE ? NBS : NBP, SQ = SAMPLE ? DSQ : SEQ;
    const bf16* P = (const bf16*)(a.ws + WS_P); const float* kcb = (const float*)(a.ws + (SAMPLE ? WS_KCS : WS_KCP));
    float* OC = (float*)(a.ws + oc_off);
    LAS float* wl = (LAS float*)F.lds + F.wave * 4096;
    WaveAtt W; W.qs = wl; W.pb = wl + 512; LAS float* pg = wl + 768 + 4; LAS float* scl = wl + 768 + 1040;
    const int gw = F.vcu * 8 + F.wave, NGW = F.G * 8, lane = F.lane;
#pragma unroll 1
    for (int it = gw; it < NB * NKV * SQ; it += NGW) {
        const int s = it % SQ, kvh = (it / SQ) % NKV, b = it / (SQ * NKV);
        const int r = SAMPLE ? MP + b * DSQ + s : b * SEQ + s, pos = SAMPLE ? PAST + s : s;
        const int nvis = pos >= 31 ? ((pos - 31) / 16 + 1 < NC ? (pos - 31) / 16 + 1 : NC) : 0;
        att_load_q(P, r, kvh, W, lane);
        const float* Kc = kcb + (((size_t)0 * NB + b) * NKV + kvh) * NCH * HD; const float* Vc = kcb + (((size_t)1 * NB + b) * NKV + kvh) * NCH * HD;
        float mx[4] = {-1e30f, -1e30f, -1e30f, -1e30f}, ls[4] = {0.f, 0.f, 0.f, 0.f};
        const int nseg = (nvis + 63) >> 6;
#pragma unroll 1
        for (int sg = 0; sg < nseg; ++sg) { const int c = sg * 64 + lane; const bool valid = c < nvis; float t[4];
            if (valid) att_dot4<float>(Kc + (size_t)c * HD, W, t); else { t[0] = t[1] = t[2] = t[3] = 0.f; }
#pragma unroll
            for (int g = 0; g < 4; ++g) { const float sv = valid ? t[g] * SCALE : -__builtin_inff(); const float m2 = fmaxf(mx[g], wave_max(sv));
                ls[g] = ls[g] * __expf(mx[g] - m2) + wave_sum(__expf(sv - m2)); mx[g] = m2; } }
#pragma unroll
        for (int g = 0; g < 4; ++g) ls[g] = ls[g] > 0.f ? 1.0f / ls[g] : 0.f;
        att_init(W);
        for (int i = lane; i < NSEG * 64; i += 64) pg[i] = 0.f;
#pragma unroll 1
        for (int sg = 0; sg < nseg; ++sg) { const int c = sg * 64 + lane; const bool valid = c < nvis; float t[4];
            if (valid) att_dot4<float>(Kc + (size_t)c * HD, W, t); else { t[0] = t[1] = t[2] = t[3] = 0.f; }
            f32x4 p; float pgs = 0.f;
#pragma unroll
            for (int g = 0; g < 4; ++g) { p[g] = valid ? __expf(t[g] * SCALE - mx[g]) * ls[g] : 0.f; pgs += p[g]; }
            pg[c] = pgs;
            const int base = sg * 64; int nk = nvis - base; nk = nk > 64 ? 64 : nk;
            *(LAS f32x4*)(W.pb + lane * 4) = p; asm volatile("s_waitcnt lgkmcnt(0)" ::: "memory");
            att_pv<float>(Vc + (size_t)base * HD, HD, nk, W, lane); asm volatile("s_waitcnt lgkmcnt(0)" ::: "memory"); }
        att_store(OC, r, kvh, W, lane, false);
        if (lane == 0) { pg[-1] = 0.f; pg[NSEG * 64] = 0.f; }
        asm volatile("s_waitcnt lgkmcnt(0)" ::: "memory");
        const int cur = pos >> 6;
        if constexpr (!SAMPLE) {
            float val = -__builtin_inff();
            if (lane < NSP) { const int n = lane; const float scv = pg[4 * n - 1] + 2.0f * (pg[4 * n] + pg[4 * n + 1] + pg[4 * n + 2]) + pg[4 * n + 3];
                const bool vld = n <= cur, forced = (n == 0) || (n > cur - 2); val = vld ? (forced ? __builtin_inff() : scv) : -__builtin_inff(); }
            int rank = 0;
            for (int k = 0; k < NSP; ++k) { const float vk = __shfl(val, k); rank += (vk > val || (vk == val && k < lane)) ? 1 : 0; }
            const bool sel = lane < NSP && rank < 16 && val > -__builtin_inff();
            const unsigned long long bm = __ballot(sel);
            if (lane == 0) ((unsigned*)(a.ws + sel_off))[((size_t)b * NKV + kvh) * SEQ + s] = (unsigned)bm;
        } else {
            for (int n = lane; n < 256; n += 64) scl[n] = (n >= 1 && n <= 254) ? pg[4 * n - 1] + 2.0f * (pg[4 * n] + pg[4 * n + 1] + pg[4 * n + 2]) + pg[4 * n + 3] : -__builtin_inff();
            asm volatile("s_waitcnt lgkmcnt(0)" ::: "memory");
            unsigned* selw = (unsigned*)(a.ws + sel_off) + (((size_t)b * NKV + kvh) * DSQ + s) * 16;
#pragma unroll
            for (int i = 0; i < 4; ++i) { const int n = lane + 64 * i; const float val = scl[n]; int rank = 0;
#pragma unroll 2
                for (int k = 1; k <= 254; ++k) { const float vk = scl[k]; rank += (vk > val || (vk == val && k < n)) ? 1 : 0; }
                const bool sel = (n >= 1 && n <= 254 && rank < 13) || n == 0 || n == 255;
                const unsigned long long bm = __ballot(sel);
                if (lane == 0) { selw[2 * i] = (unsigned)bm; selw[2 * i + 1] = (unsigned)(bm >> 32); } }
            if (lane == 0) selw[8] = 1u;
        }
        asm volatile("s_waitcnt lgkmcnt(0)" ::: "memory");
    }
}
template <int SAMPLE> __device__ __forceinline__ void ph_slc_attend(const Args& a, const Frame& F, size_t out_off = WS_OSLC) {
    constexpr int NB = SAMPLE ? NBS : NBP, SQ = SAMPLE ? DSQ : SEQ;
    const bf16* P = (const bf16*)(a.ws + WS_P); const bf16* KV6 = (const bf16*)(a.ws + WS_KV6); float* OS = (float*)(a.ws + out_off);
    LAS float* wl = (LAS float*)F.lds + F.wave * 1024; WaveAtt W; W.qs = wl; W.pb = wl + 512;
    const int gw = F.vcu * 8 + F.wave, NGW = F.G * 8, lane = F.lane;
#pragma unroll 1
    for (int it = gw; it < NB * NKV * SQ; it += NGW) {
        const int s = it % SQ, kvh = (it / SQ) % NKV, b = it / (SQ * NKV);
        const int r = SAMPLE ? MP + b * DSQ + s : b * SEQ + s;
        att_load_q(P, r, kvh, W, lane); att_init(W);
        if constexpr (!SAMPLE) {
            const unsigned mask = ((const unsigned*)(a.ws + WS_SELP))[((size_t)b * NKV + kvh) * SEQ + s];
            const bf16* Kb = KV6 + (((size_t)2 * NBP + b) * NKV + kvh) * SEQ * HD; const bf16* Vb = KV6 + (((size_t)3 * NBP + b) * NKV + kvh) * SEQ * HD;
#pragma unroll 1
            for (int n = 0; n < NSP; ++n) if ((mask >> n) & 1u) { const int k0 = n * 64; int nk = s - k0 + 1; nk = nk > 64 ? 64 : nk; if (nk <= 0) continue;
                att_segment<bf16>(Kb + (size_t)k0 * HD, HD, Vb + (size_t)k0 * HD, HD, nk, lane < nk, W, lane); }
        } else {
            const unsigned* selw = (const unsigned*)(a.ws + WS_SELS) + (((size_t)b * NKV + kvh) * DSQ + s) * 16;
#pragma unroll 1
            for (int n = 0; n < 256; ++n) if ((selw[n >> 5] >> (n & 31)) & 1u) {
                const int page = a.ptab[b * NPAGES + (n >> 1)];
                const float* base = a.cache + ((size_t)page * PAGE + (n & 1) * 64) * 2048 + kvh * HD;
                att_segment<float>(base + 2 * 512, 2048, base + 3 * 512, 2048, 64, true, W, lane); }
            att_segment<bf16>(PX(P, MP + b * DSQ, PC_KV + 2 * 512 + kvh * HD), PRS, PX(P, MP + b * DSQ, PC_KV + 3 * 512 + kvh * HD), PRS, s + 1, lane <= s, W, lane);
        }
        att_store(OS, r, kvh, W, lane, true);
    }
}
template <int SAMPLE> __device__ __forceinline__ void ph_win_attend(const Args& a, const Frame& F, size_t out_off = WS_OWIN) {
    constexpr int NB = SAMPLE ? NBS : NBP, SQ = SAMPLE ? DSQ : SEQ;
    const bf16* P = (const bf16*)(a.ws + WS_P); const bf16* KV6 = (const bf16*)(a.ws + WS_KV6); float* OW = (float*)(a.ws + out_off);
    LAS float* wl = (LAS float*)F.lds + F.wave * 1024; WaveAtt W; W.qs = wl; W.pb = wl + 512;
    const int gw = F.vcu * 8 + F.wave, NGW = F.G * 8, lane = F.lane;
#pragma unroll 1
    for (int it = gw; it < NB * NKV * SQ; it += NGW) {
        const int s = it % SQ, kvh = (it / SQ) % NKV, b = it / (SQ * NKV);
        const int r = SAMPLE ? MP + b * DSQ + s : b * SEQ + s;
        att_load_q(P, r, kvh, W, lane); att_init(W);
        if constexpr (!SAMPLE) {
            const bf16* Kb = KV6 + (((size_t)4 * NBP + b) * NKV + kvh) * SEQ * HD; const bf16* Vb = KV6 + (((size_t)5 * NBP + b) * NKV + kvh) * SEQ * HD;
            const int lo = s - 511 > 0 ? s - 511 : 0;
#pragma unroll 1
            for (int k0 = (lo >> 6) << 6; k0 <= s; k0 += 64) { int nk = s - k0 + 1; nk = nk > 64 ? 64 : nk; const int kp = k0 + lane;
                att_segment<bf16>(Kb + (size_t)k0 * HD, HD, Vb + (size_t)k0 * HD, HD, nk, kp >= lo && kp <= s, W, lane); }
        } else {
            const float* st = a.st_win + (size_t)b * 512 * 1024 + kvh * HD;
#pragma unroll 1
            for (int i0 = 0; i0 < 512; i0 += 64) { const int i = i0 + lane;
                att_segment<float>(st + (size_t)i0 * 1024, 1024, st + (size_t)i0 * 1024 + 512, 1024, 64, i > s, W, lane); }
            att_segment<bf16>(PX(P, MP + b * DSQ, PC_KWIN + kvh * HD), PRS, PX(P, MP + b * DSQ, PC_VWIN + kvh * HD), PRS, s + 1, lane <= s, W, lane);
        }
        att_store(OW, r, kvh, W, lane, true);
    }
    if constexpr (SAMPLE) {
        float* ow = a.out + OUT_WINS;
        for (size_t i = (size_t)(F.vcu * 512 + F.tid); i < (size_t)NBS * 504 * 256; i += (size_t)F.G * 512) { const size_t b = i / (504 * 256), rem = i % (504 * 256);
            *(f32x4*)(ow + b * 512 * 1024 + rem * 4) = *(const f32x4*)(a.st_win + b * 512 * 1024 + 8 * 1024 + rem * 4); }
    }
}


namespace fa {
constexpr int NW = 8, QBLK = 32, KVBLK = 64, QB = NW * QBLK, DH = 128;
constexpr int SHM_V = KVBLK * DH * 2, SHM_K = KVBLK * DH * 2;
constexpr int FA_LDS_BYTES = 2 * SHM_V + 2 * SHM_K + NW * 64 * 4;
constexpr int FA_STG_OFF = 2 * SHM_V + 2 * SHM_K, FA_WS_OFF = 131072 + 4096, OSA = 2 * D;
constexpr float THR = 8.f;
constexpr int QS = PRS;
constexpr int OS = D;
typedef float f32x16 __attribute__((ext_vector_type(16)));
typedef short s16x4 __attribute__((ext_vector_type(4)));
#define KSWZ(row, colB) ((row) * 256 + ((colB) ^ (((row) & 7) << 4)))
#define SBAR() __builtin_amdgcn_sched_barrier(0)
__device__ __forceinline__ int v_st(int k, int c) { const int kk = (k & ~0xC) | ((k & 4) << 1) | ((k & 8) >> 1); return ((kk >> 3) * 4 + (c >> 5)) * 512 + ((kk & 7) * 32 + (c & 31)) * 2; }
__device__ __forceinline__ int v_rd_base(int lane) { return ((lane & 3) << 3) | (((lane >> 2) & 3) << 6) | (((lane >> 4) & 1) << 5) | (((lane >> 5) & 1) << 8); }
constexpr int v_rd_off(int d0, int ks, int half) { return d0 * 512 + ks * 4096 + half * 2048; }
__device__ __forceinline__ int crow(int r, int hi) { return (r & 3) + 8 * (r >> 2) + 4 * hi; }
__device__ __forceinline__ unsigned cvtpk(float lo, float hi) { unsigned r; asm volatile("v_cvt_pk_bf16_f32 %0, %1, %2" : "=v"(r) : "v"(lo), "v"(hi)); return r; }
__device__ __forceinline__ bf16x8 load8(const bf16* p) { return *reinterpret_cast<const bf16x8*>(p); }
__device__ __forceinline__ void mask_tile(f32x16& p0, f32x16& p1, int dq, unsigned W) {
    const float NEG = -__builtin_inff();
#pragma unroll
    for (int r = 0; r < 16; ++r) {
        const int c = (r & 3) + 8 * (r >> 2);
        if ((unsigned)(dq - c) >= W) p0[r] = NEG;
        if ((unsigned)(dq - c - 32) >= W) p1[r] = NEG;
    }
}
__device__ __forceinline__ void partialSM(f32x16& p0, f32x16& p1, float& m_reg, float& mn, float& alpha) {
    float pmax = p0[0]; for (int r = 1; r < 16; ++r) pmax = fmaxf(pmax, p0[r]); for (int r = 0; r < 16; ++r) pmax = fmaxf(pmax, p1[r]);
    { auto rr = __builtin_amdgcn_permlane32_swap(__float_as_uint(pmax), __float_as_uint(pmax), false, false);
      pmax = fmaxf(__uint_as_float(rr[0]), __uint_as_float(rr[1])); }
    constexpr float C2 = 1.4426950408889634f * SCALE;
    if (__builtin_expect(__all((pmax - m_reg) * SCALE <= THR), 1)) { mn = m_reg; alpha = 1.f; }
    else { mn = fmaxf(m_reg, pmax); alpha = __builtin_amdgcn_exp2f((m_reg - mn) * C2); m_reg = mn; }
    const float mnL = -mn * C2;
    for (int r = 0; r < 16; ++r) p0[r] = fmaf(p0[r], C2, mnL); for (int r = 0; r < 16; ++r) p1[r] = fmaf(p1[r], C2, mnL);
    for (int r = 0; r < 16; ++r) p0[r] = __builtin_amdgcn_exp2f(p0[r]);
}
__device__ __forceinline__ void finishSM(f32x16& p0, f32x16& p1, float alpha, float& l_reg, bf16x8& pa0, bf16x8& pa1, bf16x8& pa2, bf16x8& pa3) {
    for (int r = 0; r < 16; ++r) p1[r] = __builtin_amdgcn_exp2f(p1[r]);
    float ps = 0; for (int r = 0; r < 16; ++r) ps += p0[r]; for (int r = 0; r < 16; ++r) ps += p1[r];
    { auto rr = __builtin_amdgcn_permlane32_swap(__float_as_uint(ps), __float_as_uint(ps), false, false);
      ps = __uint_as_float(rr[0]) + __uint_as_float(rr[1]); }
    l_reg = l_reg * alpha + ps;
#define PK4(P, B_, OUT) do { unsigned a0 = cvtpk(P[B_+0], P[B_+1]), a1 = cvtpk(P[B_+2], P[B_+3]);                          \
        unsigned b0 = cvtpk(P[B_+4], P[B_+5]), b1 = cvtpk(P[B_+6], P[B_+7]);                                             \
        auto r0 = __builtin_amdgcn_permlane32_swap(a0, b0, false, false); auto r1 = __builtin_amdgcn_permlane32_swap(a1, b1, false, false); \
        u32x4 w = {r0[0], r1[0], r0[1], r1[1]}; OUT = *reinterpret_cast<bf16x8*>(&w); } while (0)
    PK4(p0, 0, pa0); PK4(p0, 8, pa1); PK4(p1, 0, pa2); PK4(p1, 8, pa3);
#undef PK4
}
template <int KB>
__device__ __forceinline__ void qkt(f32x16& p0, f32x16& p1, const char* K_lds, int r32, int hi, const bf16x8* qr) {
    p0 = f32x16{}; p1 = f32x16{};
    const char* kb[4];
#pragma unroll
    for (int dd = 0; dd < 4; ++dd) kb[dd] = K_lds + KB * SHM_K + KSWZ(r32, (dd * 16 + hi * 8) * 2);
#pragma unroll
    for (int d0 = 0; d0 < 8; ++d0) { const char* a = kb[d0 & 3] + (d0 >> 2) * 128;
        bf16x8 b0 = *reinterpret_cast<const bf16x8*>(a);
        bf16x8 b1 = *reinterpret_cast<const bf16x8*>(a + 32 * 256);
        p0 = __builtin_amdgcn_mfma_f32_32x32x16_bf16(b0, qr[d0], p0, 0, 0, 0);
        p1 = __builtin_amdgcn_mfma_f32_32x32x16_bf16(b1, qr[d0], p1, 0, 0, 0); }
}
template <int VB>
__device__ __forceinline__ void pv_tile(f32x16* o, int vb0, bf16x8 pa0, bf16x8 pa1, bf16x8 pa2, bf16x8 pa3) {
#define TRRD(dst, off) asm volatile("ds_read_b64_tr_b16 %0, %1 offset:%2" : "=&v"(dst) : "v"(vb0), "i"(off) : "memory")
#define PV_D0(d0) do { s16x4 l0, l1, l2, l3, h0, h1, h2, h3; constexpr int b_ = VB * SHM_V + v_rd_off(d0, 0, 0); \
        TRRD(l0, b_); TRRD(h0, b_ + 2048); TRRD(l1, b_ + 4096); TRRD(h1, b_ + 6144); TRRD(l2, b_ + 8192); TRRD(h2, b_ + 10240); TRRD(l3, b_ + 12288); TRRD(h3, b_ + 14336); \
        asm volatile("s_waitcnt lgkmcnt(0)" ::: "memory"); SBAR();   \
        o[d0] = __builtin_amdgcn_mfma_f32_32x32x16_bf16(pa0, (bf16x8){l0[0], l0[1], l0[2], l0[3], h0[0], h0[1], h0[2], h0[3]}, o[d0], 0, 0, 0);   \
        o[d0] = __builtin_amdgcn_mfma_f32_32x32x16_bf16(pa1, (bf16x8){l1[0], l1[1], l1[2], l1[3], h1[0], h1[1], h1[2], h1[3]}, o[d0], 0, 0, 0);   \
        o[d0] = __builtin_amdgcn_mfma_f32_32x32x16_bf16(pa2, (bf16x8){l2[0], l2[1], l2[2], l2[3], h2[0], h2[1], h2[2], h2[3]}, o[d0], 0, 0, 0);   \
        o[d0] = __builtin_amdgcn_mfma_f32_32x32x16_bf16(pa3, (bf16x8){l3[0], l3[1], l3[2], l3[3], h3[0], h3[1], h3[2], h3[3]}, o[d0], 0, 0, 0); } while (0)
    PV_D0(0); PV_D0(1); PV_D0(2); PV_D0(3);
#undef PV_D0
#undef TRRD
}
struct BlockRef { const bf16* Q; const bf16* K; const bf16* V; float* O; const unsigned* sel; const bf16* gate; const bf16* C; int P0, W; };
struct Seam { bf16x8 qr[8]; bf16x8 st_v0, st_v1, st_k0, st_k1; };
__device__ __forceinline__ int swa_jlo(int P0, int W) { const int lowk = P0 - W + 1; return lowk > 0 ? lowk / KVBLK : 0; }
#define ROW(p, k0, rr) ((p) + (size_t)((k0) + (rr)) * DH + sc)
#define VMW() asm volatile("s_waitcnt vmcnt(0)" ::: "memory")
#define VMWN(n) asm volatile("s_waitcnt vmcnt(%0)" :: "i"(n) : "memory")
#define SLOAD_H(Kp, Vp, k0) do { S.st_v0 = load8(ROW(Vp, k0, sr)); S.st_v1 = load8(ROW(Vp, k0, 32 + sr));              \
                         S.st_k0 = load8(ROW(Kp, k0, sr)); S.st_k1 = load8(ROW(Kp, k0, 32 + sr)); } while (0)
#define SWRITE_HK(bf) do { *(bf16x8*)(K_lds + (bf) * SHM_K + kws) = S.st_k0; *(bf16x8*)(K_lds + (bf) * SHM_K + kws + 32 * 256) = S.st_k1; } while (0)
#define SWRITE_HV(bf) do { *(bf16x8*)(V_lds + (bf) * SHM_V + vst0) = S.st_v0; *(bf16x8*)(V_lds + (bf) * SHM_V + vst1) = S.st_v1; } while (0)
#define SWRITE_H(bf) do { SWRITE_HV(bf); SWRITE_HK(bf); } while (0)
__device__ __forceinline__ void prime(const BlockRef& cur, char* lds, Seam& S) {
    const int tid = threadIdx.x, wid = __builtin_amdgcn_readfirstlane(tid >> 6), lane = tid & 63, r32 = lane & 31, hi = lane >> 5;
    const int sr = tid >> 4, sc = (tid & 15) * 8, kws = KSWZ(sr, sc * 2); char* K_lds = lds + 2 * SHM_V;
    const int kb0 = swa_jlo(cur.P0, cur.W) * KVBLK;
    for (int d0 = 0; d0 < 8; ++d0) S.qr[d0] = load8(cur.Q + (size_t)(wid * QBLK + r32) * QS + d0 * 16 + hi * 8);
    SLOAD_H(cur.K, cur.V, kb0); VMW(); SWRITE_HK(0);
    __syncthreads();
}
__device__ __forceinline__ void block(const BlockRef& cur, const BlockRef& nxt, int skv, char* lds, Seam& S) {
    int tid_ = threadIdx.x; asm volatile("" : "+v"(tid_));
    const int tid = tid_, wid = __builtin_amdgcn_readfirstlane(tid >> 6), lane = tid & 63, r32 = lane & 31, hi = lane >> 5;
    const int W = cur.W;
    const int j_lo = swa_jlo(cur.P0, W);
    int j_hi = (cur.P0 + QB - 1) / KVBLK + 1; if (j_hi > skv / KVBLK) j_hi = skv / KVBLK;
    const int NT = j_hi - j_lo;
    const int kbn = swa_jlo(nxt.P0, nxt.W) * KVBLK;
    const int qlo = cur.P0 + wid * QBLK, qm = qlo + r32 - 4 * hi;
    char* V_lds = lds; char* K_lds = lds + 2 * SHM_V;
    float* ws = (float*)(lds + FA_WS_OFF) + wid * 64; float* li_l = ws, * al_l = ws + 32;
    float m_reg = -1e30f, l_reg = 0; f32x16 o[4] = {};
    const int sr = tid >> 4, sc = (tid & 15) * 8, vst0 = v_st(sr, sc), vst1 = v_st(32 + sr, sc), kws = KSWZ(sr, sc * 2);
    const int vb0 = (int)(uintptr_t)V_lds + v_rd_base(lane);
    const bf16* Kh = cur.K; const bf16* Vh = cur.V;
    const bool hasSel = cur.sel != nullptr;
    const unsigned selmask = hasSel ? cur.sel[qlo + r32] : 0xffffffffu;
#define RESC(a) do { if (__any((a) < 1.f)) { if (hi == 0) al_l[r32] = (a); asm volatile("s_waitcnt lgkmcnt(0)" ::: "memory");              \
                     for (int d_ = 0; d_ < 4; ++d_) for (int r = 0; r < 16; ++r) o[d_][r] *= al_l[crow(r, hi)]; } } while (0)
#define KBASE(t) ((j_lo + (t)) * KVBLK)
#define MASKT(P0_, P1_, t) do { const int kb_ = KBASE(t); if (kb_ + KVBLK - 1 > qlo || kb_ <= qlo + QBLK - 1 - W) mask_tile(P0_, P1_, qm - kb_, (unsigned)W); \
        if (hasSel) { const bool off_ = ((selmask >> (j_lo + (t))) & 1u) == 0u; const float NEG_ = -__builtin_inff(); \
            _Pragma("unroll") for (int r_ = 0; r_ < 16; ++r_) { P0_[r_] = off_ ? NEG_ : P0_[r_]; P1_[r_] = off_ ? NEG_ : P1_[r_]; } } } while (0)
    constexpr int NQL = 8;
#define SEAM_K0() do { VMWN(NQL); SWRITE_HK(0); SBAR(); } while (0)
    f32x16 pA0, pA1, pB0, pB1; float mnA, mnB, alA, alB; bf16x8 pa0, pa1, pa2, pa3;
    SWRITE_HV(0); SBAR();
    if (NT > 1) { SLOAD_H(Kh, Vh, KBASE(1)); }
#if GATED
    if (hasSel) { const bf16* Cw = cur.C + (size_t)(wid * QBLK) * OS + (r32 & ~1); const bool odd = r32 & 1;
#pragma unroll
        for (int r = 0; r < 16; ++r)
#pragma unroll
            for (int dp = 0; dp < 2; ++dp)
                __builtin_amdgcn_global_load_lds((const unsigned*)(Cw + (size_t)crow(r, hi) * OS + (odd ? dp + 2 : dp) * 32), (LAS unsigned*)((LAS char*)lds + FA_STG_OFF + (r * 2 + dp) * 2048 + wid * 256), 4, 0, 0); }
#endif
    SBAR(); qkt<0>(pA0, pA1, K_lds, r32, hi, S.qr);
    MASKT(pA0, pA1, 0); partialSM(pA0, pA1, m_reg, mnA, alA);
    if (NT > 1) { VMW(); SWRITE_H(1); }
    __syncthreads();
#define HALF_STEP(PX0, PX1, mnX, alX, PY0, PY1, alY, t, KB, VB, SB) do {                                                      \
        SBAR(); qkt<KB>(PX0, PX1, K_lds, r32, hi, S.qr);                                             \
        finishSM(PY0, PY1, alY, l_reg, pa0, pa1, pa2, pa3); SBAR();                                                           \
        if ((t) + 1 < NT) { SLOAD_H(Kh, Vh, KBASE((t) + 1)); SBAR(); }                                               \
        pv_tile<VB>(o, vb0, pa0, pa1, pa2, pa3); MASKT(PX0, PX1, (t)); partialSM(PX0, PX1, m_reg, mnX, alX);                                        \
        __syncthreads();                                                                                                      \
        if ((t) + 1 < NT) { VMW(); SWRITE_H(SB); }                                                                          \
        RESC(alX); __syncthreads(); } while (0)
    for (int t = 1; t + 1 < NT; t += 2) {
        HALF_STEP(pB0, pB1, mnB, alB, pA0, pA1, alA, t, 1, 0, 0);
        HALF_STEP(pA0, pA1, mnA, alA, pB0, pB1, alB, t + 1, 0, 1, 1);
    }
    const bool even = (NT & 1) == 0;
    if (even) { SBAR(); qkt<1>(pB0, pB1, K_lds, r32, hi, S.qr); SBAR(); }
    { SLOAD_H(nxt.K, nxt.V, kbn); SBAR();
#pragma unroll
        for (int d0 = 0; d0 < 8; ++d0) S.qr[d0] = load8(nxt.Q + (size_t)(wid * QBLK + r32) * QS + d0 * 16 + hi * 8); }
    SBAR();
    finishSM(pA0, pA1, alA, l_reg, pa0, pa1, pa2, pa3); SBAR();
    pv_tile<0>(o, vb0, pa0, pa1, pa2, pa3);
    if (even) { MASKT(pB0, pB1, NT - 1); partialSM(pB0, pB1, m_reg, mnB, alB); __syncthreads(); RESC(alB);
        finishSM(pB0, pB1, alB, l_reg, pa0, pa1, pa2, pa3); SBAR(); pv_tile<1>(o, vb0, pa0, pa1, pa2, pa3); }
    SBAR(); SEAM_K0();
    if (hi == 0) li_l[r32] = l_reg; asm volatile("s_waitcnt lgkmcnt(0)" ::: "memory");
    float rli[16];
#pragma unroll
    for (int r = 0; r < 16; ++r) rli[r] = __builtin_amdgcn_rcpf(li_l[crow(r, hi)]);
#if GATED
    bf16 graw[16];
#pragma unroll
    for (int r = 0; r < 16; ++r) graw[r] = cur.gate[(size_t)(wid * QBLK + crow(r, hi)) * QS];
    LAS unsigned* sl = (LAS unsigned*)((LAS char*)lds + FA_STG_OFF) + tid;
    if (hasSel) {
#pragma unroll
        for (int r = 0; r < 16; ++r) { const float sc_ = rli[r] * sigmoidf_(bf2f(graw[r]));
#pragma unroll
            for (int dp = 0; dp < 2; ++dp) { const float va = o[dp][r] * sc_, vb = o[dp + 2][r] * sc_, na = dpp_xor1(va), nb = dpp_xor1(vb);
                const bool odd = r32 & 1; const unsigned c = sl[(r * 2 + dp) * 512]; sl[(r * 2 + dp) * 512] = cvtpk(lo_bf(c) + (odd ? nb : va), hi_bf(c) + (odd ? vb : na)); } }
    } else {
        bf16* Ow = (bf16*)cur.O + (size_t)(wid * QBLK) * OSA;
#pragma unroll
        for (int r = 0; r < 16; ++r) { const int orow = crow(r, hi);
            const float sc_ = rli[r] * sigmoidf_(bf2f(graw[r]));
#pragma unroll
            for (int dp = 0; dp < 2; ++dp) { const float va = o[dp][r] * sc_, vb = o[dp + 2][r] * sc_, na = dpp_xor1(va), nb = dpp_xor1(vb);
                const bool odd = r32 & 1; const unsigned c = sl[(r * 2 + dp) * 512];
                *(unsigned*)(Ow + (size_t)orow * OSA + (odd ? dp + 2 : dp) * 32 + (r32 & ~1)) = cvtpk(lo_bf(c) + (odd ? nb : va), hi_bf(c) + (odd ? vb : na)); } }
    }
    asm volatile("s_waitcnt lgkmcnt(0)" ::: "memory");
#else
    float* Ow = cur.O + (size_t)(wid * QBLK) * OS;
#pragma unroll
    for (int r = 0; r < 16; ++r) { const int orow = crow(r, hi);
#pragma unroll
        for (int d0 = 0; d0 < 4; ++d0) Ow[(size_t)orow * OS + d0 * 32 + r32] = o[d0][r] * rli[r]; }
#endif
    __syncthreads();
#undef RESC
#undef KBASE
#undef MASKT
#undef SEAM_K0
#undef HALF_STEP
}
#undef ROW
#undef VMW
#undef VMWN
#undef SLOAD_H
#undef SWRITE_HK
#undef SWRITE_HV
#undef SWRITE_H
}


__device__ __forceinline__ float gelu_fast(float x) { const float u = 0.7978845608028654f * (x + 0.044715f * x * x * x); const float t = 1.0f - 2.0f / (1.0f + __expf(2.0f * u)); return 0.5f * x * (1.0f + t); }
template <int SAMPLE> __device__ __forceinline__ void ph_cmp_finish_mfma(const Args& a, const Frame& F, char* lds, int widx = -1, int wcnt = 0) {
    constexpr int NB = SAMPLE ? NBS : NBP, NCH = SAMPLE ? 1024 : 128, NC = NCH - 1, NBLK = (NC + 31) / 32, NG = NB * NKV;
    typedef float f32x16 __attribute__((ext_vector_type(16)));
    const float* part = (const float*)(a.ws + (SAMPLE ? WS_PARTS : WS_PARTP)); float* kc = (float*)(a.ws + (SAMPLE ? WS_KCS : WS_KCP));
    const float* peb = (const float*)(a.ws + WS_PEB);
    const int tid = F.tid, lane = F.lane, r32 = lane & 31, hi = lane >> 5;
    __syncthreads();
    for (int i = tid; i < 2 * 128 * 16; i += 512) { const int kind = i >> 11, n = i & 127, ch = (i >> 7) & 15; const float* w2 = (kind ? a.wcv2 : a.wck2) + (size_t)(ch * 8) * 128 + n;
        u32x4 wv = {pk2(w2[0], w2[128]), pk2(w2[256], w2[384]), pk2(w2[512], w2[640]), pk2(w2[768], w2[896])};
        *(u32x4*)(lds + kind * 32768 + n * 256 + ((ch ^ (n & 15)) << 4)) = wv; }
    __syncthreads();
    const int gw = (widx >= 0 ? widx : F.vcu) * 8 + F.wave, NGW = (widx >= 0 ? wcnt : F.G) * 8;
#pragma unroll 1
    for (int it = gw; it < 2 * NG * NBLK; it += NGW) {
        const int blk = it % NBLK, q = it / NBLK, g = q % NG, kind = q / NG, c0 = blk * 32;
        const int c = c0 + r32, cc = c < NC ? c : NC - 1;
        const float* p0 = part + ((size_t)g * NCH + cc) * 512 + kind * 256; const float* p1 = p0 + 512 + 128; const float* pb = peb + kind * 128;
        f32x16 acc[4] = {};
        const char* wl = lds + kind * 32768;
#pragma unroll
        for (int ks = 0; ks < 8; ++ks) { const int f = ks * 16 + hi * 8;
            const f32x4 a0 = *(const f32x4*)(p0 + f), a1 = *(const f32x4*)(p0 + f + 4), b0 = *(const f32x4*)(p1 + f), b1 = *(const f32x4*)(p1 + f + 4), e0 = *(const f32x4*)(pb + f), e1 = *(const f32x4*)(pb + f + 4);
            float gv[8];
#pragma unroll
            for (int e = 0; e < 4; ++e) { gv[e] = gelu_fast(a0[e] + b0[e] + e0[e]); gv[4 + e] = gelu_fast(a1[e] + b1[e] + e1[e]); }
            u32x4 aw = {fa::cvtpk(gv[0], gv[1]), fa::cvtpk(gv[2], gv[3]), fa::cvtpk(gv[4], gv[5]), fa::cvtpk(gv[6], gv[7])};
            const bf16x8 af = *reinterpret_cast<bf16x8*>(&aw);
#pragma unroll
            for (int nb = 0; nb < 4; ++nb) { const int n = nb * 32 + r32; const bf16x8 bfr = *reinterpret_cast<const bf16x8*>(wl + n * 256 + (((ks * 2 + hi) ^ (n & 15)) << 4));
                acc[nb] = __builtin_amdgcn_mfma_f32_32x32x16_bf16(af, bfr, acc[nb], 0, 0, 0); } }
        float* dst = kc + (((size_t)kind * NG + g) * NCH) * HD;
#pragma unroll
        for (int r = 0; r < 16; ++r) { const int row = c0 + fa::crow(r, hi); if (row < NC) {
#pragma unroll
            for (int nb = 0; nb < 4; ++nb) dst[(size_t)row * HD + nb * 32 + r32] = acc[nb][r]; } }
    }
}


template <int MODE = 0  > __device__ __forceinline__ void ph_compress_sample(const Args& a, const Frame& F, char* lds) {
    typedef float f32x16 __attribute__((ext_vector_type(16)));
    const int tid = F.tid, lane = F.lane, wid = F.wave, wm = wid >> 2, wn = wid & 3, r32 = lane & 31, hi = lane >> 5;
    char* As = lds; char* Bs = lds + 32768;
    const bf16* wct = (const bf16*)(a.ws + WS_WC_T); float* parts = (float*)(a.ws + (MODE ? WS_DBGA : WS_PARTS));
    const int acl = tid >> 4, aseg = tid & 15, brl = tid >> 3, bch = tid & 7;
#pragma unroll 1
    for (int unit = F.vcu; unit < 512; unit += F.G) {
        const int kind = unit >> 8, b = (unit >> 5) & 7, rt = unit & 31;
        const int c = rt * 32 + acl, page = a.ptab[b * NPAGES + (c >> 3)];
        const float* abase = a.cache + ((size_t)page * PAGE + (c & 7) * 16) * 2048 + kind * 512 + aseg * 4;
        const bf16* bbase = wct + (size_t)(kind * 256 + brl) * 2048 + bch * 8;
        f32x16 acc[2][2] = {};
        f32x4 ra[4][4] = {}; u32x4 rb[2][4] = {};
#define CS_LOADA(slot, kt) do { if (MODE == 2) break; const float* p_ = abase + (size_t)((kt) >> 1) * 2048 + ((kt) & 1) * 64; _Pragma("unroll") for (int j_ = 0; j_ < 4; ++j_) ra[slot][j_] = __builtin_nontemporal_load((const f32x4*)(p_ + j_ * HD)); } while (0)
#define CS_LOADB(bs, kt) do { if (MODE == 2) break; const bf16* p_ = bbase + (kt) * 64; _Pragma("unroll") for (int j_ = 0; j_ < 4; ++j_) rb[bs][j_] = *(const u32x4*)(p_ + (size_t)j_ * 64 * 2048); } while (0)
#define CS_WRITE(slot, bs, buf) do { \
        _Pragma("unroll") for (int j_ = 0; j_ < 4; ++j_) { const int row_ = j_ * 32 + acl; \
            *(u32x2*)(As + (buf) * 16384 + row_ * 128 + (((aseg >> 1) ^ (row_ & 7)) << 4) + (aseg & 1) * 8) = (u32x2){fa::cvtpk(ra[slot][j_][0], ra[slot][j_][1]), fa::cvtpk(ra[slot][j_][2], ra[slot][j_][3])}; } \
        _Pragma("unroll") for (int j_ = 0; j_ < 4; ++j_) { const int row_ = j_ * 64 + brl; *(u32x4*)(Bs + (buf) * 32768 + row_ * 128 + ((bch ^ (row_ & 7)) << 4)) = rb[bs][j_]; } } while (0)
#define CS_COMPUTE(buf) do { if (MODE == 1) break; _Pragma("unroll") for (int ks_ = 0; ks_ < 4; ++ks_) { bf16x8 af_[2], bf_[2]; \
        _Pragma("unroll") for (int t_ = 0; t_ < 2; ++t_) { const int ar_ = wm * 64 + t_ * 32 + r32, br_ = wn * 64 + t_ * 32 + r32; \
            af_[t_] = *(const bf16x8*)(As + (buf) * 16384 + ar_ * 128 + (((ks_ * 2 + hi) ^ (ar_ & 7)) << 4)); \
            bf_[t_] = *(const bf16x8*)(Bs + (buf) * 32768 + br_ * 128 + (((ks_ * 2 + hi) ^ (br_ & 7)) << 4)); } \
        _Pragma("unroll") for (int mt_ = 0; mt_ < 2; ++mt_) _Pragma("unroll") for (int nt_ = 0; nt_ < 2; ++nt_) acc[mt_][nt_] = __builtin_amdgcn_mfma_f32_32x32x16_bf16(af_[mt_], bf_[nt_], acc[mt_][nt_], 0, 0, 0); } } while (0)
        __syncthreads();
        CS_LOADA(0, 0); CS_LOADB(0, 0); CS_LOADB(1, 1); CS_LOADA(1, 1); CS_LOADA(2, 2); CS_LOADA(3, 3);
        CS_WRITE(0, 0, 0); CS_LOADB(0, 2);
        __syncthreads();
#define CS_STEP(kt, s1, s3) do { const int k3_ = (kt) + 3 < 32 ? (kt) + 3 : 31, k4_ = (kt) + 4 < 32 ? (kt) + 4 : 31;     \
        CS_LOADA(s3, k4_); CS_COMPUTE((kt) & 1); CS_WRITE(s1, ((kt) + 1) & 1, ((kt) + 1) & 1); CS_LOADB(((kt) + 1) & 1, k3_); __syncthreads(); } while (0)
#pragma unroll 1
        for (int kt = 0; kt < 32; kt += 4) { CS_STEP(kt, 1, 0); CS_STEP(kt + 1, 2, 1); CS_STEP(kt + 2, 3, 2); CS_STEP(kt + 3, 0, 3); }
#undef CS_STEP
#undef CS_COMPUTE
#undef CS_WRITE
#undef CS_LOADB
#undef CS_LOADA
#pragma unroll
        for (int mt = 0; mt < 2; ++mt)
#pragma unroll
            for (int r = 0; r < 16; ++r) {
                float* dr = parts + ((size_t)(b * NKV + wm * 2 + mt) * 1024 + rt * 32 + fa::crow(r, hi)) * 512 + kind * 256 + wn * 64 + r32;
#pragma unroll
                for (int nt = 0; nt < 2; ++nt) dr[nt * 32] = acc[mt][nt][r]; }
    }
    __syncthreads();
}

__device__ __forceinline__ void ph_cmp_prompt(const Args& a, const Frame& F, char* lds) {
    using namespace fa;
    const int tid = F.tid, wid = F.wave, lane = F.lane, r32 = lane & 31, hi = lane >> 5;
    char* V_lds = lds; char* K_lds = lds + 2 * SHM_V; float* pgw = (float*)(lds + 2 * SHM_V + 2 * SHM_K) + wid * 1024;
    const int sr = tid >> 4, sc = (tid & 15) * 8;
    const int vb0 = (int)(uintptr_t)V_lds + v_rd_base(lane);
    const bf16* P = (const bf16*)(a.ws + WS_P); const float* kcp = (const float*)(a.ws + WS_KCP); float* OC = (float*)(a.ws + WS_OCMP);
    unsigned* selp = (unsigned*)(a.ws + WS_SELP);
    constexpr float C2 = 1.4426950408889634f * SCALE;
    for (int w = F.vcu; w < 256; w += F.G) {
        const int bk = w >> 4, b = bk >> 2, kvh = bk & 3;
        const float* Kc = kcp + (((size_t)0 * NBP + b) * NKV + kvh) * 128 * HD; const float* Vc = kcp + (((size_t)1 * NBP + b) * NKV + kvh) * 128 * HD;
        __syncthreads();
#pragma unroll
        for (int t = 0; t < 2; ++t)
#pragma unroll
            for (int hf = 0; hf < 2; ++hf) { const int key0 = 64 * t + 32 * hf + sr, key = key0 < NCP ? key0 : NCP - 1;
                const f32x4 k0 = *(const f32x4*)(Kc + (size_t)key * HD + sc), k1 = *(const f32x4*)(Kc + (size_t)key * HD + sc + 4);
                const f32x4 v0 = *(const f32x4*)(Vc + (size_t)key * HD + sc), v1 = *(const f32x4*)(Vc + (size_t)key * HD + sc + 4);
                u32x4 kw = {cvtpk(k0[0], k0[1]), cvtpk(k0[2], k0[3]), cvtpk(k1[0], k1[1]), cvtpk(k1[2], k1[3])};
                u32x4 vw = {cvtpk(v0[0], v0[1]), cvtpk(v0[2], v0[3]), cvtpk(v1[0], v1[1]), cvtpk(v1[2], v1[3])};
                *(u32x4*)(K_lds + t * SHM_K + KSWZ(32 * hf + sr, sc * 2)) = kw;
                *(u32x4*)(V_lds + t * SHM_V + v_st(32 * hf + sr, sc)) = vw; }
        __syncthreads();
#pragma unroll 1
        for (int qi = 0; qi < 2; ++qi) {
            const int s0 = ((w & 15) * 2 + qi) * 64 + wid * 8, s = s0 + (r32 >> 2), h = kvh * 4 + (r32 & 3);
            bf16x8 qr[8];
            { const bf16* qb_ = PX(P, b * SEQ + s, h * HD) + hi * 8;
#pragma unroll
              for (int d0 = 0; d0 < 8; ++d0) qr[d0] = load8(qb_ + d0 * 16); }
            f32x16 p[4];
            qkt<0>(p[0], p[1], K_lds, r32, hi, qr); qkt<1>(p[2], p[3], K_lds, r32, hi, qr);
            const int nvis = s >= 31 ? (s - 31) / 16 + 1 : 0;
            float mx = -__builtin_inff();
#pragma unroll
            for (int j = 0; j < 4; ++j)
#pragma unroll
                for (int r = 0; r < 16; ++r) { const int key = 32 * j + crow(r, hi); p[j][r] = key < nvis ? p[j][r] : -__builtin_inff(); mx = fmaxf(mx, p[j][r]); }
            { auto rr = __builtin_amdgcn_permlane32_swap(__float_as_uint(mx), __float_as_uint(mx), false, false); mx = fmaxf(__uint_as_float(rr[0]), __uint_as_float(rr[1])); }
            const float mref = mx > -1e30f ? mx : 0.f, mnL = -mref * C2;
            float ps = 0.f;
#pragma unroll
            for (int j = 0; j < 4; ++j)
#pragma unroll
                for (int r = 0; r < 16; ++r) { p[j][r] = __builtin_amdgcn_exp2f(fmaf(p[j][r], C2, mnL)); ps += p[j][r]; }
            { auto rr = __builtin_amdgcn_permlane32_swap(__float_as_uint(ps), __float_as_uint(ps), false, false); ps = __uint_as_float(rr[0]) + __uint_as_float(rr[1]); }
            const float inv = ps > 0.f ? 1.0f / ps : 0.f;
#pragma unroll
            for (int j = 0; j < 4; ++j)
#pragma unroll
                for (int r = 0; r < 16; ++r) { p[j][r] *= inv; float v = p[j][r]; v += dpp_xor1(v); v += dpp_xor2(v);
                    if ((r32 & 3) == 0) pgw[(r32 >> 2) * 128 + 32 * j + crow(r, hi)] = v; }
            bf16x8 pa[8];
#define PK4(P_, B_, OUT) do { unsigned a0 = cvtpk(P_[B_+0], P_[B_+1]), a1 = cvtpk(P_[B_+2], P_[B_+3]); unsigned b0 = cvtpk(P_[B_+4], P_[B_+5]), b1 = cvtpk(P_[B_+6], P_[B_+7]); \
        auto r0 = __builtin_amdgcn_permlane32_swap(a0, b0, false, false); auto r1 = __builtin_amdgcn_permlane32_swap(a1, b1, false, false); \
        u32x4 w_ = {r0[0], r1[0], r0[1], r1[1]}; OUT = *reinterpret_cast<bf16x8*>(&w_); } while (0)
            PK4(p[0], 0, pa[0]); PK4(p[0], 8, pa[1]); PK4(p[1], 0, pa[2]); PK4(p[1], 8, pa[3]);
            PK4(p[2], 0, pa[4]); PK4(p[2], 8, pa[5]); PK4(p[3], 0, pa[6]); PK4(p[3], 8, pa[7]);
#undef PK4
            f32x16 o[4] = {};
            pv_tile<0>(o, vb0, pa[0], pa[1], pa[2], pa[3]); pv_tile<1>(o, vb0, pa[4], pa[5], pa[6], pa[7]);
#if GATED
            bf16 graw[16];
#pragma unroll
            for (int j = 0; j < 4; ++j) { const u32x2 g4 = *(const u32x2*)PX(P, b * SEQ + s0 + 2 * j + hi, PC_G + kvh * 4);
                graw[4 * j] = (bf16)(g4[0] & 0xffffu); graw[4 * j + 1] = (bf16)(g4[0] >> 16); graw[4 * j + 2] = (bf16)(g4[1] & 0xffffu); graw[4 * j + 3] = (bf16)(g4[1] >> 16); }
#endif
#pragma unroll
            for (int r = 0; r < 16; ++r) { const int row = crow(r, hi);
#if GATED
                const size_t tr = (size_t)(b * SEQ + s0 + (row >> 2)); const int hh = kvh * 4 + (row & 3);
                const float gsc = sigmoidf_(bf2f(graw[r])); bf16* op = (bf16*)OC + tr * D + hh * HD + r32;
#pragma unroll
                for (int dp = 0; dp < 2; ++dp) { const float va = o[dp][r] * gsc, vb = o[dp + 2][r] * gsc, na = dpp_xor1(va), nb = dpp_xor1(vb); const bool odd = r32 & 1;
                    *(unsigned*)(op - r32 + (odd ? dp + 2 : dp) * 32 + (r32 & ~1)) = cvtpk(odd ? nb : va, odd ? vb : na); }
#else
                float* op = OC + (size_t)(b * SEQ + s0 + (row >> 2)) * D + (kvh * 4 + (row & 3)) * HD + r32;
#pragma unroll
                for (int d0 = 0; d0 < 4; ++d0) op[d0 * 32] = o[d0][r];
#endif
            }
            asm volatile("s_waitcnt lgkmcnt(0)" ::: "memory");
            const int cur = s0 >> 6, n = lane & 31;
#pragma unroll 1
            for (int i = 0; i < 4; ++i) { const float* pq = pgw + (i + 4 * hi) * 128;
                const float scv = (n > 0 ? pq[4 * n - 1] : 0.f) + 2.0f * (pq[4 * n] + pq[4 * n + 1] + pq[4 * n + 2]) + pq[4 * n + 3];
                const bool vld = n <= cur, forced = (n == 0) || (n > cur - 2); const float val = vld ? (forced ? __builtin_inff() : scv) : -__builtin_inff();
                int rank = 0;
#pragma unroll
                for (int k = 0; k < 32; ++k) { const float vlo = __int_as_float(__builtin_amdgcn_readlane(__float_as_int(val), k)), vhi = __int_as_float(__builtin_amdgcn_readlane(__float_as_int(val), 32 + k));
                    const float vk = hi ? vhi : vlo; rank += (vk > val || (vk == val && k < n)) ? 1 : 0; }
                const unsigned long long bm = __ballot(rank < 16 && val > -__builtin_inff());
                if (lane == 0) { unsigned* sp = selp + ((size_t)b * NKV + kvh) * SEQ + s0 + i; sp[0] = (unsigned)bm; sp[4] = (unsigned)(bm >> 32); } }
            asm volatile("s_waitcnt lgkmcnt(0)" ::: "memory");
        }
    }
}

__device__ __forceinline__ void att_combine(const WaveAtt& W, LAS float* xm, LAS float* xl, LAS float* xo, float* O, int r, int kvh, const Frame& F, bool normalised, const bf16* gate, float& osum, bool fin) {
#pragma unroll
    for (int g = 0; g < 4; ++g) if (F.lane == g) { xm[F.wave * 4 + g] = W.m[g]; xl[F.wave * 4 + g] = W.l[g]; }
#pragma unroll
    for (int g = 0; g < 4; ++g) *(LAS f32x2*)(xo + F.wave * 512 + g * 128 + 2 * F.lane) = (f32x2){W.o[g][0], W.o[g][1]};
    __syncthreads();
    { const int g = F.tid >> 7, d = F.tid & 127; float M = -1e30f;
#pragma unroll
      for (int v = 0; v < 8; ++v) M = fmaxf(M, xm[v * 4 + g]);
      float L = 0.f, acc = 0.f;
#pragma unroll
      for (int v = 0; v < 8; ++v) { const float f = normalised ? 1.0f : __expf(xm[v * 4 + g] - M); L += f * xl[v * 4 + g]; acc += f * xo[v * 512 + g * 128 + d]; }
      const float val = normalised ? acc : (L > 0.f ? acc / L : 0.f);
#if GATED
      osum += val * sigmoidf_(bf2f(gate[g]));
      if (fin) ((bf16*)O)[(size_t)r * 2 * D + (kvh * 4 + g) * HD + d] = (bf16)f2bf(osum);
#else
      O[(size_t)r * D + (kvh * 4 + g) * HD + d] = val;
#endif
    }
    __syncthreads();
}
__device__ __forceinline__ void ph_sample_attn(const Args& a, const Frame& F, size_t oc_off = WS_OCMP, size_t os_off = WS_OSLC, size_t ow_off = WS_OWIN) {
    const bf16* P = (const bf16*)(a.ws + WS_P); const float* kcs = (const float*)(a.ws + WS_KCS);
    LAS float* base = (LAS float*)F.lds; LAS float* wl = base + F.wave * 1024; WaveAtt W; W.qs = wl; W.pb = wl + 512;
    LAS float* xm = base + 8192; LAS float* xl = xm + 32; LAS float* xo = xl + 32; LAS float* pg = xo + 4096 + 4; LAS float* scl = pg + 1028; LAS int* list = (LAS int*)(scl + 264);
    const int wv = F.wave;
    for (int w = F.vcu; w < NBS * NKV * DSQ; w += F.G) {
        int lane = F.lane; asm volatile("" : "+v"(lane));
        const int b = w >> 5, kvh = (w >> 3) & 3, s = w & 7, r = MP + b * DSQ + s;
        att_load_q(P, r, kvh, W, lane);
        const float* Kc = kcs + (((size_t)0 * NBS + b) * NKV + kvh) * 1024 * HD; const float* Vc = kcs + (((size_t)1 * NBS + b) * NKV + kvh) * 1024 * HD;
        float mx[4] = {-1e30f, -1e30f, -1e30f, -1e30f}, ls[4] = {0.f, 0.f, 0.f, 0.f}; float scs[2][4];
#pragma unroll
        for (int q = 0; q < 2; ++q) { const int c = (2 * wv + q) * 64 + lane; const bool valid = c < NCS; float t[4];
            if (valid) att_dot4<float>(Kc + (size_t)c * HD, W, t); else { t[0] = t[1] = t[2] = t[3] = 0.f; }
#pragma unroll
            for (int g = 0; g < 4; ++g) { const float sv = valid ? t[g] * SCALE : -__builtin_inff(); scs[q][g] = sv; const float m2 = fmaxf(mx[g], wave_max(sv));
                ls[g] = ls[g] * __expf(mx[g] - m2) + wave_sum(__expf(sv - m2)); mx[g] = m2; } }
#pragma unroll
        for (int g = 0; g < 4; ++g) if (lane == g) { xm[wv * 4 + g] = mx[g]; xl[wv * 4 + g] = ls[g]; }
        __syncthreads();
        float M[4], Li[4];
#pragma unroll
        for (int g = 0; g < 4; ++g) { float m_ = -1e30f;
#pragma unroll
            for (int v = 0; v < 8; ++v) m_ = fmaxf(m_, xm[v * 4 + g]);
            float l_ = 0.f;
#pragma unroll
            for (int v = 0; v < 8; ++v) l_ += xl[v * 4 + g] * __expf(xm[v * 4 + g] - m_);
            M[g] = m_; Li[g] = l_ > 0.f ? 1.0f / l_ : 0.f; }
        __syncthreads();
        att_init(W);
#pragma unroll
        for (int q = 0; q < 2; ++q) { const int sg = 2 * wv + q, c = sg * 64 + lane;
            f32x4 p; float pgs = 0.f;
#pragma unroll
            for (int g = 0; g < 4; ++g) { p[g] = __expf(scs[q][g] - M[g]) * Li[g]; pgs += p[g]; }
            pg[c] = pgs;
            int nk = NCS - sg * 64; nk = nk > 64 ? 64 : nk;
            *(LAS f32x4*)(W.pb + lane * 4) = p; asm volatile("s_waitcnt lgkmcnt(0)" ::: "memory");
            att_pv<float>(Vc + (size_t)sg * 64 * HD, HD, nk, W, lane); asm volatile("s_waitcnt lgkmcnt(0)" ::: "memory"); }
        if (F.tid == 0) pg[-1] = 0.f;
        const bf16* grow = PX(P, r, PC_G + kvh * 4);
        float osum = 0.f;
        att_combine(W, xm, xl, xo, (float*)(a.ws + oc_off), r, kvh, F, true, grow, osum, false);
        if (F.tid < 256) { const int n = F.tid; scl[n] = (n >= 1 && n <= 254) ? pg[4 * n - 1] + 2.0f * (pg[4 * n] + pg[4 * n + 1] + pg[4 * n + 2]) + pg[4 * n + 3] : -__builtin_inff(); }
        __syncthreads();
        if (F.tid < 256) { const int n = F.tid; const float val = scl[n]; int rank = 0;
#pragma unroll 2
            for (int k = 1; k <= 254; ++k) { const float vk = scl[k]; rank += (vk > val || (vk == val && k < n)) ? 1 : 0; }
            const bool sel = (n >= 1 && n <= 254 && rank < 13) || n == 0 || n == 255;
            const unsigned long long bm = __ballot(sel);
            if (lane == 0) { ((LAS unsigned*)list)[2 * wv] = (unsigned)bm; ((LAS unsigned*)list)[2 * wv + 1] = (unsigned)(bm >> 32); } }
        __syncthreads();
        if (F.tid == 0) { int cnt = 0;
#pragma unroll 1
            for (int i = 0; i < 8; ++i) { unsigned x = ((LAS unsigned*)list)[i];
#pragma unroll 1
                while (x) { const int bpos = __ffs(x) - 1; x &= x - 1; if (cnt < 16) { list[8 + cnt] = i * 32 + bpos; ++cnt; } } }
            if (cnt < 17) { list[8 + cnt] = 256; ++cnt; }
#pragma unroll 1
            for (; cnt < 17; ++cnt) list[8 + cnt] = -1; }
        __syncthreads();
        att_init(W);
#pragma unroll 1
        for (int e = wv; e < 17; e += 8) {
            const int n = list[8 + e]; if (n < 0) continue;
            if (n < 256) {
                const int page = a.ptab[b * NPAGES + (n >> 1)];
                const float* kb = a.cache + ((size_t)page * PAGE + (n & 1) * 64) * 2048 + kvh * HD;
                att_segment<float, PVS>(kb + 2 * 512, 2048, kb + 3 * 512, 2048, 64, true, W, lane);
            } else { att_segment<bf16, PVS>(PX(P, MP + b * DSQ, PC_KV + 2 * 512 + kvh * HD), PRS, PX(P, MP + b * DSQ, PC_KV + 3 * 512 + kvh * HD), PRS, s + 1, lane <= s, W, lane); }
        }
        att_combine(W, xm, xl, xo, (float*)(a.ws + os_off), r, kvh, F, false, grow + 16, osum, false);
        att_init(W);
        { const float* st = a.st_win + (size_t)b * 512 * 1024 + kvh * HD; const int i0 = wv * 64;
          const float* nw = a.out + OUT_WINS + ((size_t)b * 512 + 504) * 1024 + kvh * HD;
          if (wv == 0) att_segment<float, PVS>(st, 1024, st + 512, 1024, 64, true, W, lane, nw, nw + 512, s + 1);
          else att_segment<float, PVS>(st + (size_t)i0 * 1024, 1024, st + (size_t)i0 * 1024 + 512, 1024, 64, true, W, lane); }
        att_combine(W, xm, xl, xo, (float*)(a.ws + (GATED ? WS_A2 : ow_off)), r, kvh, F, false, grow + 32, osum, true);
    }
    { float* ow = a.out + OUT_WINS;
      for (size_t i = (size_t)(F.vcu * 512 + F.tid); i < (size_t)NBS * 504 * 256; i += (size_t)F.G * 512) { const size_t b = i / (504 * 256), rem = i % (504 * 256);
          *(f32x4*)(ow + b * 512 * 1024 + rem * 4) = *(const f32x4*)(a.st_win + b * 512 * 1024 + 8 * 1024 + rem * 4); } }
}

__device__ __forceinline__ fa::BlockRef fa_ref(const Args& a, int w, int i) {
    const int bh = w >> 2, p = w & 3, b = bh >> 4, h = bh & 15, kvh = h >> 2;
#if GATED
    const bool win = i & 1; const int qb = (i < 2) ? 7 - p : p;
#else
    const bool win = i >= 2; int qb;
    if (!win) qb = (i == 0) ? 7 - p : p;
    else { const int j = i - 2; qb = p == 0 ? 7 - j : (p == 1 ? 5 - j : (p == 2 ? (j ? 1 : 3) : (j ? 0 : 2))); }
#endif
    const bf16* P = (const bf16*)(a.ws + WS_P); const bf16* KV6 = (const bf16*)(a.ws + WS_KV6);
    fa::BlockRef r; r.P0 = qb * 256; r.W = win ? 512 : (1 << 20);
    r.Q = PX(P, b * SEQ + r.P0, h * HD);
    r.K = KV6 + (((size_t)(win ? 4 : 2) * NBP + b) * NKV + kvh) * SEQ * HD; r.V = KV6 + (((size_t)(win ? 5 : 3) * NBP + b) * NKV + kvh) * SEQ * HD;
#if GATED
    r.O = (float*)((bf16*)(a.ws + WS_A2) + (size_t)(b * SEQ + r.P0) * fa::OSA + h * HD);
    r.C = (const bf16*)(a.ws + WS_OCMP) + (size_t)(b * SEQ + r.P0) * D + h * HD;
#else
    r.O = (float*)(a.ws + (win ? WS_OWIN : WS_OSLC)) + (size_t)(b * SEQ + r.P0) * D + h * HD; r.C = nullptr;
#endif
    r.gate = PX(P, b * SEQ + r.P0, PC_G + (win ? 32 : 16) + h);
    r.sel = win ? nullptr : (const unsigned*)(a.ws + WS_SELP) + ((size_t)b * NKV + kvh) * SEQ;
    return r;
}
__device__ __forceinline__ void ph_fa_prompt(const Args& a, const Frame& F, char* lds) {
    const int nW = (256 - F.vcu + F.G - 1) / F.G;
    if (F.vcu >= 256) return;
    const int total = nW * 4;
    int it = 0;
    fa::BlockRef cur = fa_ref(a, F.vcu, 0);
    fa::Seam S;
    fa::prime(cur, lds, S);
    for (;;) {
        const bool last = it + 1 >= total;
        const int itn = last ? it : it + 1;
        const fa::BlockRef nxt = fa_ref(a, F.vcu + (itn >> 2) * F.G, itn & 3);
        fa::block(cur, nxt, SEQ, lds, S);
        if (last) break;
        cur = nxt; it = itn;
    }
}


#ifndef DBG_MASK_TOL
#define DBG_MASK_TOL 1000u
#endif
constexpr int CW_DBG = 2048;
__device__ __forceinline__ void ph_check(const Args& a, const Frame& F, size_t offA, size_t offB, size_t nfloats, float tol, unsigned bit) {
    const float* A = (const float*)(a.ws + offA); const float* B = (const float*)(a.ws + offB); bool bad = false;
    for (size_t i = (size_t)F.vcu * 512 + F.tid; i < nfloats / 4; i += (size_t)F.G * 512) { const f32x4 x = *(const f32x4*)(A + i * 4), y = *(const f32x4*)(B + i * 4);
#pragma unroll
        for (int e = 0; e < 4; ++e) { const float d = fabsf(x[e] - y[e]); if (!(d <= tol)) bad = true; } }
    if (__any(bad) && F.lane == 0) atomicOr((unsigned*)(a.ws + WS_CTL) + CW_DBG, bit);
}

constexpr int CW_DBGCNT = 2112;
__device__ __forceinline__ void ph_check_masks(const Args& a, const Frame& F) {
    const unsigned* A = (const unsigned*)(a.ws + WS_SELP); const unsigned* B = (const unsigned*)(a.ws + WS_SELP2); int bad = 0;
    for (int i = F.vcu * 512 + F.tid; i < NBP * NKV * SEQ; i += F.G * 512) bad += (A[i] != B[i]) ? 1 : 0;
    bad = (int)wave_sum((float)bad);
    if (F.lane == 0 && bad) atomicAdd((unsigned*)(a.ws + WS_CTL) + CW_DBGCNT, (unsigned)bad);
}


__device__ __forceinline__ void ph_conv_z(const Args& a, const Frame& F) {
    const bf16* P = (const bf16*)(a.ws + WS_P); bf16* A2 = (bf16*)(a.ws + WS_A2);
    const int gw = F.vcu * 8 + F.wave, NGW = F.G * 8, lane = F.lane;
    constexpr int NPI = (MP / 16) * 4, NSI = NBS * 4;
#pragma unroll 1
    for (int it = gw; it < NPI + NSI; it += NGW) {
        const bool smp = it >= NPI; const int q = smp ? (it - NPI) & 3 : it & 3, ch = smp ? (it - NPI) >> 2 : it >> 2;
        const int r0 = smp ? MP + ch * DSQ : ch * 16, nrow = smp ? DSQ : 16, s0 = smp ? 0 : (r0 & 2047), SL = smp ? DSQ : SEQ, b = smp ? ch : r0 >> 11;
        const int c = q * 512 + lane * 8;
        float w0[8], w1[8], w2[8], cb[8], u1[8], u2[8];
#pragma unroll
        for (int h = 0; h < 2; ++h) { const f32x4 x0 = *(const f32x4*)(a.conv_w + c + 4 * h), x1 = *(const f32x4*)(a.conv_w + D + c + 4 * h), x2 = *(const f32x4*)(a.conv_w + 2 * D + c + 4 * h), x3 = *(const f32x4*)(a.conv_b + c + 4 * h);
#pragma unroll
            for (int e = 0; e < 4; ++e) { w0[4 * h + e] = x0[e]; w1[4 * h + e] = x1[e]; w2[4 * h + e] = x2[e]; cb[4 * h + e] = x3[e]; } }
        if (smp) {
#pragma unroll
            for (int h = 0; h < 2; ++h) { const f32x4 p0 = *(const f32x4*)(a.st_conv + ((size_t)b * 2 + 0) * D + c + 4 * h), p1 = *(const f32x4*)(a.st_conv + ((size_t)b * 2 + 1) * D + c + 4 * h);
#pragma unroll
                for (int e = 0; e < 4; ++e) { u2[4 * h + e] = p0[e]; u1[4 * h + e] = p1[e]; } }
        } else if (s0 == 0) {
#pragma unroll
            for (int e = 0; e < 8; ++e) { u1[e] = 0.f; u2[e] = 0.f; }
        } else {
            const u32x4 c2 = *(const u32x4*)PX(P, r0 - 2, PC_C + c), i2 = *(const u32x4*)PX(P, r0 - 2, PC_U + c), c1 = *(const u32x4*)PX(P, r0 - 1, PC_C + c), i1 = *(const u32x4*)PX(P, r0 - 1, PC_U + c);
#pragma unroll
            for (int e = 0; e < 4; ++e) { u2[2 * e] = lo_bf(c2[e]) * lo_bf(i2[e]); u2[2 * e + 1] = hi_bf(c2[e]) * hi_bf(i2[e]); u1[2 * e] = lo_bf(c1[e]) * lo_bf(i1[e]); u1[2 * e + 1] = hi_bf(c1[e]) * hi_bf(i1[e]); }
        }
#pragma unroll 1
        for (int i0 = 0; i0 < nrow; i0 += 4) {
            u32x4 cg[4], ui[4], bg[4];
#pragma unroll
            for (int k = 0; k < 4; ++k) { const int rr_ = r0 + i0 + k; cg[k] = *(const u32x4*)PX(P, rr_, PC_C + c); ui[k] = *(const u32x4*)PX(P, rr_, PC_U + c); bg[k] = *(const u32x4*)PX(P, rr_, PC_B + c); }
#pragma unroll
            for (int k = 0; k < 4; ++k) { const int r = r0 + i0 + k, s = s0 + i0 + k; float u[8], z[8];
#pragma unroll
                for (int e = 0; e < 4; ++e) { u[2 * e] = lo_bf(cg[k][e]) * lo_bf(ui[k][e]); u[2 * e + 1] = hi_bf(cg[k][e]) * hi_bf(ui[k][e]); }
#pragma unroll
                for (int e = 0; e < 8; ++e) { const float y = cb[e] + w0[e] * u2[e] + w1[e] * u1[e] + w2[e] * u[e]; z[e] = ((e & 1) ? hi_bf(bg[k][e >> 1]) : lo_bf(bg[k][e >> 1])) * y; }
                *(u32x4*)(A2 + (size_t)r * 2 * D + D + c) = (u32x4){pk2(z[0], z[1]), pk2(z[2], z[3]), pk2(z[4], z[5]), pk2(z[6], z[7])};
                if (s >= SL - 2) { float* o = a.out + (smp ? OUT_CONVS : OUT_CONVP) + ((size_t)b * 2 + (s - (SL - 2))) * D + c; *(f32x4*)o = (f32x4){u[0], u[1], u[2], u[3]}; *(f32x4*)(o + 4) = (f32x4){u[4], u[5], u[6], u[7]}; }
#pragma unroll
                for (int e = 0; e < 8; ++e) { u2[e] = u1[e]; u1[e] = u[e]; } }
        }
    }
}
__device__ __forceinline__ void ph_combine(const Args& a, const Frame& F) {
    const bf16* P = (const bf16*)(a.ws + WS_P); bf16* A2 = (bf16*)(a.ws + WS_A2);
    const float* OC = (const float*)(a.ws + WS_OCMP); const float* OS = (const float*)(a.ws + WS_OSLC); const float* OW = (const float*)(a.ws + WS_OWIN);
    const int gw = F.vcu * 8 + F.wave, NGW = F.G * 8, lane = F.lane;
    for (int r = gw; r < MPAD; r += NGW) {
        bf16* orow = A2 + (size_t)r * 2 * D;
        if (r >= MR) { for (int j = 0; j < 8; ++j) *(u32x4*)(orow + (lane + 64 * j) * 8) = (u32x4){0u, 0u, 0u, 0u}; continue; }
#if GATED
#pragma unroll
        for (int j = 0; j < 4; ++j) { const int c = (lane + 64 * j) * 8;
            const u32x4 x = *(const u32x4*)((const bf16*)OC + (size_t)r * D + c), y = *(const u32x4*)((const bf16*)OS + (size_t)r * D + c), z_ = *(const u32x4*)((const bf16*)OW + (size_t)r * D + c);
            u32x4 w;
#pragma unroll
            for (int e = 0; e < 4; ++e) w[e] = pk2(lo_bf(x[e]) + lo_bf(y[e]) + lo_bf(z_[e]), hi_bf(x[e]) + hi_bf(y[e]) + hi_bf(z_[e]));
            *(u32x4*)(orow + c) = w; }
#else
#pragma unroll
        for (int j = 0; j < 8; ++j) { const int c = (lane + 64 * j) * 4, h = c >> 7;
            const float g0 = sigmoidf_(bf2f(*PX(P, r, PC_G + h))), g1 = sigmoidf_(bf2f(*PX(P, r, PC_G + 16 + h))), g2 = sigmoidf_(bf2f(*PX(P, r, PC_G + 32 + h)));
            const f32x4 v = g0 * *(const f32x4*)(OC + (size_t)r * D + c) + g1 * *(const f32x4*)(OS + (size_t)r * D + c) + g2 * *(const f32x4*)(OW + (size_t)r * D + c);
            *(u32x2*)(orow + c) = (u32x2){pk2(v[0], v[1]), pk2(v[2], v[3])}; }
#endif
#if !GATED
        const bool smp = r >= MP; const int s = smp ? (r - MP) & 7 : r & 2047, b = smp ? (r - MP) >> 3 : r >> 11;
#pragma unroll
        for (int j = 0; j < 8; ++j) { const int c = (lane + 64 * j) * 4; f32x4 u[3];
#pragma unroll
            for (int t = 0; t < 3; ++t) { const int ss = s - 2 + t;
                if (ss >= 0) { const int rq = r - (2 - t); const u32x2 cg = *(const u32x2*)PX(P, rq, PC_C + c), ui = *(const u32x2*)PX(P, rq, PC_U + c);
                    u[t] = (f32x4){lo_bf(cg[0]) * lo_bf(ui[0]), hi_bf(cg[0]) * hi_bf(ui[0]), lo_bf(cg[1]) * lo_bf(ui[1]), hi_bf(cg[1]) * hi_bf(ui[1])}; }
                else if (smp) u[t] = *(const f32x4*)(a.st_conv + ((size_t)b * 2 + (ss + 2)) * D + c);
                else u[t] = (f32x4){0.f, 0.f, 0.f, 0.f}; }
            const f32x4 w0 = *(const f32x4*)(a.conv_w + c), w1 = *(const f32x4*)(a.conv_w + D + c), w2 = *(const f32x4*)(a.conv_w + 2 * D + c), cb = *(const f32x4*)(a.conv_b + c);
            const u32x2 bg = *(const u32x2*)PX(P, r, PC_B + c);
            const f32x4 y = cb + w0 * u[0] + w1 * u[1] + w2 * u[2];
            const f32x4 z = {lo_bf(bg[0]) * y[0], hi_bf(bg[0]) * y[1], lo_bf(bg[1]) * y[2], hi_bf(bg[1]) * y[3]};
            *(u32x2*)(orow + D + c) = (u32x2){pk2(z[0], z[1]), pk2(z[2], z[3])};
            const int SL = smp ? DSQ : SEQ;
            if (s >= SL - 2) { float* o = a.out + (smp ? OUT_CONVS : OUT_CONVP) + ((size_t)b * 2 + (s - (SL - 2))) * D + c; *(f32x4*)o = u[2]; } }
#endif
    }
}
__device__ __forceinline__ void ph_final(const Args& a, const Frame& F) {
    const int gw = F.vcu * 8 + F.wave, NGW = F.G * 8; const float* X2 = (const float*)(a.ws + WS_X2);
#if DBG_CHECK
    { unsigned fl = __hip_atomic_load((unsigned*)(a.ws + WS_CTL) + CW_DBG, __ATOMIC_RELAXED, __HIP_MEMORY_SCOPE_AGENT);
      if (__hip_atomic_load((unsigned*)(a.ws + WS_CTL) + CW_DBGCNT, __ATOMIC_RELAXED, __HIP_MEMORY_SCOPE_AGENT) > (DBG_MASK_TOL)) fl |= 8u;
      if (F.vcu == 0 && F.tid < 4 && ((fl >> F.tid) & 1u)) { const size_t tgt = F.tid == 0 ? OUT_CONVS : (F.tid == 1 ? OUT_CONVP : (F.tid == 2 ? OUT_WINS : OUT_KVS)); a.out[tgt] = 1e6f; } }
#endif
    for (int r = gw; r < MR; r += NGW) {
        const float* xr = X2 + (size_t)r * D; float* o = a.out + (r < MP ? OUT_YP + (size_t)r * D : OUT_YS + (size_t)(r - MP) * D);
        f32x4 v[8]; float ss = 0.f;
#pragma unroll
        for (int j = 0; j < 8; ++j) { v[j] = *(const f32x4*)(xr + (F.lane + 64 * j) * 4); ss += (v[j][0] * v[j][0] + v[j][1] * v[j][1]) + (v[j][2] * v[j][2] + v[j][3] * v[j][3]); }
        const float rstd = rsqrtf(wave_sum(ss) * (1.0f / D) + RMS_EPS);
#pragma unroll
        for (int j = 0; j < 8; ++j) { const int c = (F.lane + 64 * j) * 4; *(f32x4*)(o + c) = v[j] * rstd * *(const f32x4*)(a.nfg + c); }
    }
}


__device__ __forceinline__ void ph_check_a2(const Args& a, const Frame& F, float tol, unsigned bit) {
    const bf16* P = (const bf16*)(a.ws + WS_P); const bf16* A2 = (const bf16*)(a.ws + WS_A2);
    const float* RC = (const float*)(a.ws + WS_DBGC); const float* RS = (const float*)(a.ws + WS_DBGA); const float* RW = (const float*)(a.ws + WS_DBGB);
    bool bad = false;
    for (size_t i = (size_t)F.vcu * 512 + F.tid; i < (size_t)MR * D; i += (size_t)F.G * 512) { const int r = (int)(i >> 11), c = (int)(i & 2047), h = c >> 7;
        const float ref = sigmoidf_(bf2f(*PX(P, r, PC_G + h))) * RC[i] + sigmoidf_(bf2f(*PX(P, r, PC_G + 16 + h))) * RS[i] + sigmoidf_(bf2f(*PX(P, r, PC_G + 32 + h))) * RW[i];
        const float got = bf2f(A2[(size_t)r * 2 * D + c]); if (!(fabsf(ref - got) <= tol)) bad = true; }
    if (__any(bad) && F.lane == 0) atomicOr((unsigned*)(a.ws + WS_CTL) + CW_DBG, bit);
}

#define PHF __device__ __forceinline__ void
PHF phase0(const Args& a, const Frame& F, unsigned char* lds_raw) { ph_ada(a, F); __syncthreads();
    ph_transpose_range(a, F, TR_NBIG, TR_NIT, F.vcu, F.G);
    constexpr int NADA = 6 * D / 64;
    if (F.G > NADA && F.vcu >= NADA) ph_transpose_range(a, F, 0, TR_EARLY, F.vcu - NADA, F.G - NADA);
}
PHF phase1(const Args& a, const Frame& F, unsigned char* lds_raw) { ph_peb_sum(a, F); ph_transpose_range(a, F, (F.G > 6 * D / 64) ? TR_EARLY : 0, TR_NBIG, F.vcu, F.G); ph_modnorm<0>(a, F); ph_compress_sample(a, F, (char*)lds_raw);
    if ((DBG_REPEAT >> 17) & 1) { __syncthreads(); ph_transpose_range(a, F, 0, TR_NBIG, F.vcu, F.G); }
    if ((DBG_REPEAT >> 18) & 1) { __syncthreads(); ph_modnorm<0>(a, F); }
    if ((DBG_REPEAT >> 19) & 1) { __syncthreads(); ph_compress_sample<0>(a, F, (char*)lds_raw); }
    if ((DBG_REPEAT >> 20) & 1) { __syncthreads(); ph_compress_sample<1>(a, F, (char*)lds_raw); }
    if ((DBG_REPEAT >> 21) & 1) { __syncthreads(); ph_compress_sample<2>(a, F, (char*)lds_raw); }
#if DBG_CHECK & 16
    ph_cache_cvt(a, F);
#endif
}
PHF phase2(const Args& a, const Frame& F, unsigned char* lds_raw) {
    {
      const int nwg = (MPAD / 256) * (NIN / 256), c = (int)blockIdx.x, full = (nwg + F.G - 1) / F.G, mine = c < nwg ? (nwg - c + F.G - 1) / F.G : 0;
      const int first_short = nwg - (full - 1) * F.G;
      if (first_short < F.G) { if (mine < full) ph_cmp_finish_mfma<1>(a, F, (char*)lds_raw, c - first_short, F.G - first_short); }
      else ph_cmp_finish_mfma<1>(a, F, (char*)lds_raw); }
    pg8::Prob g{(const char*)(a.ws + WS_H), (const char*)(a.ws + WS_WIN_T), (size_t)256 * D * 2, 0, 0, (size_t)256 * D * 2, 0, D * 2, D * 2, D / 64};
    pg8::Order S; S.init(MPAD, NIN, F.G, (int)blockIdx.x, 1);
    EpiIn E{(bf16*)(a.ws + WS_P), (bf16*)(a.ws + WS_KV6), a.out};
    __syncthreads();
    pg8::gemm_phase<EpiIn, false, true>(F.lds, g, S, E);
    if ((DBG_REPEAT >> 15) & 1) { __syncthreads(); EpiNull EN{(float*)(a.ws + WS_DBGA)}; pg8::gemm_phase<EpiNull>(F.lds, g, S, EN); }
#if DBG_CHECK & 16
    { __syncthreads();
      pg8::Prob g2{(const char*)(a.ws + WS_CA), (const char*)(a.ws + WS_WC_T), (size_t)256 * 2048 * 2, (size_t)NBS * NKV * PAST * HD * 2, 0, (size_t)256 * 2048 * 2, 0, 2048 * 2, 2048 * 2, 2048 / 64};
      pg8::Order S2; S2.init(32768, 512, F.G, (int)blockIdx.x, 1);
      EpiF32 E2{(float*)(a.ws + WS_DBGA), 512};
      pg8::gemm_phase<EpiF32>(F.lds, g2, S2, E2); }
#endif
}
PHF phase3(const Args& a, const Frame& F, unsigned char* lds_raw) {
#if DBG_CHECK & 16
    ph_check(a, F, WS_PARTS, WS_DBGA, (size_t)32768 * 512, 2e-3f, 1u);
#endif
    ph_compress_prompt(a, F);
#if DBG_CHECK & 32
    { __syncthreads(); pg8::Prob g{(const char*)(a.ws + WS_KV6), (const char*)(a.ws + WS_WC_T), (size_t)256 * 2048 * 2, (size_t)NBP * NKV * SEQ * HD * 2, 0, (size_t)256 * 2048 * 2, 0, 2048 * 2, 2048 * 2, 2048 / 64};
      pg8::Order S; S.init(2048, 512, F.G, (int)blockIdx.x, 1);
      EpiF32 E{(float*)(a.ws + WS_DBGA), 512};
      pg8::gemm_phase<EpiF32>(F.lds, g, S, E); }
#endif
    __syncthreads(); ph_sample_attn(a, F);
}
PHF phase4(const Args& a, const Frame& F, unsigned char* lds_raw) {
#if DBG_CHECK & 32
    ph_check(a, F, WS_PARTP, WS_DBGA, (size_t)2048 * 512, 2e-3f, 1u);
#endif
    ph_cmp_finish_mfma<0>(a, F, (char*)lds_raw);
#if GATED
    __syncthreads(); ph_conv_z(a, F);
#endif
}
PHF phase5(const Args& a, const Frame& F, unsigned char* lds_raw) { ph_cmp_prompt(a, F, (char*)lds_raw);
#if DBG_CHECK & 8
    __syncthreads(); ph_cmp_finish<1>(a, F, WS_DBGA); __syncthreads(); ph_cmp_finish<0>(a, F, WS_DBGB);
#endif
#if DBG_CHECK & 64
    __syncthreads(); ph_cmp_attend<1>(a, F, WS_DBGC);
#endif
}
PHF phase6(const Args& a, const Frame& F, unsigned char* lds_raw) {
#if DBG_CHECK & 8
    ph_check(a, F, WS_KCS, WS_DBGA, (size_t)2 * NBS * NKV * 1024 * HD, 0.02f, 1u); ph_check(a, F, WS_KCP, WS_DBGB, (size_t)2 * NBP * NKV * 128 * HD, 0.02f, 2u);
#endif
    ph_fa_prompt(a, F, (char*)lds_raw);
#if DBG_CHECK & 1
    __syncthreads(); ph_slc_attend<0>(a, F, WS_DBGA); __syncthreads(); ph_win_attend<0>(a, F, WS_DBGB);
#endif
#if DBG_CHECK & 2
    __syncthreads(); ph_cmp_attend<0>(a, F, WS_DBGC, WS_SELP2);
#endif
#if DBG_CHECK & 4
    __syncthreads(); ph_cmp_attend<1>(a, F, WS_DBGC);
#endif
#if DBG_CHECK & 64
    __syncthreads(); ph_slc_attend<0>(a, F, WS_DBGA); __syncthreads(); ph_win_attend<0>(a, F, WS_DBGB); __syncthreads(); ph_cmp_attend<0>(a, F, WS_DBGC, WS_SELP2);
    __syncthreads(); ph_slc_attend<1>(a, F, WS_DBGA); __syncthreads(); ph_win_attend<1>(a, F, WS_DBGB);
#endif
}
PHF phase7(const Args& a, const Frame& F, unsigned char* lds_raw) {
#if DBG_CHECK & 1
    ph_check(a, F, WS_OSLC, WS_DBGA, (size_t)MP * D, 0.05f, 1u); ph_check(a, F, WS_OWIN, WS_DBGB, (size_t)MP * D, 0.05f, 2u);
#endif
#if DBG_CHECK & 2
    ph_check(a, F, WS_OCMP, WS_DBGC, (size_t)MP * D, 0.03f, 4u); ph_check_masks(a, F);
#endif
#if DBG_CHECK & 4
    __syncthreads(); ph_slc_attend<1>(a, F, WS_DBGA); __syncthreads(); ph_win_attend<1>(a, F, WS_DBGB);
#endif
    ph_combine(a, F);
}
PHF phase8(const Args& a, const Frame& F, unsigned char* lds_raw) {
#if DBG_CHECK & 64
    ph_check_a2(a, F, 0.03f, 1u); ph_check_masks(a, F);
#endif
#if DBG_CHECK & 4
    ph_check(a, F, WS_OCMP + (size_t)MP * D * 4, WS_DBGC + (size_t)MP * D * 4, (size_t)MS * D, 0.01f, 1u); ph_check(a, F, WS_OSLC + (size_t)MP * D * 4, WS_DBGA + (size_t)MP * D * 4, (size_t)MS * D, 0.01f, 2u);
    ph_check(a, F, WS_OWIN + (size_t)MP * D * 4, WS_DBGB + (size_t)MP * D * 4, (size_t)MS * D, 0.01f, 4u);
#endif
    { SEpiProj SE{(const bf16*)(a.ws + WS_P), (bf16*)(a.ws + WS_MIX)};
      small_gemm<8, 2>(F, (const bf16*)(a.ws + WS_A2) + (size_t)MP * 2 * D, 2 * D, D, (const bf16*)(a.ws + WS_WP_T), 2 * D, D, D, D, SE); }
    pg8::Prob g{(const char*)(a.ws + WS_A2), (const char*)(a.ws + WS_WP_T), (size_t)256 * 2 * D * 2, 0, (size_t)D * 2, (size_t)256 * 2 * D * 2, (size_t)D * 2, 2 * D * 2, 2 * D * 2, D / 64};
    pg8::Order S; S.init(MP, D, F.G, (int)blockIdx.x, 2);
    EpiProj E{(const bf16*)(a.ws + WS_P), (bf16*)(a.ws + WS_MIX)};
    pg8::gemm_phase<EpiProj>(F.lds, g, S, E);
}
PHF phase9(const Args& a, const Frame& F, unsigned char* lds_raw) {
    { SEpiRes<0> SE{a};
      small_gemm<8, 1>(F, (const bf16*)(a.ws + WS_MIX) + (size_t)MP * D, D, 0, (const bf16*)(a.ws + WS_WOUT_T), D, 0, D, D, SE); }
    pg8::Prob g{(const char*)(a.ws + WS_MIX), (const char*)(a.ws + WS_WOUT_T), (size_t)256 * D * 2, 0, 0, (size_t)256 * D * 2, 0, D * 2, D * 2, D / 64};
    pg8::Order S; S.init(MP, D, F.G, (int)blockIdx.x, 1);
    EpiRes<0> E{a};
    pg8::gemm_phase<EpiRes<0>>(F.lds, g, S, E);
}
PHF phase10(const Args& a, const Frame& F, unsigned char* lds_raw) { ph_modnorm<1>(a, F); }
PHF phase11(const Args& a, const Frame& F, unsigned char* lds_raw) {
    { SEpiRelu2 SE{(bf16*)(a.ws + WS_HM)};
      small_gemm<32, 1>(F, (const bf16*)(a.ws + WS_H) + (size_t)MP * D, D, 0, (const bf16*)(a.ws + WS_W1_T), D, 0, D, DFF, SE); }
    pg8::Prob g{(const char*)(a.ws + WS_H), (const char*)(a.ws + WS_W1_T), (size_t)256 * D * 2, 0, 0, (size_t)256 * D * 2, 0, D * 2, D * 2, D / 64};
    pg8::Order S; S.init(MP, DFF, F.G, (int)blockIdx.x, 1);
    EpiRelu2 E{(bf16*)(a.ws + WS_HM)};
    pg8::gemm_phase<EpiRelu2, false, true>(F.lds, g, S, E);
}
PHF phase12(const Args& a, const Frame& F, unsigned char* lds_raw) {
    { SEpiRes<1> SE{a};
      small_gemm<8, 1>(F, (const bf16*)(a.ws + WS_HM) + (size_t)MP * DFF, DFF, 0, (const bf16*)(a.ws + WS_W2_T), DFF, 0, DFF, D, SE); }
    pg8::Prob g{(const char*)(a.ws + WS_HM), (const char*)(a.ws + WS_W2_T), (size_t)256 * DFF * 2, 0, 0, (size_t)256 * DFF * 2, 0, DFF * 2, DFF * 2, DFF / 64};
    pg8::Order S; S.init(MP, D, F.G, (int)blockIdx.x, 1);
    EpiRes<1> E{a};
    pg8::gemm_phase<EpiRes<1>>(F.lds, g, S, E);
}
PHF phase13(const Args& a, const Frame& F, unsigned char* lds_raw) { ph_final(a, F); }

#define CAS __attribute__((address_space(4)))
#define GAS __attribute__((address_space(1)))
__device__ __forceinline__ void load_args(Args& a) {
    const CAS unsigned long long* kp = (const CAS unsigned long long*)__builtin_amdgcn_kernarg_segment_ptr();
    asm volatile("" : "+s"(kp));
    a.x_p = (const float*)(const GAS float*)kp[0];
    a.x_s = (const float*)(const GAS float*)kp[1];
    a.c_p = (const float*)(const GAS float*)kp[2];
    a.c_s = (const float*)(const GAS float*)kp[3];
    a.cache = (const float*)(const GAS float*)kp[4];
    a.ptab = (const int*)(const GAS int*)kp[5];
    a.st_win = (const float*)(const GAS float*)kp[6];
    a.st_conv = (const float*)(const GAS float*)kp[7];
    a.w_ada = (const float*)(const GAS float*)kp[8];
    a.b_ada = (const float*)(const GAS float*)kp[9];
    a.n1g = (const float*)(const GAS float*)kp[10];
    a.n2g = (const float*)(const GAS float*)kp[11];
    a.w_in = (const float*)(const GAS float*)kp[12];
    a.wck1 = (const float*)(const GAS float*)kp[13];
    a.wck2 = (const float*)(const GAS float*)kp[14];
    a.pek = (const float*)(const GAS float*)kp[15];
    a.wcv1 = (const float*)(const GAS float*)kp[16];
    a.wcv2 = (const float*)(const GAS float*)kp[17];
    a.pev = (const float*)(const GAS float*)kp[18];
    a.conv_w = (const float*)(const GAS float*)kp[19];
    a.conv_b = (const float*)(const GAS float*)kp[20];
    a.w_ap = (const float*)(const GAS float*)kp[21];
    a.w_cp = (const float*)(const GAS float*)kp[22];
    a.w_out = (const float*)(const GAS float*)kp[23];
    a.w_m1 = (const float*)(const GAS float*)kp[24];
    a.w_m2 = (const float*)(const GAS float*)kp[25];
    a.nfg = (const float*)(const GAS float*)kp[26];
    a.out = (float*)(GAS float*)kp[27]; a.ws = (unsigned char*)(GAS unsigned char*)kp[28]; a.ph_lo = 0; a.ph_hi = 0;
}

constexpr int N_PHASES = 15;
__global__ void __launch_bounds__(512, 2) nsa_fwd(Args a) {
    extern __shared__ __attribute__((aligned(16))) unsigned char lds_raw[];
    Frame F; F.lds = (LAS unsigned char*)lds_raw; F.tid = threadIdx.x; F.lane = F.tid & 63; F.wave = __builtin_amdgcn_readfirstlane(F.tid >> 6);
    F.G = gridDim.x; { const int bx = blockIdx.x; F.vcu = (F.G % 8 == 0) ? (bx % 8) * (F.G / 8) + bx / 8 : bx; }
    volatile LAS unsigned* MISC = (volatile LAS unsigned*)(F.lds + MISC_OFF);
    for (int u = F.tid; u < (LDS_BYTES - RING_BYTES) / 4; u += 512) ((LAS unsigned*)(F.lds + RING_BYTES))[u] = 0u;
    __syncthreads();
#if MK_PER_PHASE
#define GRID_BAR() do { } while (0)
#else
    XcdBarrier bar = xcd_barrier_post((unsigned*)(a.ws + WS_CTL) + 4096, MISC + 8);
#define GRID_BAR() xcd_barrier(bar)
#endif
    (void)MISC;
    const int lo = a.ph_lo, hi = a.ph_hi;
#ifdef DBG_ONLY
#define IN(k) ((k) == DBG_ONLY && lo <= (k) && (k) < hi)
#else
#define IN(k) (lo <= (k) && (k) < hi)
#endif
#define SEAM(k) do { if (IN(k) && IN((k) + 1)) GRID_BAR(); } while (0)
#define RUN(k) do { if (IN(k)) { Args la; load_args(la); phase##k(la, F, lds_raw); if (((DBG_REPEAT >> (k)) & 1) != 0) { __syncthreads(); phase##k(la, F, lds_raw); } } } while (0)
    RUN(0); SEAM(0);
    RUN(1); SEAM(1);
    RUN(2); SEAM(2);
    RUN(3); SEAM(3);
    RUN(4); SEAM(4);
    RUN(5); SEAM(5);
    RUN(6); SEAM(6);
#if !GATED
    RUN(7); SEAM(7);
#endif
    RUN(8); SEAM(8);
    RUN(9); SEAM(9);
    RUN(10); SEAM(10);
    RUN(11); SEAM(11);
    RUN(12); SEAM(12);
    RUN(13);
#undef IN
#undef SEAM
}

extern "C" void kernel_launch(void* const* d_in, const int* in_sizes, int n_in, void* d_out, int out_size, void* d_ws, size_t ws_size, hipStream_t stream) {
    static int grid = 0;
    if (grid == 0) {
        if (n_in != 27 || (size_t)out_size != OUT_END || ws_size < WS_END) { fprintf(stderr, "kernel_launch: unexpected shapes (n_in %d out %d ws %zu need %zu)\n", n_in, out_size, ws_size, (size_t)WS_END); grid = -1; return; }
        int dev = 0, cus = 0;
        if (hipGetDevice(&dev) != hipSuccess || hipDeviceGetAttribute(&cus, hipDeviceAttributeMultiprocessorCount, dev) != hipSuccess) { grid = -1; return; }
        if (hipFuncSetAttribute((const void*)nsa_fwd, hipFuncAttributeMaxDynamicSharedMemorySize, LDS_BYTES) != hipSuccess) { fprintf(stderr, "kernel_launch: hipFuncSetAttribute failed\n"); grid = -1; return; }
        (void)hipGetLastError();
        grid = cus;
    }
    if (grid < 0) return;
    if (hipMemsetAsync((char*)d_ws + WS_CTL, 0, CTL_BYTES, stream) != hipSuccess) { fprintf(stderr, "kernel_launch: memset failed\n"); return; }
    Args a{};
    const float** fp = (const float**)&a;
    for (int i = 0; i < 27; ++i) fp[i] = (const float*)d_in[i];
    a.out = (float*)d_out; a.ws = (unsigned char*)d_ws;
#if MK_PER_PHASE
    for (int p = 0; p < N_PHASES - 1; ++p) { a.ph_lo = p; a.ph_hi = p + 1; hipLaunchKernelGGL(nsa_fwd, dim3(grid), dim3(512), LDS_BYTES, stream, a); }
#else
    a.ph_lo = 0; a.ph_hi = N_PHASES; hipLaunchKernelGGL(nsa_fwd, dim3(grid), dim3(512), LDS_BYTES, stream, a);
#endif
    const hipError_t le = hipPeekAtLastError();
    if (le != hipSuccess) fprintf(stderr, "kernel_launch: launch failed: %s\n", hipGetErrorName(le));
}
```

```cpp
#include <hip/hip_runtime.h>
#include <cstdio>
#include <cstdint>

#ifndef MK_PER_PHASE
#define MK_PER_PHASE 0
#endif

#ifndef DBG_REPEAT
#define DBG_REPEAT 0
#endif
#ifndef DBG_CHECK
#define DBG_CHECK 0
#endif
#define GATED ((DBG_CHECK & 7) == 0)
#define LAS __attribute__((address_space(3)))
typedef unsigned short bf16;
typedef short bf16x8 __attribute__((ext_vector_type(8)));
typedef float f32x4 __attribute__((ext_vector_type(4)));
typedef float f32x2 __attribute__((ext_vector_type(2)));
typedef unsigned u32x4 __attribute__((ext_vector_type(4)));
typedef unsigned u32x2 __attribute__((ext_vector_type(2)));

constexpr int D = 2048, NBP = 4, SEQ = 2048, NBS = 8, DSQ = 8, PAST = 16384, PAGE = 128, NPAGES = 128;
constexpr int HD = 128, NH = 16, NKV = 4, GRP = 4;
constexpr int MP = NBP * SEQ;
constexpr int MS = NBS * DSQ;
constexpr int MR = MP + MS;
constexpr int MPAD = 8448;
constexpr int NIN = 15616;
constexpr int NIN_REAL = 15408;
constexpr int DFF = 8192;
constexpr int NBATCH = NBP + NBS;
constexpr float RMS_EPS = 1e-6f;
constexpr float SCALE = 0.08838834764831845f;
constexpr int PC_Q = 0, PC_KV = 2048, PC_KWIN = 4096, PC_VWIN = 4608, PC_U = 5120, PC_B = 7168, PC_C = 9216, PC_MA = 11264, PC_MC = 13312, PC_G = 15360;
constexpr int NCP = 127, NCS = 1023;
constexpr int NSP = 32, NSS = 257;

constexpr int PRS = 256;
#define PX(P_, r_, c_) ((P_) + ((size_t)((c_) >> 8) * MPAD + (size_t)(r_)) * PRS + ((c_) & 255))
constexpr size_t OUT_YP = 0, OUT_YS = OUT_YP + (size_t)MP * D, OUT_KVP = OUT_YS + (size_t)MS * D, OUT_KVS = OUT_KVP + (size_t)MP * 2048,
                 OUT_WINP = OUT_KVS + (size_t)MS * 2048, OUT_WINS = OUT_WINP + (size_t)NBP * 512 * 1024, OUT_CONVP = OUT_WINS + (size_t)NBS * 512 * 1024,
                 OUT_CONVS = OUT_CONVP + (size_t)NBP * 2 * D, OUT_END = OUT_CONVS + (size_t)NBS * 2 * D;

constexpr size_t al256(size_t x) { return (x + 255) & ~(size_t)255; }
constexpr size_t WS_CTL = 0, CTL_BYTES = 1u << 20;
constexpr size_t WS_ADA = WS_CTL + CTL_BYTES;
constexpr size_t WS_PEB = al256(WS_ADA + (size_t)NBATCH * 6 * D * 4);
constexpr size_t WS_PEBP = al256(WS_PEB + 2 * 128 * 4);
constexpr size_t WS_WIN_T = al256(WS_PEBP + 2 * 32 * 128 * 4);
constexpr size_t WS_WP_T = al256(WS_WIN_T + (size_t)NIN * D * 2);
constexpr size_t WS_WOUT_T = al256(WS_WP_T + (size_t)D * 2 * D * 2);
constexpr size_t WS_W1_T = al256(WS_WOUT_T + (size_t)D * D * 2);
constexpr size_t WS_W2_T = al256(WS_W1_T + (size_t)DFF * D * 2);
constexpr size_t WS_WC_T = al256(WS_W2_T + (size_t)D * DFF * 2);
constexpr size_t WS_H = al256(WS_WC_T + (size_t)512 * 2048 * 2);
constexpr size_t WS_P = al256(WS_H + (size_t)MPAD * D * 2);
constexpr size_t WS_KV6 = al256(WS_P + (size_t)MPAD * NIN * 2);
constexpr size_t WS_CA = al256(WS_KV6 + (size_t)6 * NBP * NKV * SEQ * HD * 2);
constexpr size_t WS_PARTS = al256(WS_CA + (size_t)2 * NBS * NKV * PAST * HD * 2);
constexpr size_t WS_PARTP = al256(WS_PARTS + (size_t)32768 * 512 * 4);
constexpr size_t WS_KCS = al256(WS_PARTP + (size_t)2048 * 512 * 4);
constexpr size_t WS_KCP = al256(WS_KCS + (size_t)2 * NBS * NKV * 1024 * HD * 4);
constexpr size_t WS_OCMP = al256(WS_KCP + (size_t)2 * NBP * NKV * 128 * HD * 4);
constexpr size_t WS_OSLC = al256(WS_OCMP + (size_t)MPAD * D * 4);
constexpr size_t WS_OWIN = al256(WS_OSLC + (size_t)MPAD * D * 4);
constexpr size_t WS_SELP = al256(WS_OWIN + (size_t)MPAD * D * 4);
constexpr size_t WS_SELS = al256(WS_SELP + (size_t)NBP * NKV * SEQ * 4);
constexpr size_t WS_A2 = al256(WS_SELS + (size_t)NBS * NKV * DSQ * 16 * 4);
constexpr size_t WS_MIX = al256(WS_A2 + (size_t)MPAD * 2 * D * 2);
constexpr size_t WS_X1 = al256(WS_MIX + (size_t)MPAD * D * 2);
constexpr size_t WS_HM = al256(WS_X1 + (size_t)MPAD * D * 4);
constexpr size_t WS_X2 = al256(WS_HM + (size_t)MPAD * DFF * 2);
constexpr size_t WS_DBGA = al256(WS_X2 + (size_t)MPAD * D * 4);
constexpr size_t WS_DBGB = al256(WS_DBGA + (size_t)MPAD * D * 4);
constexpr size_t WS_DBGC = al256(WS_DBGB + (size_t)MPAD * D * 4);
constexpr size_t WS_SELP2 = al256(WS_DBGC + (size_t)MPAD * D * 4);
constexpr size_t WS_PARTX = al256(WS_SELP2 + (size_t)NBP * NKV * SEQ * 4);
constexpr size_t WS_END = al256(WS_PARTX + (size_t)64 * 4 * 2 * 2048 * 4);
constexpr int CW_SG2 = 8192;

__device__ __forceinline__ float bf2f(bf16 b) { return __uint_as_float(((unsigned)b) << 16); }
__device__ __forceinline__ unsigned f2bf(float f) { unsigned u = __float_as_uint(f); return (u + 0x7fffu + ((u >> 16) & 1u)) >> 16; }
__device__ __forceinline__ unsigned pk2(float lo, float hi) { return f2bf(lo) | (f2bf(hi) << 16); }
__device__ __forceinline__ float lo_bf(unsigned w) { return __uint_as_float(w << 16); }
__device__ __forceinline__ float hi_bf(unsigned w) { return __uint_as_float(w & 0xffff0000u); }
__device__ __forceinline__ float sigmoidf_(float x) { return 1.0f / (1.0f + __expf(-x)); }
template <int C> __device__ __forceinline__ float dppf(float v) { return __int_as_float(__builtin_amdgcn_update_dpp(0, __float_as_int(v), C, 0xF, 0xF, true)); }
__device__ __forceinline__ float wave_sum(float v) {
    v += dppf<0xB1>(v); v += dppf<0x4E>(v); v += dppf<0x141>(v); v += dppf<0x140>(v);
    { auto r = __builtin_amdgcn_permlane16_swap(__float_as_uint(v), __float_as_uint(v), false, false); v = __uint_as_float(r[0]) + __uint_as_float(r[1]); }
    { auto r = __builtin_amdgcn_permlane32_swap(__float_as_uint(v), __float_as_uint(v), false, false); v = __uint_as_float(r[0]) + __uint_as_float(r[1]); }
    return v;
}
__device__ __forceinline__ float wave_max(float v) {
    v = fmaxf(v, dppf<0xB1>(v)); v = fmaxf(v, dppf<0x4E>(v)); v = fmaxf(v, dppf<0x141>(v)); v = fmaxf(v, dppf<0x140>(v));
    { auto r = __builtin_amdgcn_permlane16_swap(__float_as_uint(v), __float_as_uint(v), false, false); v = fmaxf(__uint_as_float(r[0]), __uint_as_float(r[1])); }
    { auto r = __builtin_amdgcn_permlane32_swap(__float_as_uint(v), __float_as_uint(v), false, false); v = fmaxf(__uint_as_float(r[0]), __uint_as_float(r[1])); }
    return v;
}
__device__ __forceinline__ float dpp_xor1(float v) { return __int_as_float(__builtin_amdgcn_update_dpp(0, __float_as_int(v), 0xB1, 0xF, 0xF, true)); }
__device__ __forceinline__ float dpp_xor2(float v) { return __int_as_float(__builtin_amdgcn_update_dpp(0, __float_as_int(v), 0x4E, 0xF, 0xF, true)); }
__device__ __forceinline__ int batch_of(int r) { return r < MP ? (r >> 11) : (NBP + (((r < MR ? r : MR - 1) - MP) >> 3)); }

namespace pg8 {
constexpr int BM = 256, BK = 64, HALF = 128, HTB = HALF * BK * 2, STAGE_BYTES = 8 * HTB, NXCD = 8, WGM = 8;
__host__ __device__ __forceinline__ int lds_byte(int r, int c) { const int st = (r >> 4) * 2 + (c >> 5), rr = r & 15, cc = c & 31, ob = rr * 64 + cc * 2; return st * 1024 + (ob ^ (((ob >> 9) & 1) << 5)); }
__host__ __device__ __forceinline__ void stage_rc(int b, int& R, int& C) { const int st = b / 1024, sb = b % 1024, swz = sb ^ (((sb >> 9) & 1) << 5); R = (st >> 1) * 16 + swz / 64; C = (st & 1) * 32 + (swz % 64) / 2; }
__host__ __device__ __forceinline__ int perm32(int rho) { const int n = rho >> 4, i = rho & 15; return 8 * (i >> 2) + 4 * n + (i & 3); }

struct Unit { int pm, pn, part; };
struct Prob { const char* A; const char* B; size_t a_tile, a_pn, a_part, b_tile, b_part; unsigned lda, ldb; int nt;
    __device__ __forceinline__ const char* a_ptr(const Unit& u) const { return A + (size_t)u.pm * a_tile + (size_t)u.pn * a_pn + (size_t)u.part * a_part; }
    __device__ __forceinline__ const char* b_ptr(const Unit& u) const { return B + (size_t)u.pn * b_tile + (size_t)u.part * b_part; } };

struct Order {
    int nM, nN, nwg, G, c, parts;
    __device__ void init(int M, int N, int G_, int c_, int parts_) { nM = M / BM; nN = N / BM; nwg = nM * nN; G = G_; c = c_; parts = parts_; }
    __device__ bool next(int i, Unit& u) const {
        const int ti = i / parts; u.part = i - ti * parts;
        const long L = (long)ti * G + c; if (L >= nwg) return false;
        int wgid = (int)L; { const int q = nwg / NXCD, r = nwg % NXCD, xcd = wgid % NXCD, off = wgid / NXCD; wgid = (xcd < r ? xcd * (q + 1) : r * (q + 1) + (xcd - r) * q) + off; }
        const int nig = WGM * nN, gid = wgid / nig, fm = gid * WGM, gsz = (nM - fm) < WGM ? (nM - fm) : WGM;
        u.pm = fm + ((wgid % nig) % gsz); u.pn = (wgid % nig) / gsz; return true;
    }
};
__device__ __forceinline__ unsigned cvt_pk_bf16(float lo, float hi) { unsigned r; asm volatile("v_cvt_pk_bf16_f32 %0, %1, %2" : "=v"(r) : "v"(lo), "v"(hi)); return r; }

template <class Epi, bool ALIGN_EPI = true, bool SP2 = true>
__device__ __forceinline__ void gemm_phase(LAS unsigned char* lds, const Prob g, const Order& S, const Epi& E) {
    const int tid = threadIdx.x, wid = __builtin_amdgcn_readfirstlane(tid >> 6), lane = tid & 63, wr = wid >> 2, wc = wid & 3, fr = lane & 15, fq = lane >> 4;
    const int nt = g.nt;
    unsigned voffA[2], voffB[2];
#pragma unroll
    for (int i = 0; i < 2; ++i) { int R, C; stage_rc(tid * 16 + i * 8192, R, C); const int Rb = Epi::PERM ? ((R & ~31) + perm32(R & 31)) : R;
        voffA[i] = (unsigned)R * g.lda + (unsigned)C * 2u; voffB[i] = (unsigned)Rb * g.ldb + (unsigned)C * 2u; }
    const size_t kstep = (size_t)(BK * 2);
    const size_t hstepA = (size_t)HALF * g.lda, hstepB = (size_t)HALF * g.ldb;
    const unsigned ldsw = (unsigned)wid * 1024u;
    const int aoff = lds_byte(wr * 64 + fr, fq * 8), boff = lds_byte(wc * 32 + fr, fq * 8);
#define PG8_SA(b, h) (((b) * 2 + (h)) * HTB)
#define PG8_SB(b, h) ((4 + (b) * 2 + (h)) * HTB)
#define PG8_STAGE(bufoff, gbase, voff) do { _Pragma("unroll") for (int _i = 0; _i < 2; ++_i) \
        __builtin_amdgcn_global_load_lds((const unsigned*)((const char*)(gbase) + (voff)[_i]), (LAS unsigned*)(lds + (bufoff) + ldsw + _i * 8192), 16, 0, 0); } while (0)
#define PG8_LDA(dst, b, h) do { _Pragma("unroll") for (int m = 0; m < 4; ++m) _Pragma("unroll") for (int k = 0; k < 2; ++k) dst[m][k] = *(const LAS bf16x8*)(lds + PG8_SA(b, h) + aoff + m * 2048 + k * 1024); } while (0)
#define PG8_LDB(dst, b, h) do { _Pragma("unroll") for (int n = 0; n < 2; ++n) _Pragma("unroll") for (int k = 0; k < 2; ++k) dst[n][k] = *(const LAS bf16x8*)(lds + PG8_SB(b, h) + boff + n * 2048 + k * 1024); } while (0)
#define PG8_MMA(ai, bj, At, Bt) do { __builtin_amdgcn_s_setprio(1); _Pragma("unroll") for (int m = 0; m < 4; ++m) _Pragma("unroll") for (int n = 0; n < 2; ++n) _Pragma("unroll") for (int k = 0; k < 2; ++k) \
        acc[ai][bj][m][n] = __builtin_amdgcn_mfma_f32_16x16x32_bf16(Bt[n][k], At[m][k], acc[ai][bj][m][n], 0, 0, 0); __builtin_amdgcn_s_setprio(0); } while (0)
#define PG8_WAIT_V(n) asm volatile("s_waitcnt vmcnt(" #n ")" ::: "memory")
#define PG8_WAIT_L(n) asm volatile("s_waitcnt lgkmcnt(" #n ")" ::: "memory")
#define PG8_BAR __builtin_amdgcn_s_barrier()
#define PG8_SCHED __builtin_amdgcn_sched_barrier(0)
    Unit cur, nxt; int ui = 0;
    if (!S.next(0, cur)) return;
    f32x4 acc[2][2][4][2];
#pragma unroll
    for (int a = 0; a < 2; ++a)
#pragma unroll
        for (int b = 0; b < 2; ++b)
#pragma unroll
            for (int m = 0; m < 4; ++m)
#pragma unroll
                for (int n = 0; n < 2; ++n) acc[a][b][m][n] = (f32x4){0.f, 0.f, 0.f, 0.f};
    bf16x8 At[4][2], B0[2][2], B1[2][2];
    const char* cA = g.a_ptr(cur); const char* cB = g.b_ptr(cur);
    if constexpr (SP2) {
        PG8_STAGE(PG8_SB(0, 0), cB, voffB); PG8_STAGE(PG8_SB(0, 1), cB + hstepB, voffB); PG8_STAGE(PG8_SA(0, 0), cA, voffA); PG8_STAGE(PG8_SA(0, 1), cA + hstepA, voffA);
        if (wr == 1) PG8_BAR;
        PG8_WAIT_V(2); PG8_BAR;
        PG8_STAGE(PG8_SB(1, 0), cB + kstep, voffB); PG8_STAGE(PG8_SA(1, 0), cA + kstep, voffA); PG8_STAGE(PG8_SB(1, 1), cB + hstepB + kstep, voffB);
        PG8_WAIT_V(6); PG8_BAR;
    } else {
        PG8_STAGE(PG8_SB(0, 0), cB, voffB); PG8_STAGE(PG8_SA(0, 0), cA, voffA); PG8_STAGE(PG8_SB(0, 1), cB + hstepB, voffB); PG8_STAGE(PG8_SA(0, 1), cA + hstepA, voffA);
        if (wr == 1) PG8_BAR;
        PG8_WAIT_V(4); PG8_BAR;
        PG8_STAGE(PG8_SB(1, 0), cB + kstep, voffB); PG8_STAGE(PG8_SA(1, 0), cA + kstep, voffA); PG8_STAGE(PG8_SB(1, 1), cB + hstepB + kstep, voffB);
        PG8_WAIT_V(6); PG8_BAR;
    }
    for (;;) {
        const bool has_next = S.next(ui + 1, nxt);
        const char* nA = has_next ? g.a_ptr(nxt) : cA; const char* nB = has_next ? g.b_ptr(nxt) : cB;
        for (int t = 0; t < nt; t += 2) {
            const bool last = (t == nt - 2);
            const char* a1 = cA + (size_t)(t + 1) * kstep;
            const char* a2 = last ? nA : cA + (size_t)(t + 2) * kstep; const char* b2 = last ? nB : cB + (size_t)(t + 2) * kstep;
            const char* a3 = a2 + kstep; const char* b3 = b2 + kstep;
            if constexpr (SP2) {
            PG8_LDB(B0, 0, 0); PG8_LDB(B1, 0, 1); PG8_SCHED; PG8_LDA(At, 0, 0); PG8_STAGE(PG8_SA(1, 1), a1 + hstepA, voffA);
            PG8_WAIT_V(8); PG8_WAIT_L(0); PG8_BAR; PG8_MMA(0, 0, At, B0); PG8_MMA(0, 1, At, B1); PG8_BAR; PG8_SCHED;
            PG8_LDA(At, 0, 1); PG8_STAGE(PG8_SB(0, 0), b2, voffB); PG8_STAGE(PG8_SB(0, 1), b2 + hstepB, voffB); PG8_STAGE(PG8_SA(0, 0), a2, voffA);
            PG8_WAIT_V(8); PG8_WAIT_L(0); PG8_BAR; PG8_MMA(1, 0, At, B0); PG8_MMA(1, 1, At, B1); PG8_BAR; PG8_SCHED;
            PG8_LDB(B0, 1, 0); PG8_LDB(B1, 1, 1); PG8_SCHED; PG8_LDA(At, 1, 0); PG8_STAGE(PG8_SA(0, 1), a2 + hstepA, voffA);
            PG8_WAIT_V(8); PG8_WAIT_L(0); PG8_BAR; PG8_MMA(0, 0, At, B0); PG8_MMA(0, 1, At, B1); PG8_BAR; PG8_SCHED;
            PG8_LDA(At, 1, 1); PG8_STAGE(PG8_SB(1, 0), b3, voffB); PG8_STAGE(PG8_SB(1, 1), b3 + hstepB, voffB); PG8_STAGE(PG8_SA(1, 0), a3, voffA);
            PG8_WAIT_V(8); PG8_WAIT_L(0); PG8_BAR; PG8_MMA(1, 0, At, B0); PG8_MMA(1, 1, At, B1); PG8_BAR; PG8_SCHED;
            } else {
            PG8_LDB(B0, 0, 0); PG8_SCHED; PG8_LDA(At, 0, 0); PG8_STAGE(PG8_SA(1, 1), a1 + hstepA, voffA);
            PG8_WAIT_L(8); PG8_BAR; PG8_WAIT_L(0); PG8_MMA(0, 0, At, B0); PG8_BAR; PG8_SCHED;
            PG8_LDB(B1, 0, 1); PG8_STAGE(PG8_SB(0, 0), b2, voffB);
            PG8_BAR; PG8_WAIT_L(0); PG8_MMA(0, 1, At, B1); PG8_BAR;
            PG8_LDA(At, 0, 1); PG8_STAGE(PG8_SA(0, 0), a2, voffA);
            PG8_BAR; PG8_WAIT_L(0); PG8_MMA(1, 0, At, B0); PG8_BAR; PG8_SCHED;
            PG8_STAGE(PG8_SB(0, 1), b2 + hstepB, voffB);
            PG8_WAIT_V(6); PG8_BAR; PG8_MMA(1, 1, At, B1); PG8_BAR;
            PG8_LDB(B0, 1, 0); PG8_SCHED; PG8_LDA(At, 1, 0); PG8_STAGE(PG8_SA(0, 1), a2 + hstepA, voffA);
            PG8_WAIT_L(8); PG8_BAR; PG8_WAIT_L(0); PG8_MMA(0, 0, At, B0); PG8_BAR; PG8_SCHED;
            PG8_LDB(B1, 1, 1); PG8_STAGE(PG8_SB(1, 0), b3, voffB);
            PG8_BAR; PG8_WAIT_L(0); PG8_MMA(0, 1, At, B1); PG8_BAR;
            PG8_LDA(At, 1, 1); PG8_STAGE(PG8_SA(1, 0), a3, voffA);
            PG8_BAR; PG8_WAIT_L(0); PG8_MMA(1, 0, At, B0); PG8_BAR; PG8_SCHED;
            PG8_STAGE(PG8_SB(1, 1), b3 + hstepB, voffB);
            PG8_WAIT_V(6); PG8_BAR; PG8_MMA(1, 1, At, B1); PG8_BAR;
            }
        }
        if constexpr (ALIGN_EPI) { if (wr == 0) PG8_BAR; }
        E(acc, cur, wr, wc, fr, fq);
        if (!has_next) break;
        if (!E.keep(cur)) {
#pragma unroll
        for (int a = 0; a < 2; ++a)
#pragma unroll
            for (int b = 0; b < 2; ++b)
#pragma unroll
                for (int m = 0; m < 4; ++m)
#pragma unroll
                    for (int n = 0; n < 2; ++n) acc[a][b][m][n] = (f32x4){0.f, 0.f, 0.f, 0.f};
        }
        cur = nxt; cA = nA; cB = nB; ++ui;
        if constexpr (ALIGN_EPI) { if (wr == 1) PG8_BAR; }
    }
    PG8_WAIT_V(0);
    if constexpr (!ALIGN_EPI) { if (wr == 0) PG8_BAR; }
    PG8_BAR;
#undef PG8_SA
#undef PG8_SB
#undef PG8_STAGE
#undef PG8_LDA
#undef PG8_LDB
#undef PG8_MMA
#undef PG8_WAIT_V
#undef PG8_WAIT_L
#undef PG8_BAR
#undef PG8_SCHED
}
}
using pg8::Unit;
typedef f32x4 AccT[2][2][4][2];

#define XB_TMO      128
#define XB_XCNT(j)  (256  + 64 * (j))
#define XB_XSUB(j)  (1280 + 64 * (j))
#define XB_XGEN(j)  (2304 + 64 * (j))
#define XB_TOP      3328
#define XB_TOPGEN   3392
#define XCD_BAR_WORDS 3456
#define XB_SPIN_CAP (1u << 18)
__device__ __forceinline__ unsigned xb_ld(unsigned* p)              { return __hip_atomic_load(p, __ATOMIC_RELAXED, __HIP_MEMORY_SCOPE_AGENT); }
__device__ __forceinline__ unsigned xb_add(unsigned* p, unsigned v) { return __hip_atomic_fetch_add(p, v, __ATOMIC_RELAXED, __HIP_MEMORY_SCOPE_AGENT); }
__device__ __forceinline__ unsigned xb_xcc_id() { return (unsigned)__builtin_amdgcn_s_getreg((3 << 11) | 20) & 0xFu; }
#define XB_SPIN(cond, bar) do { unsigned _sp = 0; while (cond) { __builtin_amdgcn_s_sleep(1); \
    if ((++_sp & 255u) == 0u) { if (xb_ld(&(bar)[XB_TMO])) break; if (_sp > XB_SPIN_CAP) { atomicAdd(&(bar)[XB_TMO], 1u); break; } } } } while (0)
struct XcdBarrier { unsigned* bar; unsigned x; volatile LAS unsigned* st; };
__device__ __forceinline__ XcdBarrier xcd_barrier_post(unsigned* bar, volatile LAS unsigned* st) {
    XcdBarrier b; b.bar = bar; b.x = xb_xcc_id(); b.st = st;
    if (threadIdx.x == 0) (void)xb_add(&bar[XB_XCNT(b.x)], 1u);
    return b;
}
__device__ __forceinline__ void xcd_barrier_complete(unsigned* bar, unsigned x, unsigned& nloc, unsigned& nx) {
    const unsigned G = gridDim.x * gridDim.y * gridDim.z;
    unsigned sum, cnt, mine, sp = 0u;
    for (;;) {
        sum = 0u; cnt = 0u; mine = 0u;
#pragma unroll
        for (unsigned j = 0; j < 16; ++j) { const unsigned c = xb_ld(&bar[XB_XCNT(j)]); sum += c; cnt += (c > 0u) ? 1u : 0u; mine = (j == x) ? c : mine; }
        if (sum == G) break;
        __builtin_amdgcn_s_sleep(1);
        if ((++sp & 255u) == 0u) { if (xb_ld(&bar[XB_TMO])) break; if (sp > XB_SPIN_CAP) { atomicAdd(&bar[XB_TMO], 1u); break; } }
    }
    nloc = mine > 0u ? mine : 1u; nx = cnt > 0u ? cnt : 1u;
}
__device__ __forceinline__ void xcd_barrier(const XcdBarrier& b) {
    asm volatile("s_waitcnt vmcnt(0)" ::: "memory");
    __syncthreads();
    if (threadIdx.x == 0) {
        unsigned* bar = b.bar;
        __builtin_amdgcn_s_waitcnt(0);
        unsigned nloc = b.st[0], nx = b.st[1];
        if (nloc == 0u) { xcd_barrier_complete(bar, b.x, nloc, nx); b.st[0] = nloc; b.st[1] = nx; }
        const unsigned old = xb_add(&bar[XB_XSUB(b.x)], 1u);
        const unsigned gen = old / nloc;
        if (old + 1u == (gen + 1u) * nloc) {
            __builtin_amdgcn_fence(__ATOMIC_RELEASE, "agent");
            asm volatile("s_waitcnt vmcnt(0)" ::: "memory");
            const unsigned og = xb_add(&bar[XB_TOP], 1u);
            const unsigned tg = og / nx;
            if (og + 1u == (tg + 1u) * nx) xb_add(&bar[XB_TOPGEN], 1u);
            else XB_SPIN(xb_ld(&bar[XB_TOPGEN]) == tg, bar);
            __builtin_amdgcn_fence(__ATOMIC_ACQUIRE, "agent");
            xb_add(&bar[XB_XGEN(b.x)], 1u);
            asm volatile("s_waitcnt vmcnt(0)" ::: "memory");
        } else {
            XB_SPIN(xb_ld(&bar[XB_XGEN(b.x)]) == gen, bar);
            __builtin_amdgcn_fence(__ATOMIC_ACQUIRE, "agent");
            asm volatile("s_waitcnt vmcnt(0)" ::: "memory");
        }
    }
    __syncthreads();
}

__device__ __forceinline__ void sb_arrive(unsigned* ctr) {
    asm volatile("s_waitcnt vmcnt(0)" ::: "memory");
    __syncthreads();
    if (threadIdx.x == 0) { __builtin_amdgcn_fence(__ATOMIC_RELEASE, "agent"); asm volatile("s_waitcnt vmcnt(0)" ::: "memory"); (void)__hip_atomic_fetch_add(ctr, 1u, __ATOMIC_RELAXED, __HIP_MEMORY_SCOPE_AGENT); }
}
__device__ __forceinline__ void sb_wait(unsigned* ctr, unsigned G) {
    if (threadIdx.x == 0) { unsigned sp = 0; while (__hip_atomic_load(ctr, __ATOMIC_RELAXED, __HIP_MEMORY_SCOPE_AGENT) < G) { __builtin_amdgcn_s_sleep(1); if (++sp > (1u << 22)) break; }
        __builtin_amdgcn_fence(__ATOMIC_ACQUIRE, "agent"); asm volatile("s_waitcnt vmcnt(0)" ::: "memory"); }
    __syncthreads();
}
constexpr int CW_SB0 = 8448, CW_SB3 = 8512;

struct Args {
    const float *x_p, *x_s, *c_p, *c_s, *cache; const int* ptab; const float *st_win, *st_conv, *w_ada, *b_ada, *n1g, *n2g, *w_in,
        *wck1, *wck2, *pek, *wcv1, *wcv2, *pev, *conv_w, *conv_b, *w_ap, *w_cp, *w_out, *w_m1, *w_m2, *nfg;
    float* out; unsigned char* ws; int ph_lo, ph_hi;
};
struct Frame { LAS unsigned char* lds; int tid, lane, wave, vcu, G; };
constexpr int LDS_BYTES = 147456;
constexpr int RING_BYTES = 131072, MISC_OFF = RING_BYTES + 320;

__device__ __forceinline__ const float* x_row(const Args& a, int r) { const int rr = r < MR ? r : MR - 1; return rr < MP ? a.x_p + (size_t)rr * D : a.x_s + (size_t)(rr - MP) * D; }

__device__ __forceinline__ void ph_ada(const Args& a, const Frame& F) {
    LAS float* sc = (LAS float*)F.lds;
    LAS float* red = sc + NBATCH * D;
    float* ada = (float*)(a.ws + WS_ADA);
    for (int i = F.tid; i < NBATCH * D; i += 512) { const int bi = i / D, k = i % D; const float v = bi < NBP ? a.c_p[bi * D + k] : a.c_s[(bi - NBP) * D + k]; sc[i] = v / (1.0f + __expf(-v)); }
    __syncthreads();
    const int cg = F.tid & 15, sl = F.tid >> 4;
    for (int ch = F.vcu; ch < 6 * D / 64; ch += F.G) {
        f32x4 acc[NBATCH];
#pragma unroll
        for (int b = 0; b < NBATCH; ++b) acc[b] = (f32x4){0.f, 0.f, 0.f, 0.f};
        const float* w = a.w_ada + (size_t)(sl * 64) * (6 * D) + ch * 64 + cg * 4;
#pragma unroll 1
        for (int k0 = 0; k0 < 64; k0 += 16) { f32x4 wv[16];
#pragma unroll
            for (int k = 0; k < 16; ++k) wv[k] = __builtin_nontemporal_load((const f32x4*)(w + (size_t)(k0 + k) * (6 * D)));
#pragma unroll
            for (int k = 0; k < 16; ++k)
#pragma unroll
                for (int b = 0; b < NBATCH; ++b) acc[b] += sc[b * D + sl * 64 + k0 + k] * wv[k]; }
#pragma unroll
        for (int b = 0; b < NBATCH; ++b)
#pragma unroll
            for (int e = 0; e < 4; ++e) { float v = acc[b][e]; v += __shfl_xor(v, 16); v += __shfl_xor(v, 32); acc[b][e] = v; }
        if (F.lane < 16) {
#pragma unroll
            for (int b = 0; b < NBATCH; ++b) *(LAS f32x4*)(red + (F.wave * NBATCH + b) * 64 + cg * 4) = acc[b]; }
        __syncthreads();
        for (int i = F.tid; i < NBATCH * 64; i += 512) { const int b = i >> 6, jj = i & 63; float s_ = 0.f;
#pragma unroll
            for (int q = 0; q < 8; ++q) s_ += red[(q * NBATCH + b) * 64 + jj];
            ada[(size_t)b * 6 * D + ch * 64 + jj] = s_ + a.b_ada[ch * 64 + jj]; }
        __syncthreads();
    }
    for (int u = F.G - 1 - F.vcu; u < 64; u += F.G) { const int kind = u >> 5, sl = u & 31;
        const float* pe = (kind ? a.pev : a.pek) + sl * 128; const float* w1 = (kind ? a.wcv1 : a.wck1) + (size_t)sl * 128 * 128;
        const int f = F.tid & 127, q = F.tid >> 7; float s_ = 0.f;
#pragma unroll 8
        for (int jj = q * 32; jj < (q + 1) * 32; ++jj) s_ += pe[jj] * w1[(size_t)jj * 128 + f];
        __syncthreads(); red[q * 128 + f] = s_; __syncthreads();
        if (F.tid < 128) ((float*)(a.ws + WS_PEBP))[(kind * 32 + sl) * 128 + f] = red[f] + red[128 + f] + red[256 + f] + red[384 + f];
    }
}
__device__ __forceinline__ void ph_peb_sum(const Args& a, const Frame& F) {
    if (F.vcu == 0 && F.tid < 256) { const float* pp = (const float*)(a.ws + WS_PEBP) + (F.tid >> 7) * 32 * 128 + (F.tid & 127); float s_ = 0.f;
#pragma unroll 8
        for (int sl = 0; sl < 32; ++sl) s_ += pp[sl * 128];
        ((float*)(a.ws + WS_PEB))[F.tid] = s_; }
}
struct TrD { const float* W; bf16* WT; int ldw, ldt, k0, ns, nd, nv; };
__device__ __forceinline__ void tr_load(const TrD& d, f32x4 (&tv)[8], int lane) {
    const int n4 = (lane & 7) * 4;
#pragma unroll
    for (int i = 0; i < 8; ++i) { const int kk = 8 * i + (lane >> 3); tv[i] = n4 < d.nv ? __builtin_nontemporal_load((const f32x4*)(d.W + (size_t)(d.k0 + kk) * d.ldw + d.ns + n4)) : (f32x4){0.f, 0.f, 0.f, 0.f}; }
}
__device__ __forceinline__ void tr_finish(const TrD& d, const f32x4 (&tv)[8], LAS float* scr, int lane) {
    const int n4 = (lane & 7) * 4;
#pragma unroll
    for (int i = 0; i < 8; ++i) { const int kk = 8 * i + (lane >> 3); *(LAS f32x4*)(scr + kk * 36 + n4) = tv[i]; }
    asm volatile("s_waitcnt lgkmcnt(0)" ::: "memory");
    const int c = lane & 7;
#pragma unroll
    for (int j = 0; j < 4; ++j) { const int n = (lane >> 3) + 8 * j; const LAS float* s = scr + (8 * c) * 36 + n;
        u32x4 o; o.x = pk2(s[0 * 36], s[1 * 36]); o.y = pk2(s[2 * 36], s[3 * 36]); o.z = pk2(s[4 * 36], s[5 * 36]); o.w = pk2(s[6 * 36], s[7 * 36]);
        *(u32x4*)(d.WT + (size_t)(d.nd + n) * d.ldt + d.k0 + 8 * c) = o; }
    asm volatile("s_waitcnt lgkmcnt(0)" ::: "memory");
}
__device__ __forceinline__ TrD tr_decode(const Args& a, int it) {
    constexpr int I_IN = 32 * (NIN / 32), I_P = 32 * 64, I_O = 32 * 64, I_1 = 32 * 256, I_2 = 128 * 64, I_C = 32 * 4;
    bf16* win_t = (bf16*)(a.ws + WS_WIN_T); bf16* wp_t = (bf16*)(a.ws + WS_WP_T); bf16* wout_t = (bf16*)(a.ws + WS_WOUT_T);
    bf16* w1_t = (bf16*)(a.ws + WS_W1_T); bf16* w2_t = (bf16*)(a.ws + WS_W2_T); bf16* wc_t = (bf16*)(a.ws + WS_WC_T);
    int r = it;
    if (r < I_IN) { const int nb = r % (NIN / 32), kb = r / (NIN / 32), nd = nb * 32; int ns, nv;
        if (nd < PC_U) { ns = nd; nv = 32; } else if (nd < PC_G) { ns = nd + 48; nv = 32; } else { ns = 5120 + (nd - PC_G); nv = 5168 - ns; nv = nv < 0 ? 0 : (nv > 32 ? 32 : nv); }
        return TrD{a.w_in, win_t, NIN_REAL, D, kb * 64, ns, nd, nv}; } r -= I_IN;
    if (r < I_P) return TrD{a.w_ap, wp_t, D, 2 * D, (r / 64) * 64, (r % 64) * 32, (r % 64) * 32, 32}; r -= I_P;
    if (r < I_P) return TrD{a.w_cp, wp_t + D, D, 2 * D, (r / 64) * 64, (r % 64) * 32, (r % 64) * 32, 32}; r -= I_P;
    if (r < I_O) return TrD{a.w_out, wout_t, D, D, (r / 64) * 64, (r % 64) * 32, (r % 64) * 32, 32}; r -= I_O;
    if (r < I_1) return TrD{a.w_m1, w1_t, DFF, D, (r / 256) * 64, (r % 256) * 32, (r % 256) * 32, 32}; r -= I_1;
    if (r < I_2) return TrD{a.w_m2, w2_t, D, DFF, (r / 64) * 64, (r % 64) * 32, (r % 64) * 32, 32}; r -= I_2;
    { const int q = r / I_C, rr = r % I_C, kind = q >> 1, s = q & 1;
      const float* w1 = (kind ? a.wcv1 : a.wck1) + (size_t)s * 2048 * 128;
      return TrD{w1, wc_t + (size_t)(kind * 256 + s * 128) * 2048, 128, 2048, (rr / 4) * 64, (rr % 4) * 32, (rr % 4) * 32, 32}; }
}
constexpr int TR_I_C = 32 * 4, TR_NIT = 32 * (NIN / 32) + 2 * 32 * 64 + 32 * 64 + 32 * 256 + 128 * 64 + 4 * TR_I_C, TR_NBIG = TR_NIT - 4 * TR_I_C;
constexpr int TR_EARLY = 3072;
__device__ __forceinline__ void ph_transpose_range(const Args& a, const Frame& F, int ibeg, int iend, int widx, int wcnt) {
    LAS float* scr = (LAS float*)F.lds + F.wave * (64 * 36);
    const int NGW = wcnt * 8; int it = ibeg + widx * 8 + F.wave; const int end = iend;
    if (it >= end) return;
    f32x4 ta[8], tb[8]; TrD da = tr_decode(a, it), db = da; tr_load(da, ta, F.lane);
#pragma unroll 1
    for (;;) {
        int itn = it + NGW; bool hn = itn < end;
        if (hn) { db = tr_decode(a, itn); tr_load(db, tb, F.lane); }
        tr_finish(da, ta, scr, F.lane);
        if (!hn) break;
        it = itn; itn = it + NGW; hn = itn < end;
        if (hn) { da = tr_decode(a, itn); tr_load(da, ta, F.lane); }
        tr_finish(db, tb, scr, F.lane);
        if (!hn) break;
        it = itn;
    }
}
__device__ __forceinline__ void ph_cache_cvt(const Args& a, const Frame& F) {
    const int gw = F.vcu * 8 + F.wave, NGW = F.G * 8; bf16* ca = (bf16*)(a.ws + WS_CA);
    const int l = F.lane, kind = l >> 5, kvh = (l & 31) >> 3, d0 = (l & 7) * 16;
    for (int it0 = gw; it0 < NBS * PAST; it0 += 2 * NGW) {
        f32x4 v[2][4]; bool ok[2];
#pragma unroll
        for (int u = 0; u < 2; ++u) { const int it = it0 + u * NGW; ok[u] = it < NBS * PAST; const int itc = ok[u] ? it : it0; const int b = itc >> 14, pos = itc & (PAST - 1);
            const int page = a.ptab[b * NPAGES + (pos >> 7)];
            const float* src = a.cache + ((size_t)page * PAGE + (pos & 127)) * 2048 + l * 16;
#pragma unroll
            for (int q = 0; q < 4; ++q) v[u][q] = __builtin_nontemporal_load((const f32x4*)src + q); }
#pragma unroll
        for (int u = 0; u < 2; ++u) if (ok[u]) { const int it = it0 + u * NGW; const int b = it >> 14, pos = it & (PAST - 1);
            u32x4 o0 = {pk2(v[u][0][0], v[u][0][1]), pk2(v[u][0][2], v[u][0][3]), pk2(v[u][1][0], v[u][1][1]), pk2(v[u][1][2], v[u][1][3])};
            u32x4 o1 = {pk2(v[u][2][0], v[u][2][1]), pk2(v[u][2][2], v[u][2][3]), pk2(v[u][3][0], v[u][3][1]), pk2(v[u][3][2], v[u][3][3])};
            bf16* dst = ca + ((((size_t)kind * NBS + b) * NKV + kvh) * PAST + pos) * HD + d0;
            *(u32x4*)dst = o0; *(u32x4*)(dst + 8) = o1; }
    }
}

template <int WHICH> __device__ __forceinline__ void ph_modnorm(const Args& a, const Frame& F) {
    const int gw = F.vcu * 8 + F.wave, NGW = F.G * 8; const float* ada = (const float*)(a.ws + WS_ADA);
    bf16* H = (bf16*)(a.ws + WS_H); const float* g = WHICH ? a.n2g : a.n1g;
#pragma unroll 1
    for (int r0 = gw * 4; r0 < MP; r0 += NGW * 4) {
        const int bi = r0 >> 11; const float* sh = ada + (size_t)bi * 6 * D + (WHICH ? 3 * D : 0); const float* sc = sh + D;
        f32x4 ga[8], sb[8];
#pragma unroll
        for (int j = 0; j < 8; ++j) { const int c = (F.lane + 64 * j) * 4; const f32x4 gg = *(const f32x4*)(g + c), s1 = *(const f32x4*)(sc + c); sb[j] = *(const f32x4*)(sh + c);
#pragma unroll
            for (int e = 0; e < 4; ++e) ga[j][e] = gg[e] * (1.0f + s1[e]); }
#pragma unroll 2
        for (int i = 0; i < 4; ++i) { const int r = r0 + i;
            const float* xr = WHICH ? (const float*)(a.ws + WS_X1) + (size_t)r * D : a.x_p + (size_t)r * D; bf16* orow = H + (size_t)r * D;
            f32x4 v[8]; float ss = 0.f;
#pragma unroll
            for (int j = 0; j < 8; ++j) { v[j] = *(const f32x4*)(xr + (F.lane + 64 * j) * 4); ss += (v[j][0] * v[j][0] + v[j][1] * v[j][1]) + (v[j][2] * v[j][2] + v[j][3] * v[j][3]); }
            const float rstd = rsqrtf(wave_sum(ss) * (1.0f / D) + RMS_EPS);
#pragma unroll
            for (int j = 0; j < 8; ++j) { const int c = (F.lane + 64 * j) * 4; f32x4 o;
#pragma unroll
                for (int e = 0; e < 4; ++e) o[e] = v[j][e] * rstd * ga[j][e] + sb[j][e];
                *(u32x2*)(orow + c) = (u32x2){pk2(o[0], o[1]), pk2(o[2], o[3])}; } }
    }
    for (int r = MP + gw; r < MPAD; r += NGW) {
        bf16* orow = H + (size_t)r * D;
        if (r >= MR) { for (int j = 0; j < 4; ++j) *(u32x4*)(orow + (F.lane + 64 * j) * 8) = (u32x4){0u, 0u, 0u, 0u}; continue; }
        const float* xr = WHICH ? (const float*)(a.ws + WS_X1) + (size_t)r * D : x_row(a, r);
        const int bi = batch_of(r); const float* sh = ada + (size_t)bi * 6 * D + (WHICH ? 3 * D : 0); const float* sc = sh + D;
        f32x4 v[8]; float ss = 0.f;
#pragma unroll
        for (int j = 0; j < 8; ++j) { v[j] = *(const f32x4*)(xr + (F.lane + 64 * j) * 4); ss += (v[j][0] * v[j][0] + v[j][1] * v[j][1]) + (v[j][2] * v[j][2] + v[j][3] * v[j][3]); }
        const float rstd = rsqrtf(wave_sum(ss) * (1.0f / D) + RMS_EPS);
#pragma unroll
        for (int j = 0; j < 8; ++j) { const int c = (F.lane + 64 * j) * 4; const f32x4 gg = *(const f32x4*)(g + c), s1 = *(const f32x4*)(sc + c), s0 = *(const f32x4*)(sh + c);
            f32x4 o;
#pragma unroll
            for (int e = 0; e < 4; ++e) o[e] = v[j][e] * rstd * gg[e] * (1.0f + s1[e]) + s0[e];
            *(u32x2*)(orow + c) = (u32x2){pk2(o[0], o[1]), pk2(o[2], o[3])}; }
    }
}

struct EpiIn {
    static constexpr bool PERM = true;
    bf16* P; bf16* KV6; float* out;
    __device__ __forceinline__ bool keep(const Unit&) const { return false; }
    __device__ __forceinline__ void operator()(AccT& acc, const Unit& u, int wr, int wc, int fr, int fq) const {
        const int row0 = u.pm * 256 + wr * 64 + fr, colt = u.pn * 256 + wc * 32 + 8 * fq;
#pragma unroll
        for (int ai = 0; ai < 2; ++ai)
#pragma unroll
            for (int m = 0; m < 4; ++m) { const int r = row0 + ai * 128 + m * 16;
#pragma unroll
                for (int bj = 0; bj < 2; ++bj) { const int c = colt + bj * 128; const f32x4 v0 = acc[ai][bj][m][0], v1 = acc[ai][bj][m][1];
                    u32x4 w; w.x = pg8::cvt_pk_bf16(v0[0], v0[1]); w.y = pg8::cvt_pk_bf16(v0[2], v0[3]); w.z = pg8::cvt_pk_bf16(v1[0], v1[1]); w.w = pg8::cvt_pk_bf16(v1[2], v1[3]);
                    *(u32x4*)PX(P, r, c) = w;
                    if (u.pn >= 8 && u.pn < 20 && r < MR) {
                        const int cc = c - PC_KV, kind = cc >> 9, kvh = (cc >> 7) & 3, d = cc & 127;
                        if (r < MP) { const int b = r >> 11, s = r & 2047;
                            *(u32x4*)(KV6 + ((((size_t)kind * NBP + b) * NKV + kvh) * SEQ + s) * HD + d) = w;
                            if (u.pn < 16) { float* o = out + OUT_KVP + (size_t)r * 2048 + cc; *(f32x4*)o = v0; *(f32x4*)(o + 4) = v1; }
                            else if (s >= SEQ - 512) { float* o = out + OUT_WINP + ((size_t)b * 512 + (s - (SEQ - 512))) * 1024 + (c - PC_KWIN); *(f32x4*)o = v0; *(f32x4*)(o + 4) = v1; }
                        } else { const int rs = r - MP, b = rs >> 3, s = rs & 7;
                            if (u.pn < 16) { float* o = out + OUT_KVS + (size_t)rs * 2048 + cc; *(f32x4*)o = v0; *(f32x4*)(o + 4) = v1; }
                            else { float* o = out + OUT_WINS + ((size_t)b * 512 + 504 + s) * 1024 + (c - PC_KWIN); *(f32x4*)o = v0; *(f32x4*)(o + 4) = v1; }
                        }
                    }
                } }
    }
};
struct EpiF32 {
    static constexpr bool PERM = false;
    float* C; int ldc;
    __device__ __forceinline__ bool keep(const Unit&) const { return false; }
    __device__ __forceinline__ void operator()(AccT& acc, const Unit& u, int wr, int wc, int fr, int fq) const {
        const int row0 = u.pm * 256 + wr * 64 + fr, col0 = u.pn * 256 + wc * 32 + 4 * fq;
#pragma unroll
        for (int ai = 0; ai < 2; ++ai)
#pragma unroll
            for (int m = 0; m < 4; ++m) { float* rowp = C + (size_t)(row0 + ai * 128 + m * 16) * ldc + col0;
#pragma unroll
                for (int bj = 0; bj < 2; ++bj)
#pragma unroll
                    for (int n = 0; n < 2; ++n) *(f32x4*)(rowp + bj * 128 + n * 16) = acc[ai][bj][m][n]; }
    }
};
struct EpiNull {
    static constexpr bool PERM = true;
    float* C;
    __device__ __forceinline__ bool keep(const Unit&) const { return false; }
    __device__ __forceinline__ void operator()(AccT& acc, const Unit& u, int wr, int wc, int fr, int fq) const {
        f32x4 t = acc[0][0][0][0];
#pragma unroll
        for (int ai = 0; ai < 2; ++ai)
#pragma unroll
            for (int bj = 0; bj < 2; ++bj)
#pragma unroll
                for (int m = 0; m < 4; ++m)
#pragma unroll
                    for (int n = 0; n < 2; ++n) t += acc[ai][bj][m][n];
        *(f32x4*)(C + ((size_t)(u.pm * 61 + u.pn) * 512 + threadIdx.x) * 4) = t; }
};
struct EpiProj {
    static constexpr bool PERM = true;
    const bf16* P; bf16* MIX;
    __device__ __forceinline__ bool keep(const Unit& u) const { return u.part == 0; }
    __device__ __forceinline__ void operator()(AccT& acc, const Unit& u, int wr, int wc, int fr, int fq) const {
        const int row0 = u.pm * 256 + wr * 64 + fr, colt = u.pn * 256 + wc * 32 + 8 * fq;
#pragma unroll
        for (int ai = 0; ai < 2; ++ai)
#pragma unroll
            for (int m = 0; m < 4; ++m) { const int r = row0 + ai * 128 + m * 16;
#pragma unroll
                for (int bj = 0; bj < 2; ++bj) { const int c = colt + bj * 128;
                    const u32x4 mc = *(const u32x4*)PX(P, r, PC_MC + c);
                    float sc[8];
#pragma unroll
                    for (int e = 0; e < 4; ++e) { sc[2 * e] = sigmoidf_(lo_bf(mc[e])); sc[2 * e + 1] = sigmoidf_(hi_bf(mc[e])); }
                    if (u.part == 0) {
                        const u32x4 ma = *(const u32x4*)PX(P, r, PC_MA + c);
#pragma unroll
                        for (int e = 0; e < 4; ++e) { const float s0 = sigmoidf_(lo_bf(ma[e])) / sc[2 * e], s1 = sigmoidf_(hi_bf(ma[e])) / sc[2 * e + 1];
                            acc[ai][bj][m][e >> 1][(e & 1) * 2] *= s0; acc[ai][bj][m][e >> 1][(e & 1) * 2 + 1] *= s1; }
                    } else {
                        const f32x4 v0 = acc[ai][bj][m][0], v1 = acc[ai][bj][m][1];
                        u32x4 w; w.x = pg8::cvt_pk_bf16(v0[0] * sc[0], v0[1] * sc[1]); w.y = pg8::cvt_pk_bf16(v0[2] * sc[2], v0[3] * sc[3]);
                        w.z = pg8::cvt_pk_bf16(v1[0] * sc[4], v1[1] * sc[5]); w.w = pg8::cvt_pk_bf16(v1[2] * sc[6], v1[3] * sc[7]);
                        *(u32x4*)(MIX + (size_t)r * D + c) = w;
                    }
                } }
    }
};
template <int WHICH> struct EpiRes {
    static constexpr bool PERM = false;
    Args a;
    __device__ __forceinline__ bool keep(const Unit&) const { return false; }
    __device__ __forceinline__ void operator()(AccT& acc, const Unit& u, int wr, int wc, int fr, int fq) const {
        const int row0 = u.pm * 256 + wr * 64 + fr, col0 = u.pn * 256 + wc * 32 + 4 * fq;
        const float* ada = (const float*)(a.ws + WS_ADA); float* O = (float*)(a.ws + (WHICH ? WS_X2 : WS_X1));
#pragma unroll
        for (int ai = 0; ai < 2; ++ai)
#pragma unroll
            for (int m = 0; m < 4; ++m) { const int r = row0 + ai * 128 + m * 16;
                const float* base = WHICH ? (const float*)(a.ws + WS_X1) + (size_t)r * D : x_row(a, r);
                const float* gate = ada + (size_t)batch_of(r) * 6 * D + (WHICH ? 5 * D : 2 * D);
#pragma unroll
                for (int bj = 0; bj < 2; ++bj)
#pragma unroll
                    for (int n = 0; n < 2; ++n) { const int c = col0 + bj * 128 + n * 16; const f32x4 bs = *(const f32x4*)(base + c), gg = *(const f32x4*)(gate + c);
                        *(f32x4*)(O + (size_t)r * D + c) = bs + gg * acc[ai][bj][m][n]; } }
    }
};
struct EpiRelu2 {
    static constexpr bool PERM = true;
    bf16* HM;
    __device__ __forceinline__ bool keep(const Unit&) const { return false; }
    __device__ __forceinline__ void operator()(AccT& acc, const Unit& u, int wr, int wc, int fr, int fq) const {
        const int row0 = u.pm * 256 + wr * 64 + fr, colt = u.pn * 256 + wc * 32 + 8 * fq;
#pragma unroll
        for (int ai = 0; ai < 2; ++ai)
#pragma unroll
            for (int m = 0; m < 4; ++m) { const int r = row0 + ai * 128 + m * 16;
#pragma unroll
                for (int bj = 0; bj < 2; ++bj) { const int c = colt + bj * 128; f32x4 v0 = acc[ai][bj][m][0], v1 = acc[ai][bj][m][1];
#pragma unroll
                    for (int e = 0; e < 4; ++e) { const float p = fmaxf(v0[e], 0.f), q = fmaxf(v1[e], 0.f); v0[e] = p * p; v1[e] = q * q; }
                    u32x4 w; w.x = pg8::cvt_pk_bf16(v0[0], v0[1]); w.y = pg8::cvt_pk_bf16(v0[2], v0[3]); w.z = pg8::cvt_pk_bf16(v1[0], v1[1]); w.w = pg8::cvt_pk_bf16(v1[2], v1[3]);
                    *(u32x4*)(HM + (size_t)r * DFF + c) = w; } }
    }
};


template <int NC, int NPART, class Epi>
__device__ __forceinline__ void small_gemm(const Frame& F, const bf16* A, int lda, int a_part, const bf16* Bt, int ldb, int b_part, int K, int N, const Epi& E) {
    constexpr int NF = (NC + 15) / 16, NCP = NF * 16;
    LAS float* red = (LAS float*)F.lds;
    const int lane = F.lane, lr = lane & 15, lk = lane >> 4, ks = K / 8, kbeg = F.wave * ks;
    for (int ch = F.vcu; ch < N / NC; ch += F.G) {
        const int n0 = ch * NC;
        f32x4 acc[NPART][4][NF];
#pragma unroll
        for (int p = 0; p < NPART; ++p)
#pragma unroll
            for (int m = 0; m < 4; ++m)
#pragma unroll
                for (int nf = 0; nf < NF; ++nf) acc[p][m][nf] = (f32x4){0.f, 0.f, 0.f, 0.f};
#pragma unroll
        for (int p = 0; p < NPART; ++p) {
            const bf16* Ap = A + p * a_part + (size_t)lr * lda + kbeg + lk * 8;
            const bf16* Bp[NF];
#pragma unroll
            for (int nf = 0; nf < NF; ++nf) { int col = nf * 16 + lr; col = col < NC ? col : NC - 1; Bp[nf] = Bt + p * b_part + (size_t)(n0 + col) * ldb + kbeg + lk * 8; }
#pragma unroll 4
            for (int k = 0; k < ks; k += 32) {
                bf16x8 af[4], bfr[NF];
#pragma unroll
                for (int m = 0; m < 4; ++m) af[m] = *(const bf16x8*)(Ap + (size_t)(m * 16) * lda + k);
#pragma unroll
                for (int nf = 0; nf < NF; ++nf) bfr[nf] = *(const bf16x8*)(Bp[nf] + k);
#pragma unroll
                for (int m = 0; m < 4; ++m)
#pragma unroll
                    for (int nf = 0; nf < NF; ++nf) acc[p][m][nf] = __builtin_amdgcn_mfma_f32_16x16x32_bf16(af[m], bfr[nf], acc[p][m][nf], 0, 0, 0);
            }
        }
        __syncthreads();
#pragma unroll
        for (int p = 0; p < NPART; ++p)
#pragma unroll
            for (int m = 0; m < 4; ++m)
#pragma unroll
                for (int nf = 0; nf < NF; ++nf)
#pragma unroll
                    for (int i = 0; i < 4; ++i) red[((F.wave * NPART + p) * 64 + m * 16 + lk * 4 + i) * NCP + nf * 16 + lr] = acc[p][m][nf][i];
        __syncthreads();
        for (int e = F.tid; e < 64 * NC; e += 512) { const int row = e / NC, col = e % NC; float v[NPART];
#pragma unroll
            for (int p = 0; p < NPART; ++p) { float sacc = 0.f;
#pragma unroll
                for (int w = 0; w < 8; ++w) sacc += red[((w * NPART + p) * 64 + row) * NCP + col];
                v[p] = sacc; }
            E(row, n0 + col, v); }
    }
    __syncthreads();
}
template <int NPART, class Epi>
__device__ __forceinline__ void small_gemm2(const Frame& F, const bf16* A, int lda, int a_part, const bf16* Bt, int ldb, int b_part, int K, const Epi& E, float* part, unsigned* cnt) {
    constexpr int NKG = 4, CW = 32;
    LAS float* red = (LAS float*)F.lds;
    const int lane = F.lane, lr = lane & 15, lk = lane >> 4;
    const int cb = F.vcu >> 2, kg = F.vcu & 3, n0 = cb * CW;
    const int KG = K / NKG, ks = KG / 8, kbeg = kg * KG + F.wave * ks;
    f32x4 acc[NPART][4][2];
#pragma unroll
    for (int p = 0; p < NPART; ++p)
#pragma unroll
        for (int m = 0; m < 4; ++m)
#pragma unroll
            for (int nf = 0; nf < 2; ++nf) acc[p][m][nf] = (f32x4){0.f, 0.f, 0.f, 0.f};
#pragma unroll
    for (int p = 0; p < NPART; ++p) {
        const bf16* Ap = A + p * a_part + (size_t)lr * lda + kbeg + lk * 8;
        const bf16* Bp = Bt + p * b_part + (size_t)(n0 + lr) * ldb + kbeg + lk * 8;
#pragma unroll 4
        for (int k = 0; k < ks; k += 32) {
            bf16x8 af[4], bfr[2];
#pragma unroll
            for (int m = 0; m < 4; ++m) af[m] = *(const bf16x8*)(Ap + (size_t)(m * 16) * lda + k);
#pragma unroll
            for (int nf = 0; nf < 2; ++nf) bfr[nf] = *(const bf16x8*)(Bp + (size_t)(nf * 16) * ldb + k);
#pragma unroll
            for (int m = 0; m < 4; ++m)
#pragma unroll
                for (int nf = 0; nf < 2; ++nf) acc[p][m][nf] = __builtin_amdgcn_mfma_f32_16x16x32_bf16(af[m], bfr[nf], acc[p][m][nf], 0, 0, 0);
        }
    }
    __syncthreads();
#pragma unroll
    for (int p = 0; p < NPART; ++p)
#pragma unroll
        for (int m = 0; m < 4; ++m)
#pragma unroll
            for (int nf = 0; nf < 2; ++nf)
#pragma unroll
                for (int i = 0; i < 4; ++i) red[((F.wave * NPART + p) * 64 + m * 16 + lk * 4 + i) * CW + nf * 16 + lr] = acc[p][m][nf][i];
    __syncthreads();
    const int e0 = F.tid * 4, row = e0 >> 5, col = e0 & 31;
    float* mine = part + (size_t)((cb * NKG + kg) * NPART) * 2048;
#pragma unroll
    for (int p = 0; p < NPART; ++p) { f32x4 sacc = {0.f, 0.f, 0.f, 0.f};
#pragma unroll
        for (int w = 0; w < 8; ++w) sacc += *(const LAS f32x4*)(red + ((w * NPART + p) * 64 + row) * CW + col);
        *(f32x4*)(mine + p * 2048 + e0) = sacc; }
    asm volatile("s_waitcnt vmcnt(0)" ::: "memory");
    __syncthreads();
    volatile LAS unsigned* flag = (volatile LAS unsigned*)(F.lds + RING_BYTES + 2048);
    if (F.tid == 0) {
        __builtin_amdgcn_fence(__ATOMIC_RELEASE, "agent");
        asm volatile("s_waitcnt vmcnt(0)" ::: "memory");
        const unsigned old = __hip_atomic_fetch_add(cnt + cb, 1u, __ATOMIC_RELAXED, __HIP_MEMORY_SCOPE_AGENT);
        const unsigned last = (old == (unsigned)(NKG - 1)) ? 1u : 0u;
        if (last) { __builtin_amdgcn_fence(__ATOMIC_ACQUIRE, "agent"); asm volatile("s_waitcnt vmcnt(0)" ::: "memory"); }
        *flag = last;
    }
    __syncthreads();
    if (*flag) {
        f32x4 tot[NPART];
#pragma unroll
        for (int p = 0; p < NPART; ++p) { tot[p] = (f32x4){0.f, 0.f, 0.f, 0.f};
#pragma unroll
            for (int q = 0; q < NKG; ++q) tot[p] += *(const f32x4*)(part + (size_t)((cb * NKG + q) * NPART + p) * 2048 + e0); }
#pragma unroll
        for (int i = 0; i < 4; ++i) { float v[NPART];
#pragma unroll
            for (int p = 0; p < NPART; ++p) v[p] = tot[p][i];
            E(row, n0 + col + i, v); }
    }
    __syncthreads();
}
struct SEpiProj { const bf16* P; bf16* MIX;
    __device__ __forceinline__ void operator()(int row, int c, const float (&v)[2]) const { const int r = MP + row;
        const float o = sigmoidf_(bf2f(*PX(P, r, PC_MA + c))) * v[0] + sigmoidf_(bf2f(*PX(P, r, PC_MC + c))) * v[1]; MIX[(size_t)r * D + c] = (bf16)f2bf(o); } };
template <int WHICH> struct SEpiRes { Args a;
    __device__ __forceinline__ void operator()(int row, int c, const float (&v)[1]) const { const int r = MP + row; const float* ada = (const float*)(a.ws + WS_ADA);
        const float base = WHICH ? ((const float*)(a.ws + WS_X1))[(size_t)r * D + c] : a.x_s[(size_t)row * D + c];
        const float gate = ada[(size_t)batch_of(r) * 6 * D + (WHICH ? 5 * D : 2 * D) + c];
        ((float*)(a.ws + (WHICH ? WS_X2 : WS_X1)))[(size_t)r * D + c] = base + gate * v[0]; } };
struct SEpiRelu2 { bf16* HM;
    __device__ __forceinline__ void operator()(int row, int c, const float (&v)[1]) const { const float p = fmaxf(v[0], 0.f); HM[(size_t)(MP + row) * DFF + c] = (bf16)f2bf(p * p); } };


__device__ __forceinline__ void ph_compress_prompt(const Args& a, const Frame& F) {
    LAS float* red = (LAS float*)F.lds;
    const bf16* kv6 = (const bf16*)(a.ws + WS_KV6); const bf16* wct = (const bf16*)(a.ws + WS_WC_T); float* partp = (float*)(a.ws + WS_PARTP);
    const int lane = F.lane, lr = lane & 15, lk = lane >> 4, kbeg = F.wave * 256;
#pragma unroll 1
    for (int unit = F.vcu; unit < 256; unit += F.G) {
        const int kind = unit >> 7, rb = (unit >> 2) & 31, cb = unit & 3;
        const bf16* Ap = kv6 + (size_t)kind * NBP * NKV * SEQ * HD + (size_t)(rb * 64 + lr) * 2048 + kbeg + lk * 8;
        const bf16* Bp = wct + (size_t)(kind * 256 + cb * 64 + lr) * 2048 + kbeg + lk * 8;
        f32x4 acc[4][4];
#pragma unroll
        for (int m = 0; m < 4; ++m)
#pragma unroll
            for (int n = 0; n < 4; ++n) acc[m][n] = (f32x4){0.f, 0.f, 0.f, 0.f};
#pragma unroll 2
        for (int k = 0; k < 256; k += 32) {
            bf16x8 af[4], bfr[4];
#pragma unroll
            for (int m = 0; m < 4; ++m) af[m] = *(const bf16x8*)(Ap + (size_t)(m * 16) * 2048 + k);
#pragma unroll
            for (int n = 0; n < 4; ++n) bfr[n] = *(const bf16x8*)(Bp + (size_t)(n * 16) * 2048 + k);
#pragma unroll
            for (int m = 0; m < 4; ++m)
#pragma unroll
                for (int n = 0; n < 4; ++n) acc[m][n] = __builtin_amdgcn_mfma_f32_16x16x32_bf16(af[m], bfr[n], acc[m][n], 0, 0, 0);
        }
        __syncthreads();
#pragma unroll
        for (int m = 0; m < 4; ++m)
#pragma unroll
            for (int n = 0; n < 4; ++n)
#pragma unroll
                for (int i = 0; i < 4; ++i) red[(F.wave * 64 + m * 16 + lk * 4 + i) * 64 + n * 16 + lr] = acc[m][n][i];
        __syncthreads();
        for (int e = F.tid; e < 64 * 64; e += 512) { const int row = e >> 6, col = e & 63; float sacc = 0.f;
#pragma unroll
            for (int w = 0; w < 8; ++w) sacc += red[(w * 64 + row) * 64 + col];
            partp[(size_t)(rb * 64 + row) * 512 + kind * 256 + cb * 64 + col] = sacc; }
    }
    __syncthreads();
}

__device__ __forceinline__ float gelu_tanh(float x) { const float u = 0.7978845608028654f * (x + 0.044715f * x * x * x); return 0.5f * x * (1.0f + tanhf(u)); }
template <int SAMPLE> __device__ __forceinline__ void ph_cmp_finish(const Args& a, const Frame& F, size_t out_off) {
    constexpr int NB = SAMPLE ? NBS : NBP, NCH = SAMPLE ? 1024 : 128, NC = NCH - 1;
    const float* part = (const float*)(a.ws + (SAMPLE ? WS_PARTS : WS_PARTP)); float* kc = (float*)(a.ws + out_off);
    const float* peb = (const float*)(a.ws + WS_PEB);
    LAS float* gl = (LAS float*)F.lds + F.wave * 128;
    const int gw = F.vcu * 8 + F.wave, NGW = F.G * 8;
    for (int it = gw; it < 2 * NB * NKV * NC; it += NGW) {
        const int c = it % NC, q = it / NC, kvh = q % NKV, b = (q / NKV) % NB, kind = q / (NKV * NB);
        const size_t row = ((size_t)b * NKV + kvh) * NCH + c;
        const float* w2 = kind ? a.wcv2 : a.wck2;
#pragma unroll
        for (int j = 0; j < 2; ++j) { const int f = F.lane + 64 * j;
            const float h = part[row * 512 + kind * 256 + f] + part[(row + 1) * 512 + kind * 256 + 128 + f] + peb[kind * 128 + f];
            gl[f] = gelu_tanh(h); }
        asm volatile("s_waitcnt lgkmcnt(0)" ::: "memory");
        float o0 = 0.f, o1 = 0.f;
        for (int f = 0; f < 128; ++f) { const float gv = gl[f]; o0 += gv * w2[f * 128 + F.lane]; o1 += gv * w2[f * 128 + 64 + F.lane]; }
        float* dst = kc + ((((size_t)kind * NB + b) * NKV + kvh) * NCH + c) * HD;
        dst[F.lane] = o0; dst[64 + F.lane] = o1;
        asm volatile("s_waitcnt lgkmcnt(0)" ::: "memory");
    }
}

struct WaveAtt { LAS float* qs; LAS float* pb; float o[4][2]; float m[4]; float l[4]; };
__device__ __forceinline__ void att_load_q(const bf16* P, int r, int kvh, WaveAtt& W, int lane) {
#pragma unroll
    for (int j = 0; j < 4; ++j) { const unsigned w = *(const unsigned*)PX(P, r, PC_Q + kvh * 512 + (lane + 64 * j) * 2);   W.qs[(lane + 64 * j) * 2] = lo_bf(w); W.qs[(lane + 64 * j) * 2 + 1] = hi_bf(w); }
    asm volatile("s_waitcnt lgkmcnt(0)" ::: "memory");
}
__device__ __forceinline__ void att_init(WaveAtt& W) {
#pragma unroll
    for (int g = 0; g < 4; ++g) { W.o[g][0] = 0.f; W.o[g][1] = 0.f; W.m[g] = -1e30f; W.l[g] = 0.f; }
}
template <class T> __device__ __forceinline__ void att_dot4(const T* krow, const WaveAtt& W, float (&s)[4]) {
    s[0] = s[1] = s[2] = s[3] = 0.f;
#pragma unroll 8
    for (int d = 0; d < 128; d += 8) {
        float kv[8];
        if constexpr (sizeof(T) == 4) { const f32x4 a0 = *(const f32x4*)((const float*)krow + d), a1 = *(const f32x4*)((const float*)krow + d + 4);
            kv[0] = a0[0]; kv[1] = a0[1]; kv[2] = a0[2]; kv[3] = a0[3]; kv[4] = a1[0]; kv[5] = a1[1]; kv[6] = a1[2]; kv[7] = a1[3]; }
        else { const u32x4 a0 = *(const u32x4*)((const bf16*)krow + d);
#pragma unroll
            for (int e = 0; e < 4; ++e) { kv[2 * e] = lo_bf(a0[e]); kv[2 * e + 1] = hi_bf(a0[e]); } }
#pragma unroll
        for (int g = 0; g < 4; ++g) { const f32x4 q0 = *(const LAS f32x4*)(W.qs + g * 128 + d), q1 = *(const LAS f32x4*)(W.qs + g * 128 + d + 4);
            s[g] += (kv[0] * q0[0] + kv[1] * q0[1]) + (kv[2] * q0[2] + kv[3] * q0[3]) + (kv[4] * q1[0] + kv[5] * q1[1]) + (kv[6] * q1[2] + kv[7] * q1[3]); }
    }
}
#ifndef PVB
#define PVB 16
#endif
#ifndef PVS
#define PVS 32
#endif
template <class T, int NB> __device__ __forceinline__ void att_pv_load(const T* V, size_t vstride, int jb, int lane, const T* Valt, int nalt, float (&v0)[NB], float (&v1)[NB]) {
    const T* vb = V + (size_t)(jb * NB) * vstride;
#pragma unroll
    for (int u = 0; u < NB; ++u) { const T* vr = (jb == 0 && u < nalt) ? Valt + (size_t)u * vstride : vb + (size_t)u * vstride;
        if constexpr (sizeof(T) == 4) { const f32x2 v = *(const f32x2*)((const float*)vr + 2 * lane); v0[u] = v[0]; v1[u] = v[1]; }
        else { const unsigned w = *(const unsigned*)((const bf16*)vr + 2 * lane); v0[u] = lo_bf(w); v1[u] = hi_bf(w); } }
}
template <int NB> __device__ __forceinline__ void att_pv_fma(int jb, int nk, const float (&v0)[NB], const float (&v1)[NB], WaveAtt& W) {
#pragma unroll
    for (int u = 0; u < NB; ++u) { f32x4 p = *(const LAS f32x4*)(W.pb + (jb * NB + u) * 4); if (jb * NB + u >= nk) p = (f32x4){0.f, 0.f, 0.f, 0.f};
#pragma unroll
        for (int g = 0; g < 4; ++g) { W.o[g][0] += p[g] * v0[u]; W.o[g][1] += p[g] * v1[u]; }
        if ((u & 7) == 7) __builtin_amdgcn_sched_barrier(0); }
}
template <class T> __device__ __forceinline__ void att_pv(const T* V, size_t vstride, int nk, WaveAtt& W, int lane, const T* Valt = nullptr, int nalt = 0) {
    const int nkb = (nk + PVB - 1) / PVB;
#pragma unroll 1
    for (int jb = 0; jb < nkb; ++jb) { float v0[PVB], v1[PVB]; att_pv_load<T, PVB>(V, vstride, jb, lane, Valt, nalt, v0, v1); att_pv_fma<PVB>(jb, nk, v0, v1, W); }
}
template <class T, int PVS_ = PVB> __device__ __forceinline__ void att_segment(const T* K, size_t kstride, const T* V, size_t vstride, int nk, bool valid, WaveAtt& W, int lane, const T* Kalt = nullptr, const T* Valt = nullptr, int nalt = 0) {
    float s[4]; float v0[PVS_], v1[PVS_];
    att_pv_load<T, PVS_>(V, vstride, 0, lane, Valt, nalt, v0, v1);
    if (valid) att_dot4<T>((lane < nalt ? Kalt : K) + (size_t)lane * kstride, W, s); else { s[0] = s[1] = s[2] = s[3] = 0.f; }
    f32x4 p;
#pragma unroll
    for (int g = 0; g < 4; ++g) { const float sv = valid ? s[g] * SCALE : -__builtin_inff();
        const float mx = wave_max(sv), mn = fmaxf(W.m[g], mx), alpha = __expf(W.m[g] - mn), pv = __expf(sv - mn);
        W.l[g] = W.l[g] * alpha + wave_sum(pv); W.o[g][0] *= alpha; W.o[g][1] *= alpha; W.m[g] = mn; p[g] = pv; }
    *(LAS f32x4*)(W.pb + lane * 4) = p;
    asm volatile("s_waitcnt lgkmcnt(0)" ::: "memory");
    att_pv_fma<PVS_>(0, nk, v0, v1, W);
    const int nkb = (nk + PVS_ - 1) / PVS_;
#pragma unroll 1
    for (int jb = 1; jb < nkb; ++jb) { att_pv_load<T, PVS_>(V, vstride, jb, lane, Valt, nalt, v0, v1); att_pv_fma<PVS_>(jb, nk, v0, v1, W); }
    asm volatile("s_waitcnt lgkmcnt(0)" ::: "memory");
}
__device__ __forceinline__ void att_store(float* O, int r, int kvh, const WaveAtt& W, int lane, bool normalise) {
#pragma unroll
    for (int g = 0; g < 4; ++g) { const float inv = normalise ? (W.l[g] > 0.f ? 1.0f / W.l[g] : 0.f) : 1.0f;
        *(f32x2*)(O + (size_t)r * D + (kvh * 4 + g) * 128 + 2 * lane) = (f32x2){W.o[g][0] * inv, W.o[g][1] * inv}; }
}

template <int SAMPLE> struct KcT { typedef float type; };
template <> struct KcT<1> { typedef bf16 type; };
template <int SAMPLE> __device__ __forceinline__ void ph_cmp_attend(const Args& a, const Frame& F, size_t oc_off = WS_OCMP, size_t sel_off = (SAMPLE ? WS_SELS : WS_SELP)) {
    constexpr int NSEG = SAMPLE ? 16 : 2, NCH = SAMPLE ? 1024 : 128, NC = NCH - 1, NB = SAMPLE ? NBS : NBP, SQ = SAMPLE ? DSQ : SEQ;
    using KT = typename KcT<SAMPLE>::type;
    const bf16* P = (const bf16*)(a.ws + WS_P); const KT* kcb = (const KT*)(a.ws + (SAMPLE ? WS_KCS : WS_KCP));
    float* OC = (float*)(a.ws + oc_off);
    LAS float* wl = (LAS float*)F.lds + F.wave * 4096;
    WaveAtt W; W.qs = wl; W.pb = wl + 512; LAS float* pg = wl + 768 + 4; LAS float* scl = wl + 768 + 1040;
    const int gw = F.vcu * 8 + F.wave, NGW = F.G * 8, lane = F.lane;
#pragma unroll 1
    for (int it = gw; it < NB * NKV * SQ; it += NGW) {
        const int s = it % SQ, kvh = (it / SQ) % NKV, b = it / (SQ * NKV);
        const int r = SAMPLE ? MP + b * DSQ + s : b * SEQ + s, pos = SAMPLE ? PAST + s : s;
        const int nvis = pos >= 31 ? ((pos - 31) / 16 + 1 < NC ? (pos - 31) / 16 + 1 : NC) : 0;
        att_load_q(P, r, kvh, W, lane);
        const KT* Kc = kcb + (((size_t)0 * NB + b) * NKV + kvh) * NCH * HD; const KT* Vc = kcb + (((size_t)1 * NB + b) * NKV + kvh) * NCH * HD;
        float mx[4] = {-1e30f, -1e30f, -1e30f, -1e30f}, ls[4] = {0.f, 0.f, 0.f, 0.f};
        const int nseg = (nvis + 63) >> 6;
#pragma unroll 1
        for (int sg = 0; sg < nseg; ++sg) { const int c = sg * 64 + lane; const bool valid = c < nvis; float t[4];
            if (valid) att_dot4<KT>(Kc + (size_t)c * HD, W, t); else { t[0] = t[1] = t[2] = t[3] = 0.f; }
#pragma unroll
            for (int g = 0; g < 4; ++g) { const float sv = valid ? t[g] * SCALE : -__builtin_inff(); const float m2 = fmaxf(mx[g], wave_max(sv));
                ls[g] = ls[g] * __expf(mx[g] - m2) + wave_sum(__expf(sv - m2)); mx[g] = m2; } }
#pragma unroll
        for (int g = 0; g < 4; ++g) ls[g] = ls[g] > 0.f ? 1.0f / ls[g] : 0.f;
        att_init(W);
        for (int i = lane; i < NSEG * 64; i += 64) pg[i] = 0.f;
#pragma unroll 1
        for (int sg = 0; sg < nseg; ++sg) { const int c = sg * 64 + lane; const bool valid = c < nvis; float t[4];
            if (valid) att_dot4<KT>(Kc + (size_t)c * HD, W, t); else { t[0] = t[1] = t[2] = t[3] = 0.f; }
            f32x4 p; float pgs = 0.f;
#pragma unroll
            for (int g = 0; g < 4; ++g) { p[g] = valid ? __expf(t[g] * SCALE - mx[g]) * ls[g] : 0.f; pgs += p[g]; }
            pg[c] = pgs;
            const int base = sg * 64; int nk = nvis - base; nk = nk > 64 ? 64 : nk;
            *(LAS f32x4*)(W.pb + lane * 4) = p; asm volatile("s_waitcnt lgkmcnt(0)" ::: "memory");
            att_pv<KT>(Vc + (size_t)base * HD, HD, nk, W, lane); asm volatile("s_waitcnt lgkmcnt(0)" ::: "memory"); }
        att_store(OC, r, kvh, W, lane, false);
        if (lane == 0) { pg[-1] = 0.f; pg[NSEG * 64] = 0.f; }
        asm volatile("s_waitcnt lgkmcnt(0)" ::: "memory");
        const int cur = pos >> 6;
        if constexpr (!SAMPLE) {
            float val = -__builtin_inff();
            if (lane < NSP) { const int n = lane; const float scv = pg[4 * n - 1] + 2.0f * (pg[4 * n] + pg[4 * n + 1] + pg[4 * n + 2]) + pg[4 * n + 3];
                const bool vld = n <= cur, forced = (n == 0) || (n > cur - 2); val = vld ? (forced ? __builtin_inff() : scv) : -__builtin_inff(); }
            int rank = 0;
            for (int k = 0; k < NSP; ++k) { const float vk = __shfl(val, k); rank += (vk > val || (vk == val && k < lane)) ? 1 : 0; }
            const bool sel = lane < NSP && rank < 16 && val > -__builtin_inff();
            const unsigned long long bm = __ballot(sel);
            if (lane == 0) ((unsigned*)(a.ws + sel_off))[((size_t)b * NKV + kvh) * SEQ + s] = (unsigned)bm;
        } else {
            for (int n = lane; n < 256; n += 64) scl[n] = (n >= 1 && n <= 254) ? pg[4 * n - 1] + 2.0f * (pg[4 * n] + pg[4 * n + 1] + pg[4 * n + 2]) + pg[4 * n + 3] : -__builtin_inff();
            asm volatile("s_waitcnt lgkmcnt(0)" ::: "memory");
            unsigned* selw = (unsigned*)(a.ws + sel_off) + (((size_t)b * NKV + kvh) * DSQ + s) * 16;
#pragma unroll
            for (int i = 0; i < 4; ++i) { const int n = lane + 64 * i; const float val = scl[n]; int rank = 0;
#pragma unroll 2
                for (int k = 1; k <= 254; ++k) { const float vk = scl[k]; rank += (vk > val || (vk == val && k < n)) ? 1 : 0; }
                const bool sel = (n >= 1 && n <= 254 && rank < 13) || n == 0 || n == 255;
                const unsigned long long bm = __ballot(sel);
                if (lane == 0) { selw[2 * i] = (unsigned)bm; selw[2 * i + 1] = (unsigned)(bm >> 32); } }
            if (lane == 0) selw[8] = 1u;
        }
        asm volatile("s_waitcnt lgkmcnt(0)" ::: "memory");
    }
}
template <int SAMPLE> __device__ __forceinline__ void ph_slc_attend(const Args& a, const Frame& F, size_t out_off = WS_OSLC) {
    constexpr int NB = SAMPLE ? NBS : NBP, SQ = SAMPLE ? DSQ : SEQ;
    const bf16* P = (const bf16*)(a.ws + WS_P); const bf16* KV6 = (const bf16*)(a.ws + WS_KV6); float* OS = (float*)(a.ws + out_off);
    LAS float* wl = (LAS float*)F.lds + F.wave * 1024; WaveAtt W; W.qs = wl; W.pb = wl + 512;
    const int gw = F.vcu * 8 + F.wave, NGW = F.G * 8, lane = F.lane;
#pragma unroll 1
    for (int it = gw; it < NB * NKV * SQ; it += NGW) {
        const int s = it % SQ, kvh = (it / SQ) % NKV, b = it / (SQ * NKV);
        const int r = SAMPLE ? MP + b * DSQ + s : b * SEQ + s;
        att_load_q(P, r, kvh, W, lane); att_init(W);
        if constexpr (!SAMPLE) {
            const unsigned mask = ((const unsigned*)(a.ws + WS_SELP))[((size_t)b * NKV + kvh) * SEQ + s];
            const bf16* Kb = KV6 + (((size_t)2 * NBP + b) * NKV + kvh) * SEQ * HD; const bf16* Vb = KV6 + (((size_t)3 * NBP + b) * NKV + kvh) * SEQ * HD;
#pragma unroll 1
            for (int n = 0; n < NSP; ++n) if ((mask >> n) & 1u) { const int k0 = n * 64; int nk = s - k0 + 1; nk = nk > 64 ? 64 : nk; if (nk <= 0) continue;
                att_segment<bf16>(Kb + (size_t)k0 * HD, HD, Vb + (size_t)k0 * HD, HD, nk, lane < nk, W, lane); }
        } else {
            const unsigned* selw = (const unsigned*)(a.ws + WS_SELS) + (((size_t)b * NKV + kvh) * DSQ + s) * 16;
#pragma unroll 1
            for (int n = 0; n < 256; ++n) if ((selw[n >> 5] >> (n & 31)) & 1u) {
                const int page = a.ptab[b * NPAGES + (n >> 1)];
                const float* base = a.cache + ((size_t)page * PAGE + (n & 1) * 64) * 2048 + kvh * HD;
                att_segment<float>(base + 2 * 512, 2048, base + 3 * 512, 2048, 64, true, W, lane); }
            att_segment<bf16>(PX(P, MP + b * DSQ, PC_KV + 2 * 512 + kvh * HD), PRS, PX(P, MP + b * DSQ, PC_KV + 3 * 512 + kvh * HD), PRS, s + 1, lane <= s, W, lane);
        }
        att_store(OS, r, kvh, W, lane, true);
    }
}
template <int SAMPLE> __device__ __forceinline__ void ph_win_attend(const Args& a, const Frame& F, size_t out_off = WS_OWIN) {
    constexpr int NB = SAMPLE ? NBS : NBP, SQ = SAMPLE ? DSQ : SEQ;
    const bf16* P = (const bf16*)(a.ws + WS_P); const bf16* KV6 = (const bf16*)(a.ws + WS_KV6); float* OW = (float*)(a.ws + out_off);
    LAS float* wl = (LAS float*)F.lds + F.wave * 1024; WaveAtt W; W.qs = wl; W.pb = wl + 512;
    const int gw = F.vcu * 8 + F.wave, NGW = F.G * 8, lane = F.lane;
#pragma unroll 1
    for (int it = gw; it < NB * NKV * SQ; it += NGW) {
        const int s = it % SQ, kvh = (it / SQ) % NKV, b = it / (SQ * NKV);
        const int r = SAMPLE ? MP + b * DSQ + s : b * SEQ + s;
        att_load_q(P, r, kvh, W, lane); att_init(W);
        if constexpr (!SAMPLE) {
            const bf16* Kb = KV6 + (((size_t)4 * NBP + b) * NKV + kvh) * SEQ * HD; const bf16* Vb = KV6 + (((size_t)5 * NBP + b) * NKV + kvh) * SEQ * HD;
            const int lo = s - 511 > 0 ? s - 511 : 0;
#pragma unroll 1
            for (int k0 = (lo >> 6) << 6; k0 <= s; k0 += 64) { int nk = s - k0 + 1; nk = nk > 64 ? 64 : nk; const int kp = k0 + lane;
                att_segment<bf16>(Kb + (size_t)k0 * HD, HD, Vb + (size_t)k0 * HD, HD, nk, kp >= lo && kp <= s, W, lane); }
        } else {
            const float* st = a.st_win + (size_t)b * 512 * 1024 + kvh * HD;
#pragma unroll 1
            for (int i0 = 0; i0 < 512; i0 += 64) { const int i = i0 + lane;
                att_segment<float>(st + (size_t)i0 * 1024, 1024, st + (size_t)i0 * 1024 + 512, 1024, 64, i > s, W, lane); }
            att_segment<bf16>(PX(P, MP + b * DSQ, PC_KWIN + kvh * HD), PRS, PX(P, MP + b * DSQ, PC_VWIN + kvh * HD), PRS, s + 1, lane <= s, W, lane);
        }
        att_store(OW, r, kvh, W, lane, true);
    }
    if constexpr (SAMPLE) {
        float* ow = a.out + OUT_WINS;
        for (size_t i = (size_t)(F.vcu * 512 + F.tid); i < (size_t)NBS * 504 * 256; i += (size_t)F.G * 512) { const size_t b = i / (504 * 256), rem = i % (504 * 256);
            *(f32x4*)(ow + b * 512 * 1024 + rem * 4) = *(const f32x4*)(a.st_win + b * 512 * 1024 + 8 * 1024 + rem * 4); }
    }
}


namespace fa {
constexpr int NW = 8, QBLK = 32, KVBLK = 64, QB = NW * QBLK, DH = 128;
constexpr int SHM_V = KVBLK * DH * 2, SHM_K = KVBLK * DH * 2;
constexpr int FA_LDS_BYTES = 2 * SHM_V + 2 * SHM_K + NW * 64 * 4;
constexpr int FA_STG_OFF = 2 * SHM_V + 2 * SHM_K, FA_WS_OFF = 131072 + 4096, OSA = 2 * D;
constexpr float THR = 8.f;
constexpr int QS = PRS;
constexpr int OS = D;
typedef float f32x16 __attribute__((ext_vector_type(16)));
typedef short s16x4 __attribute__((ext_vector_type(4)));
#define KSWZ(row, colB) ((row) * 256 + ((colB) ^ (((row) & 7) << 4)))
#define SBAR() __builtin_amdgcn_sched_barrier(0)
__device__ __forceinline__ int v_st(int k, int c) { const int kk = (k & ~0xC) | ((k & 4) << 1) | ((k & 8) >> 1); return ((kk >> 3) * 4 + (c >> 5)) * 512 + ((kk & 7) * 32 + (c & 31)) * 2; }
__device__ __forceinline__ int v_rd_base(int lane) { return ((lane & 3) << 3) | (((lane >> 2) & 3) << 6) | (((lane >> 4) & 1) << 5) | (((lane >> 5) & 1) << 8); }
constexpr int v_rd_off(int d0, int ks, int half) { return d0 * 512 + ks * 4096 + half * 2048; }
__device__ __forceinline__ int crow(int r, int hi) { return (r & 3) + 8 * (r >> 2) + 4 * hi; }
__device__ __forceinline__ unsigned cvtpk(float lo, float hi) { unsigned r; asm volatile("v_cvt_pk_bf16_f32 %0, %1, %2" : "=v"(r) : "v"(lo), "v"(hi)); return r; }
__device__ __forceinline__ bf16x8 load8(const bf16* p) { return *reinterpret_cast<const bf16x8*>(p); }
__device__ __forceinline__ void mask_tile(f32x16& p0, f32x16& p1, int dq, unsigned W) {
    const float NEG = -__builtin_inff();
#pragma unroll
    for (int r = 0; r < 16; ++r) {
        const int c = (r & 3) + 8 * (r >> 2);
        if ((unsigned)(dq - c) >= W) p0[r] = NEG;
        if ((unsigned)(dq - c - 32) >= W) p1[r] = NEG;
    }
}
__device__ __forceinline__ void partialSM(f32x16& p0, f32x16& p1, float& m_reg, float& mn, float& alpha) {
    float pmax = p0[0]; for (int r = 1; r < 16; ++r) pmax = fmaxf(pmax, p0[r]); for (int r = 0; r < 16; ++r) pmax = fmaxf(pmax, p1[r]);
    { auto rr = __builtin_amdgcn_permlane32_swap(__float_as_uint(pmax), __float_as_uint(pmax), false, false);
      pmax = fmaxf(__uint_as_float(rr[0]), __uint_as_float(rr[1])); }
    constexpr float C2 = 1.4426950408889634f * SCALE;
    if (__builtin_expect(__all((pmax - m_reg) * SCALE <= THR), 1)) { mn = m_reg; alpha = 1.f; }
    else { mn = fmaxf(m_reg, pmax); alpha = __builtin_amdgcn_exp2f((m_reg - mn) * C2); m_reg = mn; }
    const float mnL = -mn * C2;
    for (int r = 0; r < 16; ++r) p0[r] = fmaf(p0[r], C2, mnL); for (int r = 0; r < 16; ++r) p1[r] = fmaf(p1[r], C2, mnL);
    for (int r = 0; r < 16; ++r) p0[r] = __builtin_amdgcn_exp2f(p0[r]);
}
__device__ __forceinline__ void finishSM(f32x16& p0, f32x16& p1, float alpha, float& l_reg, bf16x8& pa0, bf16x8& pa1, bf16x8& pa2, bf16x8& pa3) {
    for (int r = 0; r < 16; ++r) p1[r] = __builtin_amdgcn_exp2f(p1[r]);
    float ps = 0; for (int r = 0; r < 16; ++r) ps += p0[r]; for (int r = 0; r < 16; ++r) ps += p1[r];
    { auto rr = __builtin_amdgcn_permlane32_swap(__float_as_uint(ps), __float_as_uint(ps), false, false);
      ps = __uint_as_float(rr[0]) + __uint_as_float(rr[1]); }
    l_reg = l_reg * alpha + ps;
#define PK4(P, B_, OUT) do { unsigned a0 = cvtpk(P[B_+0], P[B_+1]), a1 = cvtpk(P[B_+2], P[B_+3]);                          \
        unsigned b0 = cvtpk(P[B_+4], P[B_+5]), b1 = cvtpk(P[B_+6], P[B_+7]);                                             \
        auto r0 = __builtin_amdgcn_permlane32_swap(a0, b0, false, false); auto r1 = __builtin_amdgcn_permlane32_swap(a1, b1, false, false); \
        u32x4 w = {r0[0], r1[0], r0[1], r1[1]}; OUT = *reinterpret_cast<bf16x8*>(&w); } while (0)
    PK4(p0, 0, pa0); PK4(p0, 8, pa1); PK4(p1, 0, pa2); PK4(p1, 8, pa3);
#undef PK4
}
template <int KB>
__device__ __forceinline__ void qkt(f32x16& p0, f32x16& p1, const char* K_lds, int r32, int hi, const bf16x8* qr) {
    p0 = f32x16{}; p1 = f32x16{};
    const char* kb[4];
#pragma unroll
    for (int dd = 0; dd < 4; ++dd) kb[dd] = K_lds + KB * SHM_K + KSWZ(r32, (dd * 16 + hi * 8) * 2);
#pragma unroll
    for (int d0 = 0; d0 < 8; ++d0) { const char* a = kb[d0 & 3] + (d0 >> 2) * 128;
        bf16x8 b0 = *reinterpret_cast<const bf16x8*>(a);
        bf16x8 b1 = *reinterpret_cast<const bf16x8*>(a + 32 * 256);
        p0 = __builtin_amdgcn_mfma_f32_32x32x16_bf16(b0, qr[d0], p0, 0, 0, 0);
        p1 = __builtin_amdgcn_mfma_f32_32x32x16_bf16(b1, qr[d0], p1, 0, 0, 0); }
}
template <int VB>
__device__ __forceinline__ void pv_tile(f32x16* o, int vb0, bf16x8 pa0, bf16x8 pa1, bf16x8 pa2, bf16x8 pa3) {
#define TRRD(dst, off) asm volatile("ds_read_b64_tr_b16 %0, %1 offset:%2" : "=&v"(dst) : "v"(vb0), "i"(off) : "memory")
#define PV_D0(d0) do { s16x4 l0, l1, l2, l3, h0, h1, h2, h3; constexpr int b_ = VB * SHM_V + v_rd_off(d0, 0, 0); \
        TRRD(l0, b_); TRRD(h0, b_ + 2048); TRRD(l1, b_ + 4096); TRRD(h1, b_ + 6144); TRRD(l2, b_ + 8192); TRRD(h2, b_ + 10240); TRRD(l3, b_ + 12288); TRRD(h3, b_ + 14336); \
        asm volatile("s_waitcnt lgkmcnt(0)" ::: "memory"); SBAR();   \
        o[d0] = __builtin_amdgcn_mfma_f32_32x32x16_bf16(pa0, (bf16x8){l0[0], l0[1], l0[2], l0[3], h0[0], h0[1], h0[2], h0[3]}, o[d0], 0, 0, 0);   \
        o[d0] = __builtin_amdgcn_mfma_f32_32x32x16_bf16(pa1, (bf16x8){l1[0], l1[1], l1[2], l1[3], h1[0], h1[1], h1[2], h1[3]}, o[d0], 0, 0, 0);   \
        o[d0] = __builtin_amdgcn_mfma_f32_32x32x16_bf16(pa2, (bf16x8){l2[0], l2[1], l2[2], l2[3], h2[0], h2[1], h2[2], h2[3]}, o[d0], 0, 0, 0);   \
        o[d0] = __builtin_amdgcn_mfma_f32_32x32x16_bf16(pa3, (bf16x8){l3[0], l3[1], l3[2], l3[3], h3[0], h3[1], h3[2], h3[3]}, o[d0], 0, 0, 0); } while (0)
    PV_D0(0); PV_D0(1); PV_D0(2); PV_D0(3);
#undef PV_D0
#undef TRRD
}
struct BlockRef { const bf16* Q; const bf16* K; const bf16* V; float* O; const unsigned* sel; const bf16* gate; const bf16* C; int P0, W; };
struct Seam { bf16x8 qr[8]; bf16x8 st_v0, st_v1, st_k0, st_k1; };
__device__ __forceinline__ int swa_jlo(int P0, int W) { const int lowk = P0 - W + 1; return lowk > 0 ? lowk / KVBLK : 0; }
#define ROW(p, k0, rr) ((p) + (size_t)((k0) + (rr)) * DH + sc)
#define VMW() asm volatile("s_waitcnt vmcnt(0)" ::: "memory")
#define VMWN(n) asm volatile("s_waitcnt vmcnt(%0)" :: "i"(n) : "memory")
#define SLOAD_H(Kp, Vp, k0) do { S.st_v0 = load8(ROW(Vp, k0, sr)); S.st_v1 = load8(ROW(Vp, k0, 32 + sr));              \
                         S.st_k0 = load8(ROW(Kp, k0, sr)); S.st_k1 = load8(ROW(Kp, k0, 32 + sr)); } while (0)
#define SWRITE_HK(bf) do { *(bf16x8*)(K_lds + (bf) * SHM_K + kws) = S.st_k0; *(bf16x8*)(K_lds + (bf) * SHM_K + kws + 32 * 256) = S.st_k1; } while (0)
#define SWRITE_HV(bf) do { *(bf16x8*)(V_lds + (bf) * SHM_V + vst0) = S.st_v0; *(bf16x8*)(V_lds + (bf) * SHM_V + vst1) = S.st_v1; } while (0)
#define SWRITE_H(bf) do { SWRITE_HV(bf); SWRITE_HK(bf); } while (0)
__device__ __forceinline__ void prime(const BlockRef& cur, char* lds, Seam& S) {
    const int tid = threadIdx.x, wid = __builtin_amdgcn_readfirstlane(tid >> 6), lane = tid & 63, r32 = lane & 31, hi = lane >> 5;
    const int sr = tid >> 4, sc = (tid & 15) * 8, kws = KSWZ(sr, sc * 2); char* K_lds = lds + 2 * SHM_V;
    const int kb0 = swa_jlo(cur.P0, cur.W) * KVBLK;
    for (int d0 = 0; d0 < 8; ++d0) S.qr[d0] = load8(cur.Q + (size_t)(wid * QBLK + r32) * QS + d0 * 16 + hi * 8);
    SLOAD_H(cur.K, cur.V, kb0); VMW(); SWRITE_HK(0);
    __syncthreads();
}
__device__ __forceinline__ void block(const BlockRef& cur, const BlockRef& nxt, int skv, char* lds, Seam& S) {
    int tid_ = threadIdx.x; asm volatile("" : "+v"(tid_));
    const int tid = tid_, wid = __builtin_amdgcn_readfirstlane(tid >> 6), lane = tid & 63, r32 = lane & 31, hi = lane >> 5;
    const int W = cur.W;
    const int j_lo = swa_jlo(cur.P0, W);
    int j_hi = (cur.P0 + QB - 1) / KVBLK + 1; if (j_hi > skv / KVBLK) j_hi = skv / KVBLK;
    const int NT = j_hi - j_lo;
    const int kbn = swa_jlo(nxt.P0, nxt.W) * KVBLK;
    const int qlo = cur.P0 + wid * QBLK, qm = qlo + r32 - 4 * hi;
    char* V_lds = lds; char* K_lds = lds + 2 * SHM_V;
    float* ws = (float*)(lds + FA_WS_OFF) + wid * 64; float* li_l = ws, * al_l = ws + 32;
    float m_reg = -1e30f, l_reg = 0; f32x16 o[4] = {};
    const int sr = tid >> 4, sc = (tid & 15) * 8, vst0 = v_st(sr, sc), vst1 = v_st(32 + sr, sc), kws = KSWZ(sr, sc * 2);
    const int vb0 = (int)(uintptr_t)V_lds + v_rd_base(lane);
    const bf16* Kh = cur.K; const bf16* Vh = cur.V;
    const bool hasSel = cur.sel != nullptr;
    const unsigned selmask = hasSel ? cur.sel[qlo + r32] : 0xffffffffu;
#define RESC(a) do { if (__any((a) < 1.f)) { if (hi == 0) al_l[r32] = (a); asm volatile("s_waitcnt lgkmcnt(0)" ::: "memory");              \
                     for (int d_ = 0; d_ < 4; ++d_) for (int r = 0; r < 16; ++r) o[d_][r] *= al_l[crow(r, hi)]; } } while (0)
#define KBASE(t) ((j_lo + (t)) * KVBLK)
#define MASKT(P0_, P1_, t) do { const int kb_ = KBASE(t); if (kb_ + KVBLK - 1 > qlo || kb_ <= qlo + QBLK - 1 - W) mask_tile(P0_, P1_, qm - kb_, (unsigned)W); \
        if (hasSel) { const bool off_ = ((selmask >> (j_lo + (t))) & 1u) == 0u; const float NEG_ = -__builtin_inff(); \
            _Pragma("unroll") for (int r_ = 0; r_ < 16; ++r_) { P0_[r_] = off_ ? NEG_ : P0_[r_]; P1_[r_] = off_ ? NEG_ : P1_[r_]; } } } while (0)
    constexpr int NQL = 8;
#define SEAM_K0() do { VMWN(NQL); SWRITE_HK(0); SBAR(); } while (0)
    f32x16 pA0, pA1, pB0, pB1; float mnA, mnB, alA, alB; bf16x8 pa0, pa1, pa2, pa3;
    SWRITE_HV(0); SBAR();
    if (NT > 1) { SLOAD_H(Kh, Vh, KBASE(1)); }
    SBAR(); qkt<0>(pA0, pA1, K_lds, r32, hi, S.qr);
    MASKT(pA0, pA1, 0); partialSM(pA0, pA1, m_reg, mnA, alA);
    if (NT > 1) { VMW(); SWRITE_H(1); }
#if GATED
    if (hasSel) { const bf16* Cw = cur.C + (size_t)(wid * QBLK) * OS + (r32 & ~1); const bool odd = r32 & 1;
#pragma unroll
        for (int r = 0; r < 16; ++r)
#pragma unroll
            for (int dp = 0; dp < 2; ++dp)
                __builtin_amdgcn_global_load_lds((const unsigned*)(Cw + (size_t)crow(r, hi) * OS + (odd ? dp + 2 : dp) * 32), (LAS unsigned*)((LAS char*)lds + FA_STG_OFF + (r * 2 + dp) * 2048 + wid * 256), 4, 0, 0); }
#endif
    __syncthreads();
#define HALF_STEP(PX0, PX1, mnX, alX, PY0, PY1, alY, t, KB, VB, SB) do {                                                      \
        SBAR(); qkt<KB>(PX0, PX1, K_lds, r32, hi, S.qr);                                             \
        finishSM(PY0, PY1, alY, l_reg, pa0, pa1, pa2, pa3); SBAR();                                                           \
        if ((t) + 1 < NT) { SLOAD_H(Kh, Vh, KBASE((t) + 1)); SBAR(); }                                               \
        pv_tile<VB>(o, vb0, pa0, pa1, pa2, pa3); MASKT(PX0, PX1, (t)); partialSM(PX0, PX1, m_reg, mnX, alX);                                        \
        __syncthreads();                                                                                                      \
        if ((t) + 1 < NT) { VMW(); SWRITE_H(SB); }                                                                          \
        RESC(alX); __syncthreads(); } while (0)
    for (int t = 1; t + 1 < NT; t += 2) {
        HALF_STEP(pB0, pB1, mnB, alB, pA0, pA1, alA, t, 1, 0, 0);
        HALF_STEP(pA0, pA1, mnA, alA, pB0, pB1, alB, t + 1, 0, 1, 1);
    }
    const bool even = (NT & 1) == 0;
    if (even) { SBAR(); qkt<1>(pB0, pB1, K_lds, r32, hi, S.qr); SBAR(); }
    { SLOAD_H(nxt.K, nxt.V, kbn); SBAR();
#pragma unroll
        for (int d0 = 0; d0 < 8; ++d0) S.qr[d0] = load8(nxt.Q + (size_t)(wid * QBLK + r32) * QS + d0 * 16 + hi * 8); }
    SBAR();
    finishSM(pA0, pA1, alA, l_reg, pa0, pa1, pa2, pa3); SBAR();
    pv_tile<0>(o, vb0, pa0, pa1, pa2, pa3);
    if (even) { MASKT(pB0, pB1, NT - 1); partialSM(pB0, pB1, m_reg, mnB, alB); __syncthreads(); RESC(alB);
        finishSM(pB0, pB1, alB, l_reg, pa0, pa1, pa2, pa3); SBAR(); pv_tile<1>(o, vb0, pa0, pa1, pa2, pa3); }
    SBAR(); SEAM_K0();
    if (hi == 0) li_l[r32] = l_reg; asm volatile("s_waitcnt lgkmcnt(0)" ::: "memory");
    float rli[16];
#pragma unroll
    for (int r = 0; r < 16; ++r) rli[r] = __builtin_amdgcn_rcpf(li_l[crow(r, hi)]);
#if GATED
    bf16 graw[16];
#pragma unroll
    for (int r = 0; r < 16; ++r) graw[r] = cur.gate[(size_t)(wid * QBLK + crow(r, hi)) * QS];
    LAS unsigned* sl = (LAS unsigned*)((LAS char*)lds + FA_STG_OFF) + tid;
    if (hasSel) {
#pragma unroll
        for (int r = 0; r < 16; ++r) { const float sc_ = rli[r] * sigmoidf_(bf2f(graw[r]));
#pragma unroll
            for (int dp = 0; dp < 2; ++dp) { const float va = o[dp][r] * sc_, vb = o[dp + 2][r] * sc_, na = dpp_xor1(va), nb = dpp_xor1(vb);
                const bool odd = r32 & 1; const unsigned c = sl[(r * 2 + dp) * 512]; sl[(r * 2 + dp) * 512] = cvtpk(lo_bf(c) + (odd ? nb : va), hi_bf(c) + (odd ? vb : na)); } }
    } else {
        bf16* Ow = (bf16*)cur.O + (size_t)(wid * QBLK) * OSA;
#pragma unroll
        for (int r = 0; r < 16; ++r) { const int orow = crow(r, hi);
            const float sc_ = rli[r] * sigmoidf_(bf2f(graw[r]));
#pragma unroll
            for (int dp = 0; dp < 2; ++dp) { const float va = o[dp][r] * sc_, vb = o[dp + 2][r] * sc_, na = dpp_xor1(va), nb = dpp_xor1(vb);
                const bool odd = r32 & 1; const unsigned c = sl[(r * 2 + dp) * 512];
                *(unsigned*)(Ow + (size_t)orow * OSA + (odd ? dp + 2 : dp) * 32 + (r32 & ~1)) = cvtpk(lo_bf(c) + (odd ? nb : va), hi_bf(c) + (odd ? vb : na)); } }
    }
    asm volatile("s_waitcnt lgkmcnt(0)" ::: "memory");
#else
    float* Ow = cur.O + (size_t)(wid * QBLK) * OS;
#pragma unroll
    for (int r = 0; r < 16; ++r) { const int orow = crow(r, hi);
#pragma unroll
        for (int d0 = 0; d0 < 4; ++d0) Ow[(size_t)orow * OS + d0 * 32 + r32] = o[d0][r] * rli[r]; }
#endif
    __syncthreads();
#undef RESC
#undef KBASE
#undef MASKT
#undef SEAM_K0
#undef HALF_STEP
}
#undef ROW
#undef VMW
#undef VMWN
#undef SLOAD_H
#undef SWRITE_HK
#undef SWRITE_HV
#undef SWRITE_H
}


__device__ __forceinline__ float gelu_fast(float x) { const float u = 0.7978845608028654f * (x + 0.044715f * x * x * x); const float t = 1.0f - 2.0f / (1.0f + __expf(2.0f * u)); return 0.5f * x * (1.0f + t); }
template <int SAMPLE> __device__ __forceinline__ void ph_cmp_finish_mfma(const Args& a, const Frame& F, char* lds, int widx = -1, int wcnt = 0) {
    constexpr int NB = SAMPLE ? NBS : NBP, NCH = SAMPLE ? 1024 : 128, NC = NCH - 1, NBLK = (NC + 31) / 32, NG = NB * NKV;
    typedef float f32x16 __attribute__((ext_vector_type(16)));
    const float* part = (const float*)(a.ws + (SAMPLE ? WS_PARTS : WS_PARTP)); float* kc = (float*)(a.ws + (SAMPLE ? WS_KCS : WS_KCP));
    const float* peb = (const float*)(a.ws + WS_PEB);
    const int tid = F.tid, lane = F.lane, r32 = lane & 31, hi = lane >> 5;
    if ((widx >= 0 ? widx : F.vcu) * 8 >= 2 * NG * NBLK) return;
    __syncthreads();
    for (int i = tid; i < 2 * 128 * 16; i += 512) { const int kind = i >> 11, n = i & 127, ch = (i >> 7) & 15; const float* w2 = (kind ? a.wcv2 : a.wck2) + (size_t)(ch * 8) * 128 + n;
        u32x4 wv = {pk2(w2[0], w2[128]), pk2(w2[256], w2[384]), pk2(w2[512], w2[640]), pk2(w2[768], w2[896])};
        *(u32x4*)(lds + kind * 32768 + n * 256 + ((ch ^ (n & 15)) << 4)) = wv; }
    __syncthreads();
    const int gw = (widx >= 0 ? widx : F.vcu) * 8 + F.wave, NGW = (widx >= 0 ? wcnt : F.G) * 8;
#pragma unroll 1
    for (int it = gw; it < 2 * NG * NBLK; it += NGW) {
        const int blk = it % NBLK, q = it / NBLK, g = q % NG, kind = q / NG, c0 = blk * 32;
        const int c = c0 + r32, cc = c < NC ? c : NC - 1;
        const float* p0 = part + ((size_t)g * NCH + cc) * 512 + kind * 256; const float* p1 = p0 + 512 + 128; const float* pb = peb + kind * 128;
        f32x16 acc[4] = {};
        const char* wl = lds + kind * 32768;
#pragma unroll
        for (int ks = 0; ks < 8; ++ks) { const int f = ks * 16 + hi * 8;
            const f32x4 a0 = *(const f32x4*)(p0 + f), a1 = *(const f32x4*)(p0 + f + 4), b0 = *(const f32x4*)(p1 + f), b1 = *(const f32x4*)(p1 + f + 4), e0 = *(const f32x4*)(pb + f), e1 = *(const f32x4*)(pb + f + 4);
            float gv[8];
#pragma unroll
            for (int e = 0; e < 4; ++e) { gv[e] = gelu_fast(a0[e] + b0[e] + e0[e]); gv[4 + e] = gelu_fast(a1[e] + b1[e] + e1[e]); }
            u32x4 aw = {fa::cvtpk(gv[0], gv[1]), fa::cvtpk(gv[2], gv[3]), fa::cvtpk(gv[4], gv[5]), fa::cvtpk(gv[6], gv[7])};
            const bf16x8 af = *reinterpret_cast<bf16x8*>(&aw);
#pragma unroll
            for (int nb = 0; nb < 4; ++nb) { const int n = nb * 32 + r32; const bf16x8 bfr = *reinterpret_cast<const bf16x8*>(wl + n * 256 + (((ks * 2 + hi) ^ (n & 15)) << 4));
                acc[nb] = __builtin_amdgcn_mfma_f32_32x32x16_bf16(af, bfr, acc[nb], 0, 0, 0); } }
        if constexpr (SAMPLE) {
            bf16* dst = (bf16*)kc + (((size_t)kind * NG + g) * NCH) * HD;
#pragma unroll
            for (int r = 0; r < 16; ++r) { const int row = c0 + fa::crow(r, hi); if (row < NC) {
#pragma unroll
                for (int nb = 0; nb < 4; ++nb) dst[(size_t)row * HD + nb * 32 + r32] = (bf16)f2bf(acc[nb][r]); } }
        } else {
        float* dst = kc + (((size_t)kind * NG + g) * NCH) * HD;
#pragma unroll
        for (int r = 0; r < 16; ++r) { const int row = c0 + fa::crow(r, hi); if (row < NC) {
#pragma unroll
            for (int nb = 0; nb < 4; ++nb) dst[(size_t)row * HD + nb * 32 + r32] = acc[nb][r]; } }
        }
    }
}


template <int MODE = 0  > __device__ __forceinline__ void ph_compress_sample(const Args& a, const Frame& F, char* lds) {
    typedef float f32x16 __attribute__((ext_vector_type(16)));
    const int tid = F.tid, lane = F.lane, wid = F.wave, wm = wid >> 2, wn = wid & 3, r32 = lane & 31, hi = lane >> 5;
    char* As = lds; char* Bs = lds + 32768;
    const bf16* wct = (const bf16*)(a.ws + WS_WC_T); float* parts = (float*)(a.ws + (MODE ? WS_DBGA : WS_PARTS));
    const int acl = tid >> 4, aseg = tid & 15, brl = tid >> 3, bch = tid & 7;
#pragma unroll 1
    for (int unit = F.vcu; unit < 512; unit += F.G) {
        const int kind = unit >> 8, b = (unit >> 5) & 7, rt = unit & 31;
        const int c = rt * 32 + acl, page = a.ptab[b * NPAGES + (c >> 3)];
        const float* abase = a.cache + ((size_t)page * PAGE + (c & 7) * 16) * 2048 + kind * 512 + aseg * 4;
        const bf16* bbase = wct + (size_t)(kind * 256 + brl) * 2048 + bch * 8;
        const int krot = (F.vcu * 4) & 31;
        f32x16 acc[2][2] = {};
        f32x4 ra[4][4] = {}; u32x4 rb[2][4] = {};
#define CS_LOADA(slot, kt) do { if (MODE == 2) break; const int kq_ = ((kt) + krot) & 31; const float* p_ = abase + (size_t)(kq_ >> 1) * 2048 + (kq_ & 1) * 64; _Pragma("unroll") for (int j_ = 0; j_ < 4; ++j_) ra[slot][j_] = __builtin_nontemporal_load((const f32x4*)(p_ + j_ * HD)); } while (0)
#define CS_LOADB(bs, kt) do { if (MODE == 2) break; const bf16* p_ = bbase + (((kt) + krot) & 31) * 64; _Pragma("unroll") for (int j_ = 0; j_ < 4; ++j_) rb[bs][j_] = *(const u32x4*)(p_ + (size_t)j_ * 64 * 2048); } while (0)
#define CS_WRITE(slot, bs, buf) do { \
        _Pragma("unroll") for (int j_ = 0; j_ < 4; ++j_) { const int row_ = j_ * 32 + acl; \
            *(u32x2*)(As + (buf) * 16384 + row_ * 128 + (((aseg >> 1) ^ (row_ & 7)) << 4) + (aseg & 1) * 8) = (u32x2){fa::cvtpk(ra[slot][j_][0], ra[slot][j_][1]), fa::cvtpk(ra[slot][j_][2], ra[slot][j_][3])}; } \
        _Pragma("unroll") for (int j_ = 0; j_ < 4; ++j_) { const int row_ = j_ * 64 + brl; *(u32x4*)(Bs + (buf) * 32768 + row_ * 128 + ((bch ^ (row_ & 7)) << 4)) = rb[bs][j_]; } } while (0)
#define CS_COMPUTE(buf) do { if (MODE == 1) break; _Pragma("unroll") for (int ks_ = 0; ks_ < 4; ++ks_) { bf16x8 af_[2], bf_[2]; \
        _Pragma("unroll") for (int t_ = 0; t_ < 2; ++t_) { const int ar_ = wm * 64 + t_ * 32 + r32, br_ = wn * 64 + t_ * 32 + r32; \
            af_[t_] = *(const bf16x8*)(As + (buf) * 16384 + ar_ * 128 + (((ks_ * 2 + hi) ^ (ar_ & 7)) << 4)); \
            bf_[t_] = *(const bf16x8*)(Bs + (buf) * 32768 + br_ * 128 + (((ks_ * 2 + hi) ^ (br_ & 7)) << 4)); } \
        _Pragma("unroll") for (int mt_ = 0; mt_ < 2; ++mt_) _Pragma("unroll") for (int nt_ = 0; nt_ < 2; ++nt_) acc[mt_][nt_] = __builtin_amdgcn_mfma_f32_32x32x16_bf16(af_[mt_], bf_[nt_], acc[mt_][nt_], 0, 0, 0); } } while (0)
        __syncthreads();
        CS_LOADA(0, 0); CS_LOADB(0, 0); CS_LOADB(1, 1); CS_LOADA(1, 1); CS_LOADA(2, 2); CS_LOADA(3, 3);
        CS_WRITE(0, 0, 0); CS_LOADB(0, 2);
        __syncthreads();
#define CS_STEP(kt, s1, s3) do { const int k3_ = (kt) + 3 < 32 ? (kt) + 3 : 31, k4_ = (kt) + 4 < 32 ? (kt) + 4 : 31;     \
        CS_LOADA(s3, k4_); CS_COMPUTE((kt) & 1); CS_WRITE(s1, ((kt) + 1) & 1, ((kt) + 1) & 1); CS_LOADB(((kt) + 1) & 1, k3_); __syncthreads(); } while (0)
#pragma unroll 1
        for (int kt = 0; kt < 32; kt += 4) { CS_STEP(kt, 1, 0); CS_STEP(kt + 1, 2, 1); CS_STEP(kt + 2, 3, 2); CS_STEP(kt + 3, 0, 3); }
#undef CS_STEP
#undef CS_COMPUTE
#undef CS_WRITE
#undef CS_LOADB
#undef CS_LOADA
#pragma unroll
        for (int mt = 0; mt < 2; ++mt)
#pragma unroll
            for (int r = 0; r < 16; ++r) {
                float* dr = parts + ((size_t)(b * NKV + wm * 2 + mt) * 1024 + rt * 32 + fa::crow(r, hi)) * 512 + kind * 256 + wn * 64 + r32;
#pragma unroll
                for (int nt = 0; nt < 2; ++nt) dr[nt * 32] = acc[mt][nt][r]; }
    }
    __syncthreads();
}

__device__ __forceinline__ void ph_cmp_prompt(const Args& a, const Frame& F, char* lds) {
    using namespace fa;
    const int tid = F.tid, wid = F.wave, lane = F.lane, r32 = lane & 31, hi = lane >> 5;
    char* V_lds = lds; char* K_lds = lds + 2 * SHM_V; float* pgw = (float*)(lds + 2 * SHM_V + 2 * SHM_K) + wid * 1024;
    const int sr = tid >> 4, sc = (tid & 15) * 8;
    const int vb0 = (int)(uintptr_t)V_lds + v_rd_base(lane);
    const bf16* P = (const bf16*)(a.ws + WS_P); const float* kcp = (const float*)(a.ws + WS_KCP); float* OC = (float*)(a.ws + WS_OCMP);
    unsigned* selp = (unsigned*)(a.ws + WS_SELP);
    constexpr float C2 = 1.4426950408889634f * SCALE;
    for (int w = F.vcu; w < 256; w += F.G) {
        const int bk = w >> 4, b = bk >> 2, kvh = bk & 3;
        const float* Kc = kcp + (((size_t)0 * NBP + b) * NKV + kvh) * 128 * HD; const float* Vc = kcp + (((size_t)1 * NBP + b) * NKV + kvh) * 128 * HD;
        __syncthreads();
        bf16x8 qr[8];
#define CP_LOADQ(qi_) do { const bf16* qb_ = PX(P, b * SEQ + ((w & 15) * 2 + (qi_)) * 64 + wid * 8 + (r32 >> 2), (kvh * 4 + (r32 & 3)) * HD) + hi * 8; \
        _Pragma("unroll") for (int d0 = 0; d0 < 8; ++d0) qr[d0] = load8(qb_ + d0 * 16); } while (0)
        CP_LOADQ(0);
#pragma unroll
        for (int t = 0; t < 2; ++t)
#pragma unroll
            for (int hf = 0; hf < 2; ++hf) { const int key0 = 64 * t + 32 * hf + sr, key = key0 < NCP ? key0 : NCP - 1;
                const f32x4 k0 = *(const f32x4*)(Kc + (size_t)key * HD + sc), k1 = *(const f32x4*)(Kc + (size_t)key * HD + sc + 4);
                const f32x4 v0 = *(const f32x4*)(Vc + (size_t)key * HD + sc), v1 = *(const f32x4*)(Vc + (size_t)key * HD + sc + 4);
                u32x4 kw = {cvtpk(k0[0], k0[1]), cvtpk(k0[2], k0[3]), cvtpk(k1[0], k1[1]), cvtpk(k1[2], k1[3])};
                u32x4 vw = {cvtpk(v0[0], v0[1]), cvtpk(v0[2], v0[3]), cvtpk(v1[0], v1[1]), cvtpk(v1[2], v1[3])};
                *(u32x4*)(K_lds + t * SHM_K + KSWZ(32 * hf + sr, sc * 2)) = kw;
                *(u32x4*)(V_lds + t * SHM_V + v_st(32 * hf + sr, sc)) = vw; }
        __syncthreads();
#pragma unroll 1
        for (int qi = 0; qi < 2; ++qi) {
            const int s0 = ((w & 15) * 2 + qi) * 64 + wid * 8, s = s0 + (r32 >> 2);
#if GATED
            u32x2 g4[4];
#pragma unroll
            for (int j = 0; j < 4; ++j) g4[j] = *(const u32x2*)PX(P, b * SEQ + s0 + 2 * j + hi, PC_G + kvh * 4);
#endif
            f32x16 p[4];
            qkt<0>(p[0], p[1], K_lds, r32, hi, qr); qkt<1>(p[2], p[3], K_lds, r32, hi, qr);
            CP_LOADQ(1);
            const int nvis = s >= 31 ? (s - 31) / 16 + 1 : 0;
            float mx = -__builtin_inff();
#pragma unroll
            for (int j = 0; j < 4; ++j)
#pragma unroll
                for (int r = 0; r < 16; ++r) { const int key = 32 * j + crow(r, hi); p[j][r] = key < nvis ? p[j][r] : -__builtin_inff(); mx = fmaxf(mx, p[j][r]); }
            { auto rr = __builtin_amdgcn_permlane32_swap(__float_as_uint(mx), __float_as_uint(mx), false, false); mx = fmaxf(__uint_as_float(rr[0]), __uint_as_float(rr[1])); }
            const float mref = mx > -1e30f ? mx : 0.f, mnL = -mref * C2;
            float ps = 0.f;
#pragma unroll
            for (int j = 0; j < 4; ++j)
#pragma unroll
                for (int r = 0; r < 16; ++r) { p[j][r] = __builtin_amdgcn_exp2f(fmaf(p[j][r], C2, mnL)); ps += p[j][r]; }
            { auto rr = __builtin_amdgcn_permlane32_swap(__float_as_uint(ps), __float_as_uint(ps), false, false); ps = __uint_as_float(rr[0]) + __uint_as_float(rr[1]); }
            const float inv = ps > 0.f ? 1.0f / ps : 0.f;
#pragma unroll
            for (int j = 0; j < 4; ++j)
#pragma unroll
                for (int r = 0; r < 16; ++r) { p[j][r] *= inv; float v = p[j][r]; v += dpp_xor1(v); v += dpp_xor2(v);
                    if ((r32 & 3) == 0) pgw[(r32 >> 2) * 128 + 32 * j + crow(r, hi)] = v; }
            bf16x8 pa[8];
#define PK4(P_, B_, OUT) do { unsigned a0 = cvtpk(P_[B_+0], P_[B_+1]), a1 = cvtpk(P_[B_+2], P_[B_+3]); unsigned b0 = cvtpk(P_[B_+4], P_[B_+5]), b1 = cvtpk(P_[B_+6], P_[B_+7]); \
        auto r0 = __builtin_amdgcn_permlane32_swap(a0, b0, false, false); auto r1 = __builtin_amdgcn_permlane32_swap(a1, b1, false, false); \
        u32x4 w_ = {r0[0], r1[0], r0[1], r1[1]}; OUT = *reinterpret_cast<bf16x8*>(&w_); } while (0)
            PK4(p[0], 0, pa[0]); PK4(p[0], 8, pa[1]); PK4(p[1], 0, pa[2]); PK4(p[1], 8, pa[3]);
            PK4(p[2], 0, pa[4]); PK4(p[2], 8, pa[5]); PK4(p[3], 0, pa[6]); PK4(p[3], 8, pa[7]);
#undef PK4
            f32x16 o[4] = {};
            pv_tile<0>(o, vb0, pa[0], pa[1], pa[2], pa[3]); pv_tile<1>(o, vb0, pa[4], pa[5], pa[6], pa[7]);
#if GATED
            bf16 graw[16];
#pragma unroll
            for (int j = 0; j < 4; ++j) { graw[4 * j] = (bf16)(g4[j][0] & 0xffffu); graw[4 * j + 1] = (bf16)(g4[j][0] >> 16); graw[4 * j + 2] = (bf16)(g4[j][1] & 0xffffu); graw[4 * j + 3] = (bf16)(g4[j][1] >> 16); }
#endif
#pragma unroll
            for (int r = 0; r < 16; ++r) { const int row = crow(r, hi);
#if GATED
                const size_t tr = (size_t)(b * SEQ + s0 + (row >> 2)); const int hh = kvh * 4 + (row & 3);
                const float gsc = sigmoidf_(bf2f(graw[r])); bf16* op = (bf16*)OC + tr * D + hh * HD + r32;
#pragma unroll
                for (int dp = 0; dp < 2; ++dp) { const float va = o[dp][r] * gsc, vb = o[dp + 2][r] * gsc, na = dpp_xor1(va), nb = dpp_xor1(vb); const bool odd = r32 & 1;
                    *(unsigned*)(op - r32 + (odd ? dp + 2 : dp) * 32 + (r32 & ~1)) = cvtpk(odd ? nb : va, odd ? vb : na); }
#else
                float* op = OC + (size_t)(b * SEQ + s0 + (row >> 2)) * D + (kvh * 4 + (row & 3)) * HD + r32;
#pragma unroll
                for (int d0 = 0; d0 < 4; ++d0) op[d0 * 32] = o[d0][r];
#endif
            }
            asm volatile("s_waitcnt lgkmcnt(0)" ::: "memory");
            const int cur = s0 >> 6, n = lane & 31;
#pragma unroll 1
            for (int i = 0; i < 4; ++i) { const float* pq = pgw + (i + 4 * hi) * 128;
                const float scv = (n > 0 ? pq[4 * n - 1] : 0.f) + 2.0f * (pq[4 * n] + pq[4 * n + 1] + pq[4 * n + 2]) + pq[4 * n + 3];
                const bool vld = n <= cur, forced = (n == 0) || (n > cur - 2); const float val = vld ? (forced ? __builtin_inff() : scv) : -__builtin_inff();
                int rank = 0;
#pragma unroll
                for (int k = 0; k < 32; ++k) { const float vlo = __int_as_float(__builtin_amdgcn_readlane(__float_as_int(val), k)), vhi = __int_as_float(__builtin_amdgcn_readlane(__float_as_int(val), 32 + k));
                    const float vk = hi ? vhi : vlo; rank += (vk > val || (vk == val && k < n)) ? 1 : 0; }
                const unsigned long long bm = __ballot(rank < 16 && val > -__builtin_inff());
                if (lane == 0) { unsigned* sp = selp + ((size_t)b * NKV + kvh) * SEQ + s0 + i; sp[0] = (unsigned)bm; sp[4] = (unsigned)(bm >> 32); } }
            asm volatile("s_waitcnt lgkmcnt(0)" ::: "memory");
        }
    }
}

__device__ __forceinline__ void att_combine(const WaveAtt& W, LAS float* xm, LAS float* xl, LAS float* xo, float* O, int r, int kvh, const Frame& F, bool normalised, const bf16* gate, float& osum, bool fin) {
#pragma unroll
    for (int g = 0; g < 4; ++g) if (F.lane == g) { xm[F.wave * 4 + g] = W.m[g]; xl[F.wave * 4 + g] = W.l[g]; }
#pragma unroll
    for (int g = 0; g < 4; ++g) *(LAS f32x2*)(xo + F.wave * 512 + g * 128 + 2 * F.lane) = (f32x2){W.o[g][0], W.o[g][1]};
    __syncthreads();
    { const int g = F.tid >> 7, d = F.tid & 127; float M = -1e30f;
#pragma unroll
      for (int v = 0; v < 8; ++v) M = fmaxf(M, xm[v * 4 + g]);
      float L = 0.f, acc = 0.f;
#pragma unroll
      for (int v = 0; v < 8; ++v) { const float f = normalised ? 1.0f : __expf(xm[v * 4 + g] - M); L += f * xl[v * 4 + g]; acc += f * xo[v * 512 + g * 128 + d]; }
      const float val = normalised ? acc : (L > 0.f ? acc / L : 0.f);
#if GATED
      osum += val * sigmoidf_(bf2f(gate[g]));
      if (fin) ((bf16*)O)[(size_t)r * 2 * D + (kvh * 4 + g) * HD + d] = (bf16)f2bf(osum);
#else
      O[(size_t)r * D + (kvh * 4 + g) * HD + d] = val;
#endif
    }
    __syncthreads();
}
__device__ __forceinline__ void ph_sample_attn(const Args& a, const Frame& F, size_t oc_off = WS_OCMP, size_t os_off = WS_OSLC, size_t ow_off = WS_OWIN) {
    const bf16* P = (const bf16*)(a.ws + WS_P); const bf16* kcs = (const bf16*)(a.ws + WS_KCS);
    LAS float* base = (LAS float*)F.lds; LAS float* wl = base + F.wave * 1024; WaveAtt W; W.qs = wl; W.pb = wl + 512;
    LAS float* xm = base + 8192; LAS float* xl = xm + 32; LAS float* xo = xl + 32; LAS float* pg = xo + 4096 + 4; LAS float* scl = pg + 1028; LAS int* list = (LAS int*)(scl + 264);
    const int wv = F.wave;
    for (int w = F.vcu; w < NBS * NKV * DSQ; w += F.G) {
        int lane = F.lane; asm volatile("" : "+v"(lane));
        const int b = w >> 5, kvh = (w >> 3) & 3, s = w & 7, r = MP + b * DSQ + s;
        att_load_q(P, r, kvh, W, lane);
        const bf16* Kc = kcs + (((size_t)0 * NBS + b) * NKV + kvh) * 1024 * HD; const bf16* Vc = kcs + (((size_t)1 * NBS + b) * NKV + kvh) * 1024 * HD;
        float mx[4] = {-1e30f, -1e30f, -1e30f, -1e30f}, ls[4] = {0.f, 0.f, 0.f, 0.f}; float scs[2][4];
#pragma unroll
        for (int q = 0; q < 2; ++q) { const int c = (2 * wv + q) * 64 + lane; const bool valid = c < NCS; float t[4];
            if (valid) att_dot4<bf16>(Kc + (size_t)c * HD, W, t); else { t[0] = t[1] = t[2] = t[3] = 0.f; }
#pragma unroll
            for (int g = 0; g < 4; ++g) { const float sv = valid ? t[g] * SCALE : -__builtin_inff(); scs[q][g] = sv; const float m2 = fmaxf(mx[g], wave_max(sv));
                ls[g] = ls[g] * __expf(mx[g] - m2) + wave_sum(__expf(sv - m2)); mx[g] = m2; } }
#pragma unroll
        for (int g = 0; g < 4; ++g) if (lane == g) { xm[wv * 4 + g] = mx[g]; xl[wv * 4 + g] = ls[g]; }
        __syncthreads();
        float M[4], Li[4];
#pragma unroll
        for (int g = 0; g < 4; ++g) { float m_ = -1e30f;
#pragma unroll
            for (int v = 0; v < 8; ++v) m_ = fmaxf(m_, xm[v * 4 + g]);
            float l_ = 0.f;
#pragma unroll
            for (int v = 0; v < 8; ++v) l_ += xl[v * 4 + g] * __expf(xm[v * 4 + g] - m_);
            M[g] = m_; Li[g] = l_ > 0.f ? 1.0f / l_ : 0.f; }
        __syncthreads();
        att_init(W);
#pragma unroll
        for (int q = 0; q < 2; ++q) { const int sg = 2 * wv + q, c = sg * 64 + lane;
            f32x4 p; float pgs = 0.f;
#pragma unroll
            for (int g = 0; g < 4; ++g) { p[g] = __expf(scs[q][g] - M[g]) * Li[g]; pgs += p[g]; }
            pg[c] = pgs;
            int nk = NCS - sg * 64; nk = nk > 64 ? 64 : nk;
            *(LAS f32x4*)(W.pb + lane * 4) = p; asm volatile("s_waitcnt lgkmcnt(0)" ::: "memory");
            att_pv<bf16>(Vc + (size_t)sg * 64 * HD, HD, nk, W, lane); asm volatile("s_waitcnt lgkmcnt(0)" ::: "memory"); }
        if (F.tid == 0) pg[-1] = 0.f;
        const bf16* grow = PX(P, r, PC_G + kvh * 4);
        float osum = 0.f;
        att_combine(W, xm, xl, xo, (float*)(a.ws + oc_off), r, kvh, F, true, grow, osum, false);
        if (F.tid < 256) { const int n = F.tid; scl[n] = (n >= 1 && n <= 254) ? pg[4 * n - 1] + 2.0f * (pg[4 * n] + pg[4 * n + 1] + pg[4 * n + 2]) + pg[4 * n + 3] : -__builtin_inff(); }
        __syncthreads();
        if (F.tid < 256) { const int n = F.tid; const float val = scl[n]; int rank = 0;
#pragma unroll 8
            for (int k4 = 0; k4 < 256; k4 += 4) { const f32x4 v4 = *(const LAS f32x4*)(scl + k4);
#pragma unroll
                for (int e = 0; e < 4; ++e) rank += (v4[e] > val || (v4[e] == val && k4 + e < n)) ? 1 : 0; }
            const bool sel = (n >= 1 && n <= 254 && rank < 13) || n == 0 || n == 255;
            const unsigned long long bm = __ballot(sel);
            if (lane == 0) { ((LAS unsigned*)list)[2 * wv] = (unsigned)bm; ((LAS unsigned*)list)[2 * wv + 1] = (unsigned)(bm >> 32); } }
        __syncthreads();
        if (F.tid == 0) { int cnt = 0;
#pragma unroll 1
            for (int i = 0; i < 8; ++i) { unsigned x = ((LAS unsigned*)list)[i];
#pragma unroll 1
                while (x) { const int bpos = __ffs(x) - 1; x &= x - 1; if (cnt < 16) { list[8 + cnt] = i * 32 + bpos; ++cnt; } } }
            if (cnt < 17) { list[8 + cnt] = 256; ++cnt; }
#pragma unroll 1
            for (; cnt < 17; ++cnt) list[8 + cnt] = -1; }
        __syncthreads();
        att_init(W);
#pragma unroll 1
        for (int e = wv; e < 17; e += 8) {
            const int n = list[8 + e]; if (n < 0) continue;
            if (n < 256) {
                const int page = a.ptab[b * NPAGES + (n >> 1)];
                const float* kb = a.cache + ((size_t)page * PAGE + (n & 1) * 64) * 2048 + kvh * HD;
                att_segment<float, PVS>(kb + 2 * 512, 2048, kb + 3 * 512, 2048, 64, true, W, lane);
            } else { att_segment<bf16, PVS>(PX(P, MP + b * DSQ, PC_KV + 2 * 512 + kvh * HD), PRS, PX(P, MP + b * DSQ, PC_KV + 3 * 512 + kvh * HD), PRS, s + 1, lane <= s, W, lane); }
        }
        att_combine(W, xm, xl, xo, (float*)(a.ws + os_off), r, kvh, F, false, grow + 16, osum, false);
        att_init(W);
        { const float* st = a.st_win + (size_t)b * 512 * 1024 + kvh * HD; const int i0 = wv * 64;
          const float* nw = a.out + OUT_WINS + ((size_t)b * 512 + 504) * 1024 + kvh * HD;
          if (wv == 0) att_segment<float, PVS>(st, 1024, st + 512, 1024, 64, true, W, lane, nw, nw + 512, s + 1);
          else att_segment<float, PVS>(st + (size_t)i0 * 1024, 1024, st + (size_t)i0 * 1024 + 512, 1024, 64, true, W, lane); }
        att_combine(W, xm, xl, xo, (float*)(a.ws + (GATED ? WS_A2 : ow_off)), r, kvh, F, false, grow + 32, osum, true);
    }
}
__device__ __forceinline__ void ph_win_shift(const Args& a, const Frame& F, int wi, int wn) {
    float* ow = a.out + OUT_WINS;
    for (size_t i = (size_t)(wi * 512 + F.tid); i < (size_t)NBS * 504 * 256; i += (size_t)wn * 512) { const size_t b = i / (504 * 256), rem = i % (504 * 256);
        *(f32x4*)(ow + b * 512 * 1024 + rem * 4) = *(const f32x4*)(a.st_win + b * 512 * 1024 + 8 * 1024 + rem * 4); }
}

__device__ __forceinline__ fa::BlockRef fa_ref(const Args& a, int w, int i) {
    const int bh = w >> 2, p = w & 3, b = bh >> 4, h = bh & 15, kvh = h >> 2;
#if GATED
    const bool win = i & 1; const int qb = (i < 2) ? 7 - p : p;
#else
    const bool win = i >= 2; int qb;
    if (!win) qb = (i == 0) ? 7 - p : p;
    else { const int j = i - 2; qb = p == 0 ? 7 - j : (p == 1 ? 5 - j : (p == 2 ? (j ? 1 : 3) : (j ? 0 : 2))); }
#endif
    const bf16* P = (const bf16*)(a.ws + WS_P); const bf16* KV6 = (const bf16*)(a.ws + WS_KV6);
    fa::BlockRef r; r.P0 = qb * 256; r.W = win ? 512 : (1 << 20);
    r.Q = PX(P, b * SEQ + r.P0, h * HD);
    r.K = KV6 + (((size_t)(win ? 4 : 2) * NBP + b) * NKV + kvh) * SEQ * HD; r.V = KV6 + (((size_t)(win ? 5 : 3) * NBP + b) * NKV + kvh) * SEQ * HD;
#if GATED
    r.O = (float*)((bf16*)(a.ws + WS_A2) + (size_t)(b * SEQ + r.P0) * fa::OSA + h * HD);
    r.C = (const bf16*)(a.ws + WS_OCMP) + (size_t)(b * SEQ + r.P0) * D + h * HD;
#else
    r.O = (float*)(a.ws + (win ? WS_OWIN : WS_OSLC)) + (size_t)(b * SEQ + r.P0) * D + h * HD; r.C = nullptr;
#endif
    r.gate = PX(P, b * SEQ + r.P0, PC_G + (win ? 32 : 16) + h);
    r.sel = win ? nullptr : (const unsigned*)(a.ws + WS_SELP) + ((size_t)b * NKV + kvh) * SEQ;
    return r;
}
__device__ __forceinline__ void ph_fa_prompt(const Args& a, const Frame& F, char* lds) {
    const int nW = (256 - F.vcu + F.G - 1) / F.G;
    if (F.vcu >= 256) return;
    const int total = nW * 4;
    int it = 0;
    fa::BlockRef cur = fa_ref(a, F.vcu, 0);
    fa::Seam S;
    fa::prime(cur, lds, S);
    for (;;) {
        const bool last = it + 1 >= total;
        const int itn = last ? it : it + 1;
        const fa::BlockRef nxt = fa_ref(a, F.vcu + (itn >> 2) * F.G, itn & 3);
        fa::block(cur, nxt, SEQ, lds, S);
        if (last) break;
        cur = nxt; it = itn;
    }
}


#ifndef DBG_MASK_TOL
#define DBG_MASK_TOL 1000u
#endif
constexpr int CW_DBG = 2048;
__device__ __forceinline__ void ph_check(const Args& a, const Frame& F, size_t offA, size_t offB, size_t nfloats, float tol, unsigned bit) {
    const float* A = (const float*)(a.ws + offA); const float* B = (const float*)(a.ws + offB); bool bad = false;
    for (size_t i = (size_t)F.vcu * 512 + F.tid; i < nfloats / 4; i += (size_t)F.G * 512) { const f32x4 x = *(const f32x4*)(A + i * 4), y = *(const f32x4*)(B + i * 4);
#pragma unroll
        for (int e = 0; e < 4; ++e) { const float d = fabsf(x[e] - y[e]); if (!(d <= tol)) bad = true; } }
    if (__any(bad) && F.lane == 0) atomicOr((unsigned*)(a.ws + WS_CTL) + CW_DBG, bit);
}

constexpr int CW_DBGCNT = 2112;
__device__ __forceinline__ void ph_check_masks(const Args& a, const Frame& F) {
    const unsigned* A = (const unsigned*)(a.ws + WS_SELP); const unsigned* B = (const unsigned*)(a.ws + WS_SELP2); int bad = 0;
    for (int i = F.vcu * 512 + F.tid; i < NBP * NKV * SEQ; i += F.G * 512) bad += (A[i] != B[i]) ? 1 : 0;
    bad = (int)wave_sum((float)bad);
    if (F.lane == 0 && bad) atomicAdd((unsigned*)(a.ws + WS_CTL) + CW_DBGCNT, (unsigned)bad);
}


constexpr int CZ_ITEMS = (MP / 16) * 4 + NBS * 4, CZ_P6 = 1536;
__device__ __forceinline__ void ph_conv_z(const Args& a, const Frame& F, int first, int last, int gw, int NGW) {
    const bf16* P = (const bf16*)(a.ws + WS_P); bf16* A2 = (bf16*)(a.ws + WS_A2);
    const int lane = F.lane;
    constexpr int NPI = (MP / 16) * 4, NSI = NBS * 4;
#pragma unroll 1
    for (int it = first + gw; it < last; it += NGW) {
        const bool smp = it >= NPI; const int q = smp ? (it - NPI) & 3 : it & 3, ch = smp ? (it - NPI) >> 2 : it >> 2;
        const int r0 = smp ? MP + ch * DSQ : ch * 16, nrow = smp ? DSQ : 16, s0 = smp ? 0 : (r0 & 2047), SL = smp ? DSQ : SEQ, b = smp ? ch : r0 >> 11;
        const int c = q * 512 + lane * 8;
        float w0[8], w1[8], w2[8], cb[8], u1[8], u2[8];
#pragma unroll
        for (int h = 0; h < 2; ++h) { const f32x4 x0 = *(const f32x4*)(a.conv_w + c + 4 * h), x1 = *(const f32x4*)(a.conv_w + D + c + 4 * h), x2 = *(const f32x4*)(a.conv_w + 2 * D + c + 4 * h), x3 = *(const f32x4*)(a.conv_b + c + 4 * h);
#pragma unroll
            for (int e = 0; e < 4; ++e) { w0[4 * h + e] = x0[e]; w1[4 * h + e] = x1[e]; w2[4 * h + e] = x2[e]; cb[4 * h + e] = x3[e]; } }
        if (smp) {
#pragma unroll
            for (int h = 0; h < 2; ++h) { const f32x4 p0 = *(const f32x4*)(a.st_conv + ((size_t)b * 2 + 0) * D + c + 4 * h), p1 = *(const f32x4*)(a.st_conv + ((size_t)b * 2 + 1) * D + c + 4 * h);
#pragma unroll
                for (int e = 0; e < 4; ++e) { u2[4 * h + e] = p0[e]; u1[4 * h + e] = p1[e]; } }
        } else if (s0 == 0) {
#pragma unroll
            for (int e = 0; e < 8; ++e) { u1[e] = 0.f; u2[e] = 0.f; }
        } else {
            const u32x4 c2 = *(const u32x4*)PX(P, r0 - 2, PC_C + c), i2 = *(const u32x4*)PX(P, r0 - 2, PC_U + c), c1 = *(const u32x4*)PX(P, r0 - 1, PC_C + c), i1 = *(const u32x4*)PX(P, r0 - 1, PC_U + c);
#pragma unroll
            for (int e = 0; e < 4; ++e) { u2[2 * e] = lo_bf(c2[e]) * lo_bf(i2[e]); u2[2 * e + 1] = hi_bf(c2[e]) * hi_bf(i2[e]); u1[2 * e] = lo_bf(c1[e]) * lo_bf(i1[e]); u1[2 * e + 1] = hi_bf(c1[e]) * hi_bf(i1[e]); }
        }
#pragma unroll 1
        for (int i0 = 0; i0 < nrow; i0 += 4) {
            u32x4 cg[4], ui[4], bg[4];
#pragma unroll
            for (int k = 0; k < 4; ++k) { const int rr_ = r0 + i0 + k; cg[k] = *(const u32x4*)PX(P, rr_, PC_C + c); ui[k] = *(const u32x4*)PX(P, rr_, PC_U + c); bg[k] = *(const u32x4*)PX(P, rr_, PC_B + c); }
#pragma unroll
            for (int k = 0; k < 4; ++k) { const int r = r0 + i0 + k, s = s0 + i0 + k; float u[8], z[8];
#pragma unroll
                for (int e = 0; e < 4; ++e) { u[2 * e] = lo_bf(cg[k][e]) * lo_bf(ui[k][e]); u[2 * e + 1] = hi_bf(cg[k][e]) * hi_bf(ui[k][e]); }
#pragma unroll
                for (int e = 0; e < 8; ++e) { const float y = cb[e] + w0[e] * u2[e] + w1[e] * u1[e] + w2[e] * u[e]; z[e] = ((e & 1) ? hi_bf(bg[k][e >> 1]) : lo_bf(bg[k][e >> 1])) * y; }
                *(u32x4*)(A2 + (size_t)r * 2 * D + D + c) = (u32x4){pk2(z[0], z[1]), pk2(z[2], z[3]), pk2(z[4], z[5]), pk2(z[6], z[7])};
                if (s >= SL - 2) { float* o = a.out + (smp ? OUT_CONVS : OUT_CONVP) + ((size_t)b * 2 + (s - (SL - 2))) * D + c; *(f32x4*)o = (f32x4){u[0], u[1], u[2], u[3]}; *(f32x4*)(o + 4) = (f32x4){u[4], u[5], u[6], u[7]}; }
#pragma unroll
                for (int e = 0; e < 8; ++e) { u2[e] = u1[e]; u1[e] = u[e]; } }
        }
    }
}
__device__ __forceinline__ void ph_combine(const Args& a, const Frame& F) {
    const bf16* P = (const bf16*)(a.ws + WS_P); bf16* A2 = (bf16*)(a.ws + WS_A2);
    const float* OC = (const float*)(a.ws + WS_OCMP); const float* OS = (const float*)(a.ws + WS_OSLC); const float* OW = (const float*)(a.ws + WS_OWIN);
    const int gw = F.vcu * 8 + F.wave, NGW = F.G * 8, lane = F.lane;
    for (int r = gw; r < MPAD; r += NGW) {
        bf16* orow = A2 + (size_t)r * 2 * D;
        if (r >= MR) { for (int j = 0; j < 8; ++j) *(u32x4*)(orow + (lane + 64 * j) * 8) = (u32x4){0u, 0u, 0u, 0u}; continue; }
#if GATED
#pragma unroll
        for (int j = 0; j < 4; ++j) { const int c = (lane + 64 * j) * 8;
            const u32x4 x = *(const u32x4*)((const bf16*)OC + (size_t)r * D + c), y = *(const u32x4*)((const bf16*)OS + (size_t)r * D + c), z_ = *(const u32x4*)((const bf16*)OW + (size_t)r * D + c);
            u32x4 w;
#pragma unroll
            for (int e = 0; e < 4; ++e) w[e] = pk2(lo_bf(x[e]) + lo_bf(y[e]) + lo_bf(z_[e]), hi_bf(x[e]) + hi_bf(y[e]) + hi_bf(z_[e]));
            *(u32x4*)(orow + c) = w; }
#else
#pragma unroll
        for (int j = 0; j < 8; ++j) { const int c = (lane + 64 * j) * 4, h = c >> 7;
            const float g0 = sigmoidf_(bf2f(*PX(P, r, PC_G + h))), g1 = sigmoidf_(bf2f(*PX(P, r, PC_G + 16 + h))), g2 = sigmoidf_(bf2f(*PX(P, r, PC_G + 32 + h)));
            const f32x4 v = g0 * *(const f32x4*)(OC + (size_t)r * D + c) + g1 * *(const f32x4*)(OS + (size_t)r * D + c) + g2 * *(const f32x4*)(OW + (size_t)r * D + c);
            *(u32x2*)(orow + c) = (u32x2){pk2(v[0], v[1]), pk2(v[2], v[3])}; }
#endif
#if !GATED
        const bool smp = r >= MP; const int s = smp ? (r - MP) & 7 : r & 2047, b = smp ? (r - MP) >> 3 : r >> 11;
#pragma unroll
        for (int j = 0; j < 8; ++j) { const int c = (lane + 64 * j) * 4; f32x4 u[3];
#pragma unroll
            for (int t = 0; t < 3; ++t) { const int ss = s - 2 + t;
                if (ss >= 0) { const int rq = r - (2 - t); const u32x2 cg = *(const u32x2*)PX(P, rq, PC_C + c), ui = *(const u32x2*)PX(P, rq, PC_U + c);
                    u[t] = (f32x4){lo_bf(cg[0]) * lo_bf(ui[0]), hi_bf(cg[0]) * hi_bf(ui[0]), lo_bf(cg[1]) * lo_bf(ui[1]), hi_bf(cg[1]) * hi_bf(ui[1])}; }
                else if (smp) u[t] = *(const f32x4*)(a.st_conv + ((size_t)b * 2 + (ss + 2)) * D + c);
                else u[t] = (f32x4){0.f, 0.f, 0.f, 0.f}; }
            const f32x4 w0 = *(const f32x4*)(a.conv_w + c), w1 = *(const f32x4*)(a.conv_w + D + c), w2 = *(const f32x4*)(a.conv_w + 2 * D + c), cb = *(const f32x4*)(a.conv_b + c);
            const u32x2 bg = *(const u32x2*)PX(P, r, PC_B + c);
            const f32x4 y = cb + w0 * u[0] + w1 * u[1] + w2 * u[2];
            const f32x4 z = {lo_bf(bg[0]) * y[0], hi_bf(bg[0]) * y[1], lo_bf(bg[1]) * y[2], hi_bf(bg[1]) * y[3]};
            *(u32x2*)(orow + D + c) = (u32x2){pk2(z[0], z[1]), pk2(z[2], z[3])};
            const int SL = smp ? DSQ : SEQ;
            if (s >= SL - 2) { float* o = a.out + (smp ? OUT_CONVS : OUT_CONVP) + ((size_t)b * 2 + (s - (SL - 2))) * D + c; *(f32x4*)o = u[2]; } }
#endif
    }
}
__device__ __forceinline__ void ph_final(const Args& a, const Frame& F) {
    const int gw = F.vcu * 8 + F.wave, NGW = F.G * 8; const float* X2 = (const float*)(a.ws + WS_X2);
#if DBG_CHECK
    { unsigned fl = __hip_atomic_load((unsigned*)(a.ws + WS_CTL) + CW_DBG, __ATOMIC_RELAXED, __HIP_MEMORY_SCOPE_AGENT);
      if (__hip_atomic_load((unsigned*)(a.ws + WS_CTL) + CW_DBGCNT, __ATOMIC_RELAXED, __HIP_MEMORY_SCOPE_AGENT) > (DBG_MASK_TOL)) fl |= 8u;
      if (F.vcu == 0 && F.tid < 4 && ((fl >> F.tid) & 1u)) { const size_t tgt = F.tid == 0 ? OUT_CONVS : (F.tid == 1 ? OUT_CONVP : (F.tid == 2 ? OUT_WINS : OUT_KVS)); a.out[tgt] = 1e6f; } }
#endif
    for (int r = gw; r < MR; r += NGW) {
        const float* xr = X2 + (size_t)r * D; float* o = a.out + (r < MP ? OUT_YP + (size_t)r * D : OUT_YS + (size_t)(r - MP) * D);
        f32x4 v[8]; float ss = 0.f;
#pragma unroll
        for (int j = 0; j < 8; ++j) { v[j] = *(const f32x4*)(xr + (F.lane + 64 * j) * 4); ss += (v[j][0] * v[j][0] + v[j][1] * v[j][1]) + (v[j][2] * v[j][2] + v[j][3] * v[j][3]); }
        const float rstd = rsqrtf(wave_sum(ss) * (1.0f / D) + RMS_EPS);
#pragma unroll
        for (int j = 0; j < 8; ++j) { const int c = (F.lane + 64 * j) * 4; *(f32x4*)(o + c) = v[j] * rstd * *(const f32x4*)(a.nfg + c); }
    }
}


__device__ __forceinline__ void ph_check_a2(const Args& a, const Frame& F, float tol, unsigned bit) {
    const bf16* P = (const bf16*)(a.ws + WS_P); const bf16* A2 = (const bf16*)(a.ws + WS_A2);
    const float* RC = (const float*)(a.ws + WS_DBGC); const float* RS = (const float*)(a.ws + WS_DBGA); const float* RW = (const float*)(a.ws + WS_DBGB);
    bool bad = false;
    for (size_t i = (size_t)F.vcu * 512 + F.tid; i < (size_t)MR * D; i += (size_t)F.G * 512) { const int r = (int)(i >> 11), c = (int)(i & 2047), h = c >> 7;
        const float ref = sigmoidf_(bf2f(*PX(P, r, PC_G + h))) * RC[i] + sigmoidf_(bf2f(*PX(P, r, PC_G + 16 + h))) * RS[i] + sigmoidf_(bf2f(*PX(P, r, PC_G + 32 + h))) * RW[i];
        const float got = bf2f(A2[(size_t)r * 2 * D + c]); if (!(fabsf(ref - got) <= tol)) bad = true; }
    if (__any(bad) && F.lane == 0) atomicOr((unsigned*)(a.ws + WS_CTL) + CW_DBG, bit);
}

#define PHF __device__ __forceinline__ void
PHF phase0(const Args& a, const Frame& F, unsigned char* lds_raw) { ph_ada(a, F); __syncthreads();
    ph_transpose_range(a, F, TR_NBIG, TR_NIT, F.vcu, F.G);
    constexpr int NADA = 6 * D / 64;
    if (F.G > NADA && F.vcu >= NADA) ph_transpose_range(a, F, 0, TR_EARLY, F.vcu - NADA, F.G - NADA);
    sb_arrive((unsigned*)(a.ws + WS_CTL) + CW_SB0);
}
PHF phase1(const Args& a, const Frame& F, unsigned char* lds_raw) {
    ph_transpose_range(a, F, (F.G > 6 * D / 64) ? TR_EARLY : 0, TR_NBIG, F.vcu, F.G);
    sb_wait((unsigned*)(a.ws + WS_CTL) + CW_SB0, (unsigned)F.G);
    ph_peb_sum(a, F); ph_modnorm<0>(a, F); ph_compress_sample(a, F, (char*)lds_raw);
    if ((DBG_REPEAT >> 17) & 1) { __syncthreads(); ph_transpose_range(a, F, 0, TR_NBIG, F.vcu, F.G); }
    if ((DBG_REPEAT >> 18) & 1) { __syncthreads(); ph_modnorm<0>(a, F); }
    if ((DBG_REPEAT >> 19) & 1) { __syncthreads(); ph_compress_sample<0>(a, F, (char*)lds_raw); }
    if ((DBG_REPEAT >> 20) & 1) { __syncthreads(); ph_compress_sample<1>(a, F, (char*)lds_raw); }
    if ((DBG_REPEAT >> 21) & 1) { __syncthreads(); ph_compress_sample<2>(a, F, (char*)lds_raw); }
#if DBG_CHECK & 16
    ph_cache_cvt(a, F);
#endif
}
PHF phase2(const Args& a, const Frame& F, unsigned char* lds_raw) {
    {
      const int nwg = (MPAD / 256) * (NIN / 256), c = (int)blockIdx.x, full = (nwg + F.G - 1) / F.G, mine = c < nwg ? (nwg - c + F.G - 1) / F.G : 0;
      const int first_short = nwg - (full - 1) * F.G;
      if (first_short < F.G) { if (mine < full) ph_cmp_finish_mfma<1>(a, F, (char*)lds_raw, c - first_short, F.G - first_short); }
      else ph_cmp_finish_mfma<1>(a, F, (char*)lds_raw); }
    pg8::Prob g{(const char*)(a.ws + WS_H), (const char*)(a.ws + WS_WIN_T), (size_t)256 * D * 2, 0, 0, (size_t)256 * D * 2, 0, D * 2, D * 2, D / 64};
    pg8::Order S; S.init(MPAD, NIN, F.G, (int)blockIdx.x, 1);
    EpiIn E{(bf16*)(a.ws + WS_P), (bf16*)(a.ws + WS_KV6), a.out};
    __syncthreads();
    pg8::gemm_phase<EpiIn, false, true>(F.lds, g, S, E);
    if ((DBG_REPEAT >> 15) & 1) { __syncthreads(); EpiNull EN{(float*)(a.ws + WS_DBGA)}; pg8::gemm_phase<EpiNull>(F.lds, g, S, EN); }
#if DBG_CHECK & 16
    { __syncthreads();
      pg8::Prob g2{(const char*)(a.ws + WS_CA), (const char*)(a.ws + WS_WC_T), (size_t)256 * 2048 * 2, (size_t)NBS * NKV * PAST * HD * 2, 0, (size_t)256 * 2048 * 2, 0, 2048 * 2, 2048 * 2, 2048 / 64};
      pg8::Order S2; S2.init(32768, 512, F.G, (int)blockIdx.x, 1);
      EpiF32 E2{(float*)(a.ws + WS_DBGA), 512};
      pg8::gemm_phase<EpiF32>(F.lds, g2, S2, E2); }
#endif
}
PHF phase3(const Args& a, const Frame& F, unsigned char* lds_raw) {
#if DBG_CHECK & 16
    ph_check(a, F, WS_PARTS, WS_DBGA, (size_t)32768 * 512, 2e-3f, 1u);
#endif
    ph_compress_prompt(a, F);
    sb_arrive((unsigned*)(a.ws + WS_CTL) + CW_SB3);
#if DBG_CHECK & 32
    { __syncthreads(); pg8::Prob g{(const char*)(a.ws + WS_KV6), (const char*)(a.ws + WS_WC_T), (size_t)256 * 2048 * 2, (size_t)NBP * NKV * SEQ * HD * 2, 0, (size_t)256 * 2048 * 2, 0, 2048 * 2, 2048 * 2, 2048 / 64};
      pg8::Order S; S.init(2048, 512, F.G, (int)blockIdx.x, 1);
      EpiF32 E{(float*)(a.ws + WS_DBGA), 512};
      pg8::gemm_phase<EpiF32>(F.lds, g, S, E); }
#endif
    __syncthreads(); ph_sample_attn(a, F);
}
PHF phase4(const Args& a, const Frame& F, unsigned char* lds_raw) {
#if DBG_CHECK & 32
    ph_check(a, F, WS_PARTP, WS_DBGA, (size_t)2048 * 512, 2e-3f, 1u);
#endif
    if (F.vcu * 8 < 2 * NBP * NKV * 4) sb_wait((unsigned*)(a.ws + WS_CTL) + CW_SB3, (unsigned)F.G);
    ph_cmp_finish_mfma<0>(a, F, (char*)lds_raw);
#if GATED
    { const int first = F.G == 256 ? CZ_P6 : 0;
      if (F.G <= 32) { ph_conv_z(a, F, first, CZ_ITEMS, F.vcu * 8 + F.wave, F.G * 8); ph_win_shift(a, F, F.vcu, F.G); }
      else if (F.vcu >= 16) { ph_conv_z(a, F, first, CZ_ITEMS, (F.vcu - 16) * 8 + F.wave, (F.G - 16) * 8);
          const int nz = 16 + (CZ_ITEMS - first + 7) / 8;
          if (nz + 64 <= F.G) { if (F.vcu >= nz) ph_win_shift(a, F, F.vcu - nz, F.G - nz); } else ph_win_shift(a, F, F.vcu - 16, F.G - 16); } }
#endif
}
PHF phase5(const Args& a, const Frame& F, unsigned char* lds_raw) { ph_cmp_prompt(a, F, (char*)lds_raw);
#if DBG_CHECK & 8
    __syncthreads(); ph_cmp_finish<1>(a, F, WS_DBGA); __syncthreads(); ph_cmp_finish<0>(a, F, WS_DBGB);
#endif
#if DBG_CHECK & 64
    __syncthreads(); ph_cmp_attend<1>(a, F, WS_DBGC);
#endif
}
PHF phase6(const Args& a, const Frame& F, unsigned char* lds_raw) {
#if DBG_CHECK & 8
    ph_check(a, F, WS_KCS, WS_DBGA, (size_t)2 * NBS * NKV * 1024 * HD, 0.02f, 1u); ph_check(a, F, WS_KCP, WS_DBGB, (size_t)2 * NBP * NKV * 128 * HD, 0.02f, 2u);
#endif
    ph_fa_prompt(a, F, (char*)lds_raw);
#if GATED
    if (F.G == 256) { const int p = F.vcu & 3, j = F.vcu >> 2;
        if (p == 0) ph_conv_z(a, F, (j * 8 + F.wave) * 2, (j * 8 + F.wave) * 2 + 2, 0, 1);
        else if (p == 1) ph_conv_z(a, F, 1024 + j * 8 + F.wave, 1024 + j * 8 + F.wave + 1, 0, 1); }
#endif
#if DBG_CHECK & 1
    __syncthreads(); ph_slc_attend<0>(a, F, WS_DBGA); __syncthreads(); ph_win_attend<0>(a, F, WS_DBGB);
#endif
#if DBG_CHECK & 2
    __syncthreads(); ph_cmp_attend<0>(a, F, WS_DBGC, WS_SELP2);
#endif
#if DBG_CHECK & 4
    __syncthreads(); ph_cmp_attend<1>(a, F, WS_DBGC);
#endif
#if DBG_CHECK & 64
    __syncthreads(); ph_slc_attend<0>(a, F, WS_DBGA); __syncthreads(); ph_win_attend<0>(a, F, WS_DBGB); __syncthreads(); ph_cmp_attend<0>(a, F, WS_DBGC, WS_SELP2);
    __syncthreads(); ph_slc_attend<1>(a, F, WS_DBGA); __syncthreads(); ph_win_attend<1>(a, F, WS_DBGB);
#endif
}
PHF phase7(const Args& a, const Frame& F, unsigned char* lds_raw) {
#if DBG_CHECK & 1
    ph_check(a, F, WS_OSLC, WS_DBGA, (size_t)MP * D, 0.05f, 1u); ph_check(a, F, WS_OWIN, WS_DBGB, (size_t)MP * D, 0.05f, 2u);
#endif
#if DBG_CHECK & 2
    ph_check(a, F, WS_OCMP, WS_DBGC, (size_t)MP * D, 0.03f, 4u); ph_check_masks(a, F);
#endif
#if DBG_CHECK & 4
    __syncthreads(); ph_slc_attend<1>(a, F, WS_DBGA); __syncthreads(); ph_win_attend<1>(a, F, WS_DBGB);
#endif
    ph_combine(a, F);
}
#if (DBG_REPEAT >> 22) & 1
#define SG_REP(...) do { _Pragma("unroll 1") for (int rep_ = 0; rep_ < 5; ++rep_) { if (rep_) __syncthreads(); __VA_ARGS__; } } while (0)
#else
#define SG_REP(...) __VA_ARGS__
#endif
PHF phase8(const Args& a, const Frame& F, unsigned char* lds_raw) {
#if DBG_CHECK & 64
    ph_check_a2(a, F, 0.03f, 1u); ph_check_masks(a, F);
#endif
#if DBG_CHECK & 4
    ph_check(a, F, WS_OCMP + (size_t)MP * D * 4, WS_DBGC + (size_t)MP * D * 4, (size_t)MS * D, 0.01f, 1u); ph_check(a, F, WS_OSLC + (size_t)MP * D * 4, WS_DBGA + (size_t)MP * D * 4, (size_t)MS * D, 0.01f, 2u);
    ph_check(a, F, WS_OWIN + (size_t)MP * D * 4, WS_DBGB + (size_t)MP * D * 4, (size_t)MS * D, 0.01f, 4u);
#endif
    { SEpiProj SE{(const bf16*)(a.ws + WS_P), (bf16*)(a.ws + WS_MIX)};
      if (F.G == 256) small_gemm2<2>(F, (const bf16*)(a.ws + WS_A2) + (size_t)MP * 2 * D, 2 * D, D, (const bf16*)(a.ws + WS_WP_T), 2 * D, D, D, SE, (float*)(a.ws + WS_PARTX), (unsigned*)(a.ws + WS_CTL) + CW_SG2);
      else SG_REP(small_gemm<8, 2>(F, (const bf16*)(a.ws + WS_A2) + (size_t)MP * 2 * D, 2 * D, D, (const bf16*)(a.ws + WS_WP_T), 2 * D, D, D, D, SE)); }
    pg8::Prob g{(const char*)(a.ws + WS_A2), (const char*)(a.ws + WS_WP_T), (size_t)256 * 2 * D * 2, 0, (size_t)D * 2, (size_t)256 * 2 * D * 2, (size_t)D * 2, 2 * D * 2, 2 * D * 2, D / 64};
    pg8::Order S; S.init(MP, D, F.G, (int)blockIdx.x, 2);
    EpiProj E{(const bf16*)(a.ws + WS_P), (bf16*)(a.ws + WS_MIX)};
    pg8::gemm_phase<EpiProj>(F.lds, g, S, E);
}
PHF phase9(const Args& a, const Frame& F, unsigned char* lds_raw) {
    { SEpiRes<0> SE{a};
      if (F.G == 256) small_gemm2<1>(F, (const bf16*)(a.ws + WS_MIX) + (size_t)MP * D, D, 0, (const bf16*)(a.ws + WS_WOUT_T), D, 0, D, SE, (float*)(a.ws + WS_PARTX), (unsigned*)(a.ws + WS_CTL) + CW_SG2 + 64);
      else SG_REP(small_gemm<8, 1>(F, (const bf16*)(a.ws + WS_MIX) + (size_t)MP * D, D, 0, (const bf16*)(a.ws + WS_WOUT_T), D, 0, D, D, SE)); }
    pg8::Prob g{(const char*)(a.ws + WS_MIX), (const char*)(a.ws + WS_WOUT_T), (size_t)256 * D * 2, 0, 0, (size_t)256 * D * 2, 0, D * 2, D * 2, D / 64};
    pg8::Order S; S.init(MP, D, F.G, (int)blockIdx.x, 1);
    EpiRes<0> E{a};
    pg8::gemm_phase<EpiRes<0>>(F.lds, g, S, E);
}
PHF phase10(const Args& a, const Frame& F, unsigned char* lds_raw) { ph_modnorm<1>(a, F); }
PHF phase11(const Args& a, const Frame& F, unsigned char* lds_raw) {
    { SEpiRelu2 SE{(bf16*)(a.ws + WS_HM)};
      SG_REP(small_gemm<32, 1>(F, (const bf16*)(a.ws + WS_H) + (size_t)MP * D, D, 0, (const bf16*)(a.ws + WS_W1_T), D, 0, D, DFF, SE)); }
    pg8::Prob g{(const char*)(a.ws + WS_H), (const char*)(a.ws + WS_W1_T), (size_t)256 * D * 2, 0, 0, (size_t)256 * D * 2, 0, D * 2, D * 2, D / 64};
    pg8::Order S; S.init(MP, DFF, F.G, (int)blockIdx.x, 1);
    EpiRelu2 E{(bf16*)(a.ws + WS_HM)};
    pg8::gemm_phase<EpiRelu2, false, true>(F.lds, g, S, E);
}
PHF phase12(const Args& a, const Frame& F, unsigned char* lds_raw) {
    { SEpiRes<1> SE{a};
      if (F.G == 256) small_gemm2<1>(F, (const bf16*)(a.ws + WS_HM) + (size_t)MP * DFF, DFF, 0, (const bf16*)(a.ws + WS_W2_T), DFF, 0, DFF, SE, (float*)(a.ws + WS_PARTX), (unsigned*)(a.ws + WS_CTL) + CW_SG2 + 128);
      else SG_REP(small_gemm<8, 1>(F, (const bf16*)(a.ws + WS_HM) + (size_t)MP * DFF, DFF, 0, (const bf16*)(a.ws + WS_W2_T), DFF, 0, DFF, D, SE)); }
    pg8::Prob g{(const char*)(a.ws + WS_HM), (const char*)(a.ws + WS_W2_T), (size_t)256 * DFF * 2, 0, 0, (size_t)256 * DFF * 2, 0, DFF * 2, DFF * 2, DFF / 64};
    pg8::Order S; S.init(MP, D, F.G, (int)blockIdx.x, 1);
    EpiRes<1> E{a};
    pg8::gemm_phase<EpiRes<1>>(F.lds, g, S, E);
}
PHF phase13(const Args& a, const Frame& F, unsigned char* lds_raw) { ph_final(a, F); }

#define CAS __attribute__((address_space(4)))
#define GAS __attribute__((address_space(1)))
__device__ __forceinline__ void load_args(Args& a) {
    const CAS unsigned long long* kp = (const CAS unsigned long long*)__builtin_amdgcn_kernarg_segment_ptr();
    asm volatile("" : "+s"(kp));
    a.x_p = (const float*)(const GAS float*)kp[0];
    a.x_s = (const float*)(const GAS float*)kp[1];
    a.c_p = (const float*)(const GAS float*)kp[2];
    a.c_s = (const float*)(const GAS float*)kp[3];
    a.cache = (const float*)(const GAS float*)kp[4];
    a.ptab = (const int*)(const GAS int*)kp[5];
    a.st_win = (const float*)(const GAS float*)kp[6];
    a.st_conv = (const float*)(const GAS float*)kp[7];
    a.w_ada = (const float*)(const GAS float*)kp[8];
    a.b_ada = (const float*)(const GAS float*)kp[9];
    a.n1g = (const float*)(const GAS float*)kp[10];
    a.n2g = (const float*)(const GAS float*)kp[11];
    a.w_in = (const float*)(const GAS float*)kp[12];
    a.wck1 = (const float*)(const GAS float*)kp[13];
    a.wck2 = (const float*)(const GAS float*)kp[14];
    a.pek = (const float*)(const GAS float*)kp[15];
    a.wcv1 = (const float*)(const GAS float*)kp[16];
    a.wcv2 = (const float*)(const GAS float*)kp[17];
    a.pev = (const float*)(const GAS float*)kp[18];
    a.conv_w = (const float*)(const GAS float*)kp[19];
    a.conv_b = (const float*)(const GAS float*)kp[20];
    a.w_ap = (const float*)(const GAS float*)kp[21];
    a.w_cp = (const float*)(const GAS float*)kp[22];
    a.w_out = (const float*)(const GAS float*)kp[23];
    a.w_m1 = (const float*)(const GAS float*)kp[24];
    a.w_m2 = (const float*)(const GAS float*)kp[25];
    a.nfg = (const float*)(const GAS float*)kp[26];
    a.out = (float*)(GAS float*)kp[27]; a.ws = (unsigned char*)(GAS unsigned char*)kp[28]; a.ph_lo = 0; a.ph_hi = 0;
}

constexpr int N_PHASES = 15;
__global__ void __launch_bounds__(512, 2) nsa_fwd(Args a) {
    extern __shared__ __attribute__((aligned(16))) unsigned char lds_raw[];
    Frame F; F.lds = (LAS unsigned char*)lds_raw; F.tid = threadIdx.x; F.lane = F.tid & 63; F.wave = __builtin_amdgcn_readfirstlane(F.tid >> 6);
    F.G = gridDim.x; { const int bx = blockIdx.x; F.vcu = (F.G % 8 == 0) ? (bx % 8) * (F.G / 8) + bx / 8 : bx; }
    volatile LAS unsigned* MISC = (volatile LAS unsigned*)(F.lds + MISC_OFF);
    for (int u = F.tid; u < (LDS_BYTES - RING_BYTES) / 4; u += 512) ((LAS unsigned*)(F.lds + RING_BYTES))[u] = 0u;
    __syncthreads();
#if MK_PER_PHASE
#define GRID_BAR() do { } while (0)
#else
    XcdBarrier bar = xcd_barrier_post((unsigned*)(a.ws + WS_CTL) + 4096, MISC + 8);
#define GRID_BAR() xcd_barrier(bar)
#endif
    (void)MISC;
    const int lo = a.ph_lo, hi = a.ph_hi;
#ifdef DBG_ONLY
#define IN(k) ((k) == DBG_ONLY && lo <= (k) && (k) < hi)
#else
#define IN(k) (lo <= (k) && (k) < hi)
#endif
#define SEAM(k) do { if (IN(k) && IN((k) + 1)) GRID_BAR(); } while (0)
#define RUN(k) do { if (IN(k)) { Args la; load_args(la); phase##k(la, F, lds_raw); if (((DBG_REPEAT >> (k)) & 1) != 0) { __syncthreads(); phase##k(la, F, lds_raw); } } } while (0)
    RUN(0);
    RUN(1); SEAM(1);
    RUN(2); SEAM(2);
    RUN(3);
    RUN(4); SEAM(4);
    RUN(5); SEAM(5);
    RUN(6); SEAM(6);
#if !GATED
    RUN(7); SEAM(7);
#endif
    RUN(8); SEAM(8);
    RUN(9); SEAM(9);
    RUN(10); SEAM(10);
    RUN(11); SEAM(11);
    RUN(12); SEAM(12);
    RUN(13);
#undef IN
#undef SEAM
}

extern "C" void kernel_launch(void* const* d_in, const int* in_sizes, int n_in, void* d_out, int out_size, void* d_ws, size_t ws_size, hipStream_t stream) {
    static int grid = 0;
    if (grid == 0) {
        if (n_in != 27 || (size_t)out_size != OUT_END || ws_size < WS_END) { fprintf(stderr, "kernel_launch: unexpected shapes (n_in %d out %d ws %zu need %zu)\n", n_in, out_size, ws_size, (size_t)WS_END); grid = -1; return; }
        int dev = 0, cus = 0;
        if (hipGetDevice(&dev) != hipSuccess || hipDeviceGetAttribute(&cus, hipDeviceAttributeMultiprocessorCount, dev) != hipSuccess) { grid = -1; return; }
        if (hipFuncSetAttribute((const void*)nsa_fwd, hipFuncAttributeMaxDynamicSharedMemorySize, LDS_BYTES) != hipSuccess) { fprintf(stderr, "kernel_launch: hipFuncSetAttribute failed\n"); grid = -1; return; }
        (void)hipGetLastError();
        grid = cus;
    }
    if (grid < 0) return;
    if (hipMemsetAsync((char*)d_ws + WS_CTL, 0, CTL_BYTES, stream) != hipSuccess) { fprintf(stderr, "kernel_launch: memset failed\n"); return; }
    Args a{};
    const float** fp = (const float**)&a;
    for (int i = 0; i < 27; ++i) fp[i] = (const float*)d_in[i];
    a.out = (float*)d_out; a.ws = (unsigned char*)d_ws;
#if MK_PER_PHASE
    for (int p = 0; p < N_PHASES - 1; ++p) { a.ph_lo = p; a.ph_hi = p + 1; hipLaunchKernelGGL(nsa_fwd, dim3(grid), dim3(512), LDS_BYTES, stream, a); }
#else
    a.ph_lo = 0; a.ph_hi = N_PHASES; hipLaunchKernelGGL(nsa_fwd, dim3(grid), dim3(512), LDS_BYTES, stream, a);
#endif
    const hipError_t le = hipPeekAtLastError();
    if (le != hipSuccess) fprintf(stderr, "kernel_launch: launch failed: %s\n", hipGetErrorName(le));
}
```
